# Optimizing an MI355X kernel written in HIP

```python
import math
import jax, jax.numpy as jnp
from jax import lax
import numpy as np

D_MODEL = 1024
BATCH = 8
SEQ = 4096
DEPTH = 2

PLE_DIM = 256
N_EVEN = (DEPTH + 1) // 2
N_ODD = DEPTH // 2
DEEPNORM_ALPHA = (2.0 * DEPTH) ** 0.25
DEEPNORM_BETA = (8.0 * DEPTH) ** -0.25
BLOCK = 128
EPS = 1e-6
A_HEAD_DIM = 64
A_HEADS = (D_MODEL // 2) // A_HEAD_DIM
A_KV_HEADS = A_HEADS // 4
A_WIDTH = A_HEADS * A_HEAD_DIM
WINDOW = 128
B_WIDTH = D_MODEL // 2
CONV_W = 3
C_HEADS = 8
C_NOPE = 64
C_ROPE = 32
C_V = 64
C_WIDTH = C_HEADS * C_V
C_Q_RANK = D_MODEL // 4
C_KV_RANK = D_MODEL // 8
ROPE_THETA = 10000.0
D_WIDTH = D_MODEL // 2
D_GROUPS = 4
D_GROUP_DIM = D_WIDTH // D_GROUPS
D_CHUNK = 128

EVEN_SIZES = (A_WIDTH, A_KV_HEADS * A_HEAD_DIM, A_KV_HEADS * A_HEAD_DIM,
              B_WIDTH, B_WIDTH, B_WIDTH, A_WIDTH + B_WIDTH)
ODD_SIZES = (C_Q_RANK, C_KV_RANK, C_ROPE, D_WIDTH, D_WIDTH, C_WIDTH + D_WIDTH)
EVEN_IN = sum(EVEN_SIZES)
ODD_IN = sum(ODD_SIZES)
MIX_OUT = D_MODEL

kernel_name = "hybrid_swa_shortconv_mla_gmlp_deepnorm"


def _split(h, sizes):
    idx = np.cumsum(np.array(sizes))[:-1].tolist()
    return jnp.split(h, idx, axis=-1)


def rms_norm(x, g):
    xf = x.astype(jnp.float32)
    y = xf * lax.rsqrt(jnp.mean(xf * xf, axis=-1, keepdims=True) + EPS)
    return (y * g.astype(jnp.float32)).astype(x.dtype)


def layer_norm(x, g, b):
    xf = x.astype(jnp.float32)
    mu = jnp.mean(xf, axis=-1, keepdims=True)
    xc = xf - mu
    var = jnp.mean(xc * xc, axis=-1, keepdims=True)
    y = xc * lax.rsqrt(var + EPS) * g.astype(jnp.float32) + b.astype(jnp.float32)
    return y.astype(x.dtype)


def rope(x, pos):
    half = x.shape[-1] // 2
    inv = ROPE_THETA ** (-jnp.arange(half, dtype=jnp.float32) / half)
    ang = pos.astype(jnp.float32)[..., None] * inv
    cos = jnp.cos(ang)[:, :, None, :]
    sin = jnp.sin(ang)[:, :, None, :]
    xf = x.astype(jnp.float32)
    x1, x2 = xf[..., :half], xf[..., half:]
    return jnp.concatenate([x1 * cos - x2 * sin, x1 * sin + x2 * cos], axis=-1).astype(x.dtype)


def _band_windows(t, nb):
    tp = jnp.pad(t, [(0, 0), (BLOCK, BLOCK)] + [(0, 0)] * (t.ndim - 2))
    tb = tp.reshape(t.shape[0], nb + 2, BLOCK, *t.shape[2:])
    return jnp.concatenate([tb[:, :-2], tb[:, 1:-1], tb[:, 2:]], axis=2)


def windowed_gqa_sink(q, k, v, pos, sink):
    Bn, S, H, dh = q.shape
    Hk = k.shape[2]
    G = H // Hk
    nb = S // BLOCK
    kw = _band_windows(k, nb)
    vw = _band_windows(v, nb)
    posk = _band_windows(pos, nb)
    posq = pos.reshape(Bn, nb, BLOCK)
    q_idx = jnp.arange(BLOCK)[:, None]
    w_idx = jnp.arange(3 * BLOCK)[None, :]
    in_band = jnp.abs(w_idx - BLOCK - q_idx) <= WINDOW
    k_glob = jnp.arange(nb)[:, None] * BLOCK + jnp.arange(3 * BLOCK)[None, :] - BLOCK
    in_seq = (k_glob >= 0) & (k_glob < S)
    valid = in_band[None] & in_seq[:, None, :]
    slopes = jnp.exp2(-8.0 * jnp.arange(1, H + 1, dtype=jnp.float32) / H).reshape(Hk, G, 1, 1)
    dist = jnp.abs(posq[..., :, None] - posk[..., None, :]).astype(jnp.float32)
    qb = q.reshape(Bn, nb, BLOCK, Hk, G, dh)
    logits = jnp.einsum('bnqkgd,bnskd->bnkgqs', qb, kw).astype(jnp.float32) * (dh ** -0.5)
    logits = logits - slopes * dist[:, :, None, None]
    logits = jnp.where(valid[None, :, None, None], logits, -jnp.inf)
    sink_l = jnp.broadcast_to(sink.astype(jnp.float32).reshape(Hk, G, 1, 1), logits.shape[:-1] + (1,))
    probs = jax.nn.softmax(jnp.concatenate([logits, sink_l], axis=-1), axis=-1)[..., :-1]
    out = jnp.einsum('bnkgqs,bnskd->bnqkgd', probs.astype(v.dtype), vw)
    return out.reshape(Bn, S, H * dh)


def short_conv_mixer(bg, cg, xin, conv_w):
    z = cg * xin
    C = z.shape[-1]
    y = lax.conv_general_dilated(z, conv_w[:, None, :].astype(z.dtype), window_strides=(1,),
                                 padding=((CONV_W // 2, CONV_W // 2),),
                                 dimension_numbers=('NWC', 'WIO', 'NWC'), feature_group_count=C)
    return bg * y


def mla_attention(q_nope, q_rope, k_nope, k_rope, v):
    Bn, S, H, _ = q_nope.shape
    nb = S // BLOCK
    scale = (C_NOPE + C_ROPE) ** -0.5

    def to_blocks(t):
        return jnp.moveaxis(t.reshape(Bn, nb, BLOCK, *t.shape[2:]), 1, 0)

    def attend(blk):
        qn, qr = blk
        s = (jnp.einsum('bqhd,bshd->bhqs', qn, k_nope)
             + jnp.einsum('bqhr,bsr->bhqs', qr, k_rope)).astype(jnp.float32) * scale
        pr = jax.nn.softmax(s, axis=-1).astype(v.dtype)
        return jnp.einsum('bhqs,bshd->bqhd', pr, v)

    out = lax.map(attend, (to_blocks(q_nope), to_blocks(q_rope)))
    return jnp.moveaxis(out, 0, 1).reshape(Bn, S, H * v.shape[-1])


def chunked_spatial_gate(u, v, v_ln_g, v_ln_b, w_s, b_s):
    Bn, S, _ = v.shape
    nc = S // D_CHUNK
    vn = layer_norm(v, v_ln_g, v_ln_b)
    vc = vn.reshape(Bn, nc, D_CHUNK, D_GROUPS, D_GROUP_DIM)
    mixed = jnp.einsum('gts,bcsgd->bctgd', w_s.astype(v.dtype), vc) + b_s.T.astype(v.dtype)[None, None, :, :, None]
    return u * mixed.reshape(Bn, S, D_WIDTH)


def even_mixer(x, pos, w_in, conv_w, sink, a_norm, b_norm, w_out):
    Bn, S, _ = x.shape
    q, k, v, bg, cg, xin, z = _split(x @ w_in, EVEN_SIZES)
    q = q.reshape(Bn, S, A_HEADS, A_HEAD_DIM)
    k = k.reshape(Bn, S, A_KV_HEADS, A_HEAD_DIM)
    v = v.reshape(Bn, S, A_KV_HEADS, A_HEAD_DIM)
    ya = windowed_gqa_sink(q, k, v, pos, sink)
    yb = short_conv_mixer(bg, cg, xin, conv_w)
    y = jnp.concatenate([rms_norm(ya, a_norm), rms_norm(yb, b_norm)], axis=-1) * jax.nn.silu(z)
    return y @ w_out


def odd_mixer(x, pos, w_in, q_norm, w_uq, kv_norm, w_ukv, v_ln_g, v_ln_b, w_s, b_s, c_norm, d_norm, w_out):
    Bn, S, _ = x.shape
    cq, ckv, kr, du, dv, z = _split(x @ w_in, ODD_SIZES)
    q = (rms_norm(cq, q_norm) @ w_uq).reshape(Bn, S, C_HEADS, C_NOPE + C_ROPE)
    q_nope = q[..., :C_NOPE]
    q_rope = rope(q[..., C_NOPE:], pos)
    kv = (rms_norm(ckv, kv_norm) @ w_ukv).reshape(Bn, S, C_HEADS, C_NOPE + C_V)
    k_nope, v = kv[..., :C_NOPE], kv[..., C_NOPE:]
    k_rope = rope(kr[:, :, None, :], pos)[:, :, 0]
    yc = mla_attention(q_nope, q_rope, k_nope, k_rope, v)
    yd = chunked_spatial_gate(jax.nn.gelu(du), jax.nn.gelu(dv), v_ln_g, v_ln_b, w_s, b_s)
    y = jnp.concatenate([rms_norm(yc, c_norm), rms_norm(yd, d_norm)], axis=-1) * jax.nn.silu(z)
    return y @ w_out


def _normal(k, shape, std):
    return std * jax.random.normal(k, shape, jnp.float32)


def setup_inputs(seed: int = 0) -> dict:
    key = jax.random.key(seed)
    ks = iter(jax.random.split(key, 32))
    E, O, L = N_EVEN, N_ODD, DEPTH
    d = {}
    d['x'] = _normal(next(ks), (BATCH, SEQ, D_MODEL), 1.0)
    d['p'] = _normal(next(ks), (DEPTH, BATCH, SEQ, PLE_DIM), 1.0)
    d['positions'] = jnp.broadcast_to(jnp.arange(SEQ, dtype=jnp.int32), (BATCH, SEQ))
    d['ev_w_in'] = _normal(next(ks), (E, D_MODEL, EVEN_IN), D_MODEL ** -0.5)
    d['ev_conv_w'] = _normal(next(ks), (E, CONV_W, B_WIDTH), CONV_W ** -0.5)
    d['ev_sink'] = _normal(next(ks), (E, A_HEADS), 0.5)
    d['ev_a_norm'] = 1.0 + _normal(next(ks), (E, A_WIDTH), 0.02)
    d['ev_b_norm'] = 1.0 + _normal(next(ks), (E, B_WIDTH), 0.02)
    d['ev_w_out'] = _normal(next(ks), (E, MIX_OUT, D_MODEL), DEEPNORM_BETA * MIX_OUT ** -0.5)
    d['od_w_in'] = _normal(next(ks), (O, D_MODEL, ODD_IN), D_MODEL ** -0.5)
    d['od_q_norm'] = 1.0 + _normal(next(ks), (O, C_Q_RANK), 0.02)
    d['od_w_uq'] = _normal(next(ks), (O, C_Q_RANK, C_HEADS * (C_NOPE + C_ROPE)), C_Q_RANK ** -0.5)
    d['od_kv_norm'] = 1.0 + _normal(next(ks), (O, C_KV_RANK), 0.02)
    d['od_w_ukv'] = _normal(next(ks), (O, C_KV_RANK, C_HEADS * (C_NOPE + C_V)), C_KV_RANK ** -0.5)
    d['od_v_ln_g'] = 1.0 + _normal(next(ks), (O, D_WIDTH), 0.02)
    d['od_v_ln_b'] = _normal(next(ks), (O, D_WIDTH), 0.02)
    d['od_w_s'] = _normal(next(ks), (O, D_GROUPS, D_CHUNK, D_CHUNK), D_CHUNK ** -0.5)
    d['od_b_s'] = 1.0 + _normal(next(ks), (O, D_GROUPS, D_CHUNK), 0.1)
    d['od_c_norm'] = 1.0 + _normal(next(ks), (O, C_WIDTH), 0.02)
    d['od_d_norm'] = 1.0 + _normal(next(ks), (O, D_WIDTH), 0.02)
    d['od_w_out'] = _normal(next(ks), (O, MIX_OUT, D_MODEL), DEEPNORM_BETA * MIX_OUT ** -0.5)
    d['post_ln_g'] = 1.0 + _normal(next(ks), (L, D_MODEL), 0.02)
    d['post_ln_b'] = _normal(next(ks), (L, D_MODEL), 0.02)
    d['ple_proj'] = _normal(next(ks), (L, PLE_DIM, D_MODEL), PLE_DIM ** -0.5)
    d['ple_gate'] = _normal(next(ks), (L, D_MODEL, D_MODEL), D_MODEL ** -0.5)
    return d


def reference(x, p, positions, ev_w_in, ev_conv_w, ev_sink, ev_a_norm, ev_b_norm, ev_w_out,
              od_w_in, od_q_norm, od_w_uq, od_kv_norm, od_w_ukv, od_v_ln_g, od_v_ln_b, od_w_s, od_b_s,
              od_c_norm, od_d_norm, od_w_out, post_ln_g, post_ln_b, ple_proj, ple_gate):
    for i in range(DEPTH):
        j = i // 2
        if i % 2 == 0:
            y = even_mixer(x, positions, ev_w_in[j], ev_conv_w[j], ev_sink[j],
                           ev_a_norm[j], ev_b_norm[j], ev_w_out[j])
        else:
            y = odd_mixer(x, positions, od_w_in[j], od_q_norm[j], od_w_uq[j], od_kv_norm[j], od_w_ukv[j],
                          od_v_ln_g[j], od_v_ln_b[j], od_w_s[j], od_b_s[j], od_c_norm[j], od_d_norm[j],
                          od_w_out[j])
        h = layer_norm(DEEPNORM_ALPHA * x + y, post_ln_g[i], post_ln_b[i])
        x = h + jax.nn.sigmoid(h @ ple_gate[i]) * (p[i] @ ple_proj[i])
    return x
```

```cpp
#include <hip/hip_runtime.h>
#include <hip/hip_cooperative_groups.h>
#include <cstdio>
#include <cstdint>
namespace cg = cooperative_groups;

#define LAS __attribute__((address_space(3)))
typedef unsigned short bf16_t;
typedef short bf16x8 __attribute__((ext_vector_type(8)));
typedef float f32x4 __attribute__((ext_vector_type(4)));
typedef float f32x2 __attribute__((ext_vector_type(2)));
typedef float f32x16 __attribute__((ext_vector_type(16)));
typedef unsigned u32x4 __attribute__((ext_vector_type(4)));
typedef unsigned u32x2 __attribute__((ext_vector_type(2)));

constexpr int BATCH = 8, SEQ = 4096, DM = 1024, M = BATCH * SEQ;
constexpr int EV_IN = 3328, OD_IN_SRC = 2464, OD_IN = 2560;
constexpr float EPS = 1e-6f, LOG2E = 1.4426950408889634f;
constexpr float DN_ALPHA = 1.4142135623730951f;
constexpr size_t MiB = 1u << 20;
constexpr size_t WS_WT_IN0 = 0, WS_WT_OUT0 = 7 * MiB, WS_WT_GATE0 = 9 * MiB, WS_WT_GATE1 = 11 * MiB, WS_WT_PROJ0 = 13 * MiB, WS_WT_PROJ1 = 13 * MiB + 512 * 1024,
                 WS_WT_IN1 = 14 * MiB, WS_WT_UQ = 19 * MiB, WS_WT_UK = 19 * MiB + 512 * 1024, WS_WT_UV = 19 * MiB + 768 * 1024, WS_WT_OUT1 = 20 * MiB,
                 WS_WSB = 22 * MiB, WS_GV = 22 * MiB + 512 * 1024, WS_CS = 23 * MiB, WS_PART = 27 * MiB, WS_STATQ = 31 * MiB, WS_STATKV = 31 * MiB + 512 * 1024,
                 WS_STATV = 32 * MiB, WS_SSQC = 34 * MiB, WS_MRBLK = 35 * MiB, WS_BAR = 39 * MiB,
                 WS_XB = 40 * MiB, WS_PB = 104 * MiB, WS_PP = 136 * MiB, WS_HR = 200 * MiB, WS_KV = 408 * MiB, WS_END = 488 * MiB;
constexpr int MR_UMAX = 8;

__device__ __forceinline__ unsigned cvt_pk_bf16(float lo, float hi) { unsigned r; asm volatile("v_cvt_pk_bf16_f32 %0, %1, %2" : "=v"(r) : "v"(lo), "v"(hi)); return r; }
__device__ __forceinline__ float bflo(unsigned w) { return __uint_as_float(w << 16); }
__device__ __forceinline__ float bfhi(unsigned w) { return __uint_as_float(w & 0xffff0000u); }
__device__ __forceinline__ float bf2f(bf16_t v) { return __uint_as_float((unsigned)v << 16); }
__device__ __forceinline__ bf16_t f2bf(float f) { return (bf16_t)(cvt_pk_bf16(f, 0.f) & 0xffffu); }
__device__ __forceinline__ float sigm(float x) { return __builtin_amdgcn_rcpf(1.f + __expf(-x)); }
__device__ __forceinline__ float siluf(float x) { return x * sigm(x); }
__device__ __forceinline__ float geluf(float x) { return x * sigm(1.5957691216057308f * (x + 0.044715f * x * x * x)); }
__device__ __forceinline__ u32x4 pack8(const f32x4 a, const f32x4 b) { u32x4 w; w.x = cvt_pk_bf16(a[0], a[1]); w.y = cvt_pk_bf16(a[2], a[3]); w.z = cvt_pk_bf16(b[0], b[1]); w.w = cvt_pk_bf16(b[2], b[3]); return w; }

template <int X> __device__ __forceinline__ float swz_xor(float v) { return __int_as_float(__builtin_amdgcn_ds_swizzle(__float_as_int(v), (X << 10) | 0x1f)); }
__device__ __forceinline__ float xor32_add(float v) { auto rr = __builtin_amdgcn_permlane32_swap(__float_as_uint(v), __float_as_uint(v), false, false); return __uint_as_float(rr[0]) + __uint_as_float(rr[1]); }
__device__ __forceinline__ float xor32_max(float v) { auto rr = __builtin_amdgcn_permlane32_swap(__float_as_uint(v), __float_as_uint(v), false, false); return fmaxf(__uint_as_float(rr[0]), __uint_as_float(rr[1])); }
__device__ __forceinline__ int lane_id_v() { int l; asm volatile("v_mbcnt_lo_u32_b32 %0, -1, 0\n\tv_mbcnt_hi_u32_b32 %0, -1, %0" : "=v"(l)); return l; }
__device__ __forceinline__ int tid_from(int wsg) { int l; asm volatile("v_mbcnt_lo_u32_b32 %0, -1, 0\n\tv_mbcnt_hi_u32_b32 %0, -1, %0" : "=v"(l)); return (wsg << 6) | l; }
__device__ __forceinline__ void swap32(unsigned& a, unsigned& b) { auto r = __builtin_amdgcn_permlane32_swap(a, b, false, false); a = r[0]; b = r[1]; }
namespace pg8 {
constexpr int BM = 256, BK = 64, HALF = 128, HTB = HALF * BK * 2, STAGE_BYTES = 8 * HTB, NXCD = 8, WGM = 8;
__host__ __device__ __forceinline__ int lds_byte(int r, int c) { const int st = (r >> 4) * 2 + (c >> 5), rr = r & 15, cc = c & 31, ob = rr * 64 + cc * 2; return st * 1024 + (ob ^ (((ob >> 9) & 1) << 5)); }
__host__ __device__ __forceinline__ void stage_rc(int b, int& R, int& C) { const int st = b / 1024, sb = b % 1024, swz = sb ^ (((sb >> 9) & 1) << 5); R = (st >> 1) * 16 + swz / 64; C = (st & 1) * 32 + (swz % 64) / 2; }
__host__ __device__ __forceinline__ int perm32(int rho) { const int n = rho >> 4, i = rho & 15; return 8 * (i >> 2) + 4 * n + (i & 3); }
struct Unit { int pm, pn, idx; };
struct Gemm { const bf16_t* A; const bf16_t* Bt; int M, N, K, lda, ldb; };
struct StaticOrder {
    int nM, nN, nwg, G, c;
    __device__ __forceinline__ void init(int M_, int N_, int G_, int c_) { nM = M_ / BM; nN = N_ / BM; nwg = nM * nN; G = G_; c = c_; }
    __device__ __forceinline__ bool next(int i, Unit& u) const {
        const long L = (long)i * G + c; if (L >= nwg) return false;
        int wgid = (int)L; { const int q = nwg / NXCD, r = nwg % NXCD, xcd = wgid % NXCD, off = wgid / NXCD; wgid = (xcd < r ? xcd * (q + 1) : r * (q + 1) + (xcd - r) * q) + off; }
        const int nig = WGM * nN, gid = wgid / nig, fm = gid * WGM, gsz = (nM - fm) < WGM ? (nM - fm) : WGM;
        u.pm = fm + ((wgid % nig) % gsz); u.pn = (wgid % nig) / gsz; u.idx = i; return true;
    }
};
template <class Epi, class Sched>
__device__ __forceinline__ void gemm_phase(int wsg, LAS unsigned char* lds, const Gemm g, const Sched& S, const Epi& E) {
    int tid_ = tid_from(wsg); asm volatile("" : "+v"(tid_));
    const int tid = tid_, wid = __builtin_amdgcn_readfirstlane(tid >> 6), lane = tid & 63, wr = wid >> 2, wc = wid & 3, fr = lane & 15, fq = lane >> 4;
    const int K = g.K, nt = K / BK;
    unsigned voffA[2], voffB[2];
#pragma unroll
    for (int i = 0; i < 2; ++i) { int R, C; stage_rc(tid * 16 + i * 8192, R, C); const int Rb = (R & ~31) + perm32(R & 31);
        voffA[i] = (unsigned)(R * g.lda + C) * 2u; voffB[i] = (unsigned)(Rb * g.ldb + C) * 2u; }
    const size_t kstep = (size_t)(BK * 2);
    const size_t hstepA = (size_t)HALF * g.lda * 2, hstepB = (size_t)HALF * g.ldb * 2;
    const size_t tstepA = 2 * hstepA, tstepB = 2 * hstepB;
    const unsigned ldsw = (unsigned)wid * 1024u;
    const int aoff = lds_byte(wr * 64 + fr, fq * 8), boff = lds_byte(wc * 32 + fr, fq * 8);
#define PG8_SA(b, h) (((b) * 2 + (h)) * HTB)
#define PG8_SB(b, h) ((4 + (b) * 2 + (h)) * HTB)
#define PG8_STAGE(bufoff, gbase, voff) do { _Pragma("unroll") for (int _i = 0; _i < 2; ++_i) \
        __builtin_amdgcn_global_load_lds((const unsigned*)((const char*)(gbase) + (voff)[_i]), (LAS unsigned*)(lds + (bufoff) + ldsw + _i * 8192), 16, 0, 0); } while (0)
#define PG8_LDA(dst, b, h) do { _Pragma("unroll") for (int m = 0; m < 4; ++m) _Pragma("unroll") for (int k = 0; k < 2; ++k) dst[m][k] = *(const LAS bf16x8*)(lds + PG8_SA(b, h) + aoff + m * 2048 + k * 1024); } while (0)
#define PG8_LDB(dst, b, h) do { _Pragma("unroll") for (int n = 0; n < 2; ++n) _Pragma("unroll") for (int k = 0; k < 2; ++k) dst[n][k] = *(const LAS bf16x8*)(lds + PG8_SB(b, h) + boff + n * 2048 + k * 1024); } while (0)
#define PG8_MMA(ai, bj, At, Bt) do { __builtin_amdgcn_s_setprio(1); _Pragma("unroll") for (int m = 0; m < 4; ++m) _Pragma("unroll") for (int n = 0; n < 2; ++n) _Pragma("unroll") for (int k = 0; k < 2; ++k) \
        acc[ai][bj][m][n] = __builtin_amdgcn_mfma_f32_16x16x32_bf16(Bt[n][k], At[m][k], acc[ai][bj][m][n], 0, 0, 0); __builtin_amdgcn_s_setprio(0); } while (0)
#define PG8_WAIT_V(n) asm volatile("s_waitcnt vmcnt(" #n ")" ::: "memory")
#define PG8_WAIT_L(n) asm volatile("s_waitcnt lgkmcnt(" #n ")" ::: "memory")
#define PG8_BAR __builtin_amdgcn_s_barrier()
#define PG8_SCHED __builtin_amdgcn_sched_barrier(0)
    Unit cur, nxt; int ui = 0;
    if (!S.next(0, cur)) return;
    f32x4 acc[2][2][4][2];
#pragma unroll
    for (int a = 0; a < 2; ++a)
#pragma unroll
        for (int b = 0; b < 2; ++b)
#pragma unroll
            for (int m = 0; m < 4; ++m)
#pragma unroll
                for (int n = 0; n < 2; ++n) acc[a][b][m][n] = (f32x4){0.f, 0.f, 0.f, 0.f};
    bf16x8 At[4][2], B0[2][2], B1[2][2];
    const char* cA = (const char*)g.A + (size_t)cur.pm * tstepA; const char* cB = (const char*)g.Bt + (size_t)cur.pn * tstepB;
    PG8_STAGE(PG8_SB(0, 0), cB, voffB); PG8_STAGE(PG8_SB(0, 1), cB + hstepB, voffB); PG8_STAGE(PG8_SA(0, 0), cA, voffA); PG8_STAGE(PG8_SA(0, 1), cA + hstepA, voffA);
    if (wr == 1) PG8_BAR;
    PG8_WAIT_V(2); PG8_BAR;
    PG8_STAGE(PG8_SB(1, 0), cB + kstep, voffB); PG8_STAGE(PG8_SA(1, 0), cA + kstep, voffA); PG8_STAGE(PG8_SB(1, 1), cB + hstepB + kstep, voffB);
    PG8_WAIT_V(6); PG8_BAR;
    for (;;) {
        const bool has_next = S.next(ui + 1, nxt);
        const char* nA = has_next ? (const char*)g.A + (size_t)nxt.pm * tstepA : cA; const char* nB = has_next ? (const char*)g.Bt + (size_t)nxt.pn * tstepB : cB;
        for (int t = 0; t < nt; t += 2) {
            const bool last = (t == nt - 2);
            const char* a1 = cA + (size_t)(t + 1) * kstep;
            const char* a2 = last ? nA : cA + (size_t)(t + 2) * kstep; const char* b2 = last ? nB : cB + (size_t)(t + 2) * kstep;
            const char* a3 = a2 + kstep; const char* b3 = b2 + kstep;
            if constexpr (Epi::MID) { if (t == (nt >> 1)) E.mid(acc, cur, wr, lane_id_v() & 15); }
            PG8_LDB(B0, 0, 0); PG8_LDB(B1, 0, 1); PG8_SCHED; PG8_LDA(At, 0, 0); PG8_STAGE(PG8_SA(1, 1), a1 + hstepA, voffA);
            PG8_WAIT_V(8); PG8_WAIT_L(0); PG8_BAR; PG8_MMA(0, 0, At, B0); PG8_MMA(0, 1, At, B1); PG8_BAR; PG8_SCHED;
            PG8_LDA(At, 0, 1); PG8_STAGE(PG8_SB(0, 0), b2, voffB); PG8_STAGE(PG8_SB(0, 1), b2 + hstepB, voffB); PG8_STAGE(PG8_SA(0, 0), a2, voffA);
            PG8_WAIT_V(8); PG8_WAIT_L(0); PG8_BAR; PG8_MMA(1, 0, At, B0); PG8_MMA(1, 1, At, B1); PG8_BAR; PG8_SCHED;
            PG8_LDB(B0, 1, 0); PG8_LDB(B1, 1, 1); PG8_SCHED; PG8_LDA(At, 1, 0); PG8_STAGE(PG8_SA(0, 1), a2 + hstepA, voffA);
            PG8_WAIT_V(8); PG8_WAIT_L(0); PG8_BAR; PG8_MMA(0, 0, At, B0); PG8_MMA(0, 1, At, B1); PG8_BAR; PG8_SCHED;
            PG8_LDA(At, 1, 1); PG8_STAGE(PG8_SB(1, 0), b3, voffB); PG8_STAGE(PG8_SB(1, 1), b3 + hstepB, voffB); PG8_STAGE(PG8_SA(1, 0), a3, voffA);
            PG8_WAIT_V(8); PG8_WAIT_L(0); PG8_BAR; PG8_MMA(1, 0, At, B0); PG8_MMA(1, 1, At, B1); PG8_BAR; PG8_SCHED;
        }
        if (wr == 0) PG8_BAR;
        { const int l_e = lane_id_v(); E(acc, cur, wr, wc, l_e & 15, l_e >> 4); }
        if (!has_next) break;
#pragma unroll
        for (int a = 0; a < 2; ++a)
#pragma unroll
            for (int b = 0; b < 2; ++b)
#pragma unroll
                for (int m = 0; m < 4; ++m)
#pragma unroll
                    for (int n = 0; n < 2; ++n) acc[a][b][m][n] = (f32x4){0.f, 0.f, 0.f, 0.f};
        cur = nxt; cA = nA; cB = nB; ++ui;
        if (wr == 1) PG8_BAR;
    }
    PG8_WAIT_V(0);
    PG8_BAR;
#undef PG8_SA
#undef PG8_SB
#undef PG8_STAGE
#undef PG8_LDA
#undef PG8_LDB
#undef PG8_MMA
#undef PG8_WAIT_V
#undef PG8_WAIT_L
#undef PG8_BAR
#undef PG8_SCHED
}
}
using pg8::Unit;
typedef f32x4 AccT[2][2][4][2];
#define EPI_ROW(u, ai, m) ((u).pm * 256 + (ai) * 128 + wr * 64 + (m) * 16 + fr)
#define EPI_LCOL(bj) ((bj) * 128 + wc * 32 + 8 * fq)

struct EpiStore {
    static constexpr bool MID = false;
    bf16_t* O; int ldc; int silu_pn;
    __device__ __forceinline__ void operator()(const AccT& acc, const Unit& u, int wr, int wc, int fr, int fq) const {
        const bool act = u.pn >= silu_pn;
#pragma unroll
        for (int ai = 0; ai < 2; ++ai)
#pragma unroll
            for (int m = 0; m < 4; ++m) { bf16_t* rowp = O + (size_t)EPI_ROW(u, ai, m) * ldc + u.pn * 256;
#pragma unroll
                for (int bj = 0; bj < 2; ++bj) { f32x4 v0 = acc[ai][bj][m][0], v1 = acc[ai][bj][m][1];
                    if (act) {
#pragma unroll
                        for (int e = 0; e < 4; ++e) { v0[e] = siluf(v0[e]); v1[e] = siluf(v1[e]); } }
                    *(u32x4*)(rowp + EPI_LCOL(bj)) = pack8(v0, v1); }
                asm volatile("" ::: "memory"); }
    }
};
template <bool MIDSCALE, bool RESBF> struct EpiOut {
    static constexpr bool MID = MIDSCALE;
    const void* res; bf16_t* Ub; f32x2* part; const float* ssqC;
    __device__ __forceinline__ void mid(AccT& acc, const Unit& u, int wr, int fr) const {
#pragma unroll
        for (int ai = 0; ai < 2; ++ai)
#pragma unroll
            for (int m = 0; m < 4; ++m) { const int row = EPI_ROW(u, ai, m); const f32x4 a = *(const f32x4*)(ssqC + (size_t)row * 8), b = *(const f32x4*)(ssqC + (size_t)row * 8 + 4);
                const float s = ((a[0] + a[1]) + (a[2] + a[3])) + ((b[0] + b[1]) + (b[2] + b[3])); const float rc = rsqrtf(s * (1.f / 512.f) + EPS);
#pragma unroll
                for (int bj = 0; bj < 2; ++bj)
#pragma unroll
                    for (int n = 0; n < 2; ++n) acc[ai][bj][m][n] *= rc; }
    }
    __device__ __forceinline__ void operator()(const AccT& acc, const Unit& u, int wr, int wc, int fr, int fq) const {
#pragma unroll
        for (int ai = 0; ai < 2; ++ai)
#pragma unroll
            for (int m = 0; m < 4; ++m) { const int row = EPI_ROW(u, ai, m); const size_t off = (size_t)row * DM + u.pn * 256; float s = 0.f, q = 0.f;
#pragma unroll
                for (int bj = 0; bj < 2; ++bj) { const size_t o = off + EPI_LCOL(bj); f32x4 r0, r1;
                    if constexpr (RESBF) { const u32x4 rw = *(const u32x4*)((const bf16_t*)res + o); r0 = (f32x4){bflo(rw.x), bfhi(rw.x), bflo(rw.y), bfhi(rw.y)}; r1 = (f32x4){bflo(rw.z), bfhi(rw.z), bflo(rw.w), bfhi(rw.w)}; }
                    else { r0 = *(const f32x4*)((const float*)res + o); r1 = *(const f32x4*)((const float*)res + o + 4); }
                    const f32x4 u0 = r0 * DN_ALPHA + acc[ai][bj][m][0], u1 = r1 * DN_ALPHA + acc[ai][bj][m][1];
                    *(u32x4*)(Ub + o) = pack8(u0, u1);
                    s += ((u0[0] + u0[1]) + (u0[2] + u0[3])) + ((u1[0] + u1[1]) + (u1[2] + u1[3]));
                    q += ((u0[0] * u0[0] + u0[1] * u0[1]) + (u0[2] * u0[2] + u0[3] * u0[3])) + ((u1[0] * u1[0] + u1[1] * u1[1]) + (u1[2] * u1[2] + u1[3] * u1[3])); }
                s += swz_xor<16>(s); s = xor32_add(s); q += swz_xor<16>(q); q = xor32_add(q);
                if (fq == 0) part[(size_t)row * 16 + u.pn * 4 + wc] = (f32x2){s, q};
                asm volatile("" ::: "memory"); }
    }
};
struct EpiGate {
    static constexpr bool MID = false;
    const bf16_t* Ub; const f32x2* mr; const float* lng; const float* lnb; const float* G1; const float* G0; const bf16_t* pp; float* out; bf16_t* xb;
    __device__ __forceinline__ void operator()(const AccT& acc, const Unit& u, int wr, int wc, int fr, int fq) const {
#pragma unroll
        for (int bj = 0; bj < 2; ++bj) { const int col = u.pn * 256 + EPI_LCOL(bj);
            f32x4 g[2], b[2], g1[2], g0[2];
#pragma unroll
            for (int n = 0; n < 2; ++n) { g[n] = *(const f32x4*)(lng + col + 4 * n); b[n] = *(const f32x4*)(lnb + col + 4 * n); g1[n] = *(const f32x4*)(G1 + col + 4 * n); g0[n] = *(const f32x4*)(G0 + col + 4 * n); }
#pragma unroll
            for (int ai = 0; ai < 2; ++ai)
#pragma unroll
                for (int m = 0; m < 4; ++m) { const int rl = ai * 128 + wr * 64 + m * 16 + fr; const f32x2 st = mr[u.idx * 256 + rl]; const size_t o = (size_t)(u.pm * 256 + rl) * DM + col;
                    const u32x4 pw = *(const u32x4*)(pp + o), uw = *(const u32x4*)(Ub + o); f32x4 ov[2];
                    const float ppv[8] = {bflo(pw.x), bfhi(pw.x), bflo(pw.y), bfhi(pw.y), bflo(pw.z), bfhi(pw.z), bflo(pw.w), bfhi(pw.w)};
                    const float uv[8] = {bflo(uw.x), bfhi(uw.x), bflo(uw.y), bfhi(uw.y), bflo(uw.z), bfhi(uw.z), bflo(uw.w), bfhi(uw.w)};
#pragma unroll
                    for (int n = 0; n < 2; ++n) {
#pragma unroll
                        for (int e = 0; e < 4; ++e) { const float h = (uv[4 * n + e] - st.x) * st.y * g[n][e] + b[n][e]; const float t = st.y * (acc[ai][bj][m][n][e] - st.x * g1[n][e]) + g0[n][e];
                            ov[n][e] = h + sigm(t) * ppv[4 * n + e]; } }
                    if (out) { __builtin_nontemporal_store(ov[0], (f32x4*)(out + o)); __builtin_nontemporal_store(ov[1], (f32x4*)(out + o + 4)); }
                    if (xb) *(u32x4*)(xb + o) = pack8(ov[0], ov[1]);
                    asm volatile("" ::: "memory"); } }
    }
};
struct EpiH1 {
    static constexpr bool MID = false;
    bf16_t* H1; float* statQ; float* statKV; f32x2* statV; const f32x2* cs; bf16_t* Kb;
    __device__ __forceinline__ void operator()(const AccT& acc, const Unit& u, int wr, int wc, int fr, int fq) const {
        const int pn = u.pn;
#pragma unroll
        for (int ai = 0; ai < 2; ++ai)
#pragma unroll
            for (int m = 0; m < 4; ++m) { const int row = EPI_ROW(u, ai, m); bf16_t* rowp = H1 + (size_t)row * OD_IN + pn * 256;
                if (pn == 0) { float q = 0.f;
#pragma unroll
                    for (int bj = 0; bj < 2; ++bj) { const f32x4 v0 = acc[ai][bj][m][0], v1 = acc[ai][bj][m][1]; *(u32x4*)(rowp + EPI_LCOL(bj)) = pack8(v0, v1);
                        q += ((v0[0] * v0[0] + v0[1] * v0[1]) + (v0[2] * v0[2] + v0[3] * v0[3])) + ((v1[0] * v1[0] + v1[1] * v1[1]) + (v1[2] * v1[2] + v1[3] * v1[3])); }
                    q += swz_xor<16>(q); q = xor32_add(q); if (fq == 0) statQ[(size_t)row * 4 + wc] = q;
                } else if (pn == 1) {
                    { const f32x4 v0 = acc[ai][0][m][0], v1 = acc[ai][0][m][1]; *(u32x4*)(rowp + EPI_LCOL(0)) = pack8(v0, v1);
                      float q = ((v0[0] * v0[0] + v0[1] * v0[1]) + (v0[2] * v0[2] + v0[3] * v0[3])) + ((v1[0] * v1[0] + v1[1] * v1[1]) + (v1[2] * v1[2] + v1[3] * v1[3]));
                      q += swz_xor<16>(q); q = xor32_add(q); if (fq == 0) statKV[(size_t)row * 4 + wc] = q; }
                    if (wc == 0) { const f32x4 v0 = acc[ai][1][m][0], v1 = acc[ai][1][m][1]; const float x[8] = {v0[0], v0[1], v0[2], v0[3], v1[0], v1[1], v1[2], v1[3]};
                        const f32x4 c01 = *(const f32x4*)(cs + (size_t)row * 16 + 4 * fq), c23 = *(const f32x4*)(cs + (size_t)row * 16 + 4 * fq + 2);
                        const float cc[4] = {c01[0], c01[2], c23[0], c23[2]}, ss[4] = {c01[1], c01[3], c23[1], c23[3]}; float o[8];
#pragma unroll
                        for (int e = 0; e < 4; ++e) { o[2 * e] = x[2 * e] * cc[e] - x[2 * e + 1] * ss[e]; o[2 * e + 1] = x[2 * e] * ss[e] + x[2 * e + 1] * cc[e]; }
                        u32x4 w; w.x = cvt_pk_bf16(o[0], o[1]); w.y = cvt_pk_bf16(o[2], o[3]); w.z = cvt_pk_bf16(o[4], o[5]); w.w = cvt_pk_bf16(o[6], o[7]);
                        const int b = row >> 12, s = row & 4095;
#pragma unroll
                        for (int h = 0; h < 8; ++h) *(u32x4*)(Kb + ((size_t)(b * 8 + h) * SEQ + s) * 96 + 64 + 8 * fq) = w; }
                } else if (pn < 6) { float s = 0.f, q = 0.f;
#pragma unroll
                    for (int bj = 0; bj < 2; ++bj) { f32x4 v0 = acc[ai][bj][m][0], v1 = acc[ai][bj][m][1];
#pragma unroll
                        for (int e = 0; e < 4; ++e) { v0[e] = geluf(v0[e]); v1[e] = geluf(v1[e]); }
                        *(u32x4*)(rowp + EPI_LCOL(bj)) = pack8(v0, v1);
                        s += ((v0[0] + v0[1]) + (v0[2] + v0[3])) + ((v1[0] + v1[1]) + (v1[2] + v1[3]));
                        q += ((v0[0] * v0[0] + v0[1] * v0[1]) + (v0[2] * v0[2] + v0[3] * v0[3])) + ((v1[0] * v1[0] + v1[1] * v1[1]) + (v1[2] * v1[2] + v1[3] * v1[3])); }
                    if (pn >= 4) { s += swz_xor<16>(s); s = xor32_add(s); q += swz_xor<16>(q); q = xor32_add(q);
                        if (fq == 0) statV[(size_t)row * 8 + (pn - 4) * 4 + wc] = (f32x2){s, q}; }
                } else {
#pragma unroll
                    for (int bj = 0; bj < 2; ++bj) *(u32x4*)(rowp + EPI_LCOL(bj)) = pack8(acc[ai][bj][m][0], acc[ai][bj][m][1]); }
                asm volatile("" ::: "memory"); }
    }
};
struct EpiQ {
    static constexpr bool MID = false;
    const float* statQ; const f32x2* cs; bf16_t* Qb;
    __device__ __forceinline__ void operator()(const AccT& acc, const Unit& u, int wr, int wc, int fr, int fq) const {
#pragma unroll
        for (int ai = 0; ai < 2; ++ai)
#pragma unroll
            for (int m = 0; m < 4; ++m) { const int row = EPI_ROW(u, ai, m); const f32x4 sq = *(const f32x4*)(statQ + (size_t)row * 4);
                const float rq = rsqrtf(((sq[0] + sq[1]) + (sq[2] + sq[3])) * (1.f / 256.f) + EPS); const int b = row >> 12, s = row & 4095;
#pragma unroll
                for (int bj = 0; bj < 2; ++bj) { const int col = u.pn * 256 + EPI_LCOL(bj), h = col / 96, j = col - h * 96;
                    const f32x4 v0 = acc[ai][bj][m][0] * rq, v1 = acc[ai][bj][m][1] * rq; u32x4 w;
                    if (j >= 64) { const int i0 = (j - 64) >> 1; const float x[8] = {v0[0], v0[1], v0[2], v0[3], v1[0], v1[1], v1[2], v1[3]};
                        const f32x4 c01 = *(const f32x4*)(cs + (size_t)row * 16 + i0), c23 = *(const f32x4*)(cs + (size_t)row * 16 + i0 + 2);
                        const float cc[4] = {c01[0], c01[2], c23[0], c23[2]}, ss[4] = {c01[1], c01[3], c23[1], c23[3]}; float o[8];
#pragma unroll
                        for (int e = 0; e < 4; ++e) { o[2 * e] = x[2 * e] * cc[e] - x[2 * e + 1] * ss[e]; o[2 * e + 1] = x[2 * e] * ss[e] + x[2 * e + 1] * cc[e]; }
                        w.x = cvt_pk_bf16(o[0], o[1]); w.y = cvt_pk_bf16(o[2], o[3]); w.z = cvt_pk_bf16(o[4], o[5]); w.w = cvt_pk_bf16(o[6], o[7]);
                    } else w = pack8(v0, v1);
                    *(u32x4*)(Qb + ((size_t)(b * 8 + h) * SEQ + s) * 96 + j) = w; }
                asm volatile("" ::: "memory"); }
    }
};
struct EpiK {
    static constexpr bool MID = false;
    const float* statKV; bf16_t* Kb;
    __device__ __forceinline__ void operator()(const AccT& acc, const Unit& u, int wr, int wc, int fr, int fq) const {
#pragma unroll
        for (int ai = 0; ai < 2; ++ai)
#pragma unroll
            for (int m = 0; m < 4; ++m) { const int row = EPI_ROW(u, ai, m); const f32x4 sq = *(const f32x4*)(statKV + (size_t)row * 4);
                const float rk = rsqrtf(((sq[0] + sq[1]) + (sq[2] + sq[3])) * (1.f / 128.f) + EPS); const int b = row >> 12, s = row & 4095;
#pragma unroll
                for (int bj = 0; bj < 2; ++bj) { const int col = u.pn * 256 + EPI_LCOL(bj), h = col >> 6, j = col & 63;
                    *(u32x4*)(Kb + ((size_t)(b * 8 + h) * SEQ + s) * 96 + j) = pack8(acc[ai][bj][m][0] * rk, acc[ai][bj][m][1] * rk); }
                asm volatile("" ::: "memory"); }
    }
};
struct EpiVT {
    static constexpr bool MID = false;
    const float* statKV; bf16_t* Vt;
    __device__ __forceinline__ void operator()(const AccT& acc, const Unit& u, int wr, int wc, int fr, int fq) const {
#pragma unroll
        for (int bj = 0; bj < 2; ++bj) { const int tok = u.pn * 256 + EPI_LCOL(bj), b = tok >> 12, s = tok & 4095; float rk[8];
#pragma unroll
            for (int e = 0; e < 8; ++e) { const f32x4 sq = *(const f32x4*)(statKV + (size_t)(tok + e) * 4); rk[e] = rsqrtf(((sq[0] + sq[1]) + (sq[2] + sq[3])) * (1.f / 128.f) + EPS); }
#pragma unroll
            for (int ai = 0; ai < 2; ++ai)
#pragma unroll
                for (int m = 0; m < 4; ++m) { const int hd = EPI_ROW(u, ai, m); f32x4 v0 = acc[ai][bj][m][0], v1 = acc[ai][bj][m][1];
#pragma unroll
                    for (int e = 0; e < 4; ++e) { v0[e] *= rk[e]; v1[e] *= rk[4 + e]; }
                    *(u32x4*)(Vt + ((size_t)b * 512 + hd) * SEQ + s) = pack8(v0, v1);
                    asm volatile("" ::: "memory"); } }
    }
};

__device__ __forceinline__ int colmap(int map, int n) {
    switch (map) {
    case 1: { if (n < 384) return n; if (n < 416) { const int j = n - 384, i = j >> 1; return 384 + ((j & 1) ? i + 16 : i); } if (n < 512) return -1; if (n < 1024) return 416 + (n - 512); if (n < 1536) return 928 + (n - 1024); return 1440 + (n - 1536); }
    case 2: { const int h = n / 96, j = n - h * 96; if (j < 64) return n; const int jj = j - 64, i = jj >> 1; return h * 96 + 64 + ((jj & 1) ? i + 16 : i); }
    case 3: return (n >> 6) * 128 + (n & 63);
    case 4: return (n >> 6) * 128 + 64 + (n & 63);
    default: return n;
    }
}
__device__ __forceinline__ void conv_w(const float* W, bf16_t* WT, int K, int Nsrc, int Ndst, int map, const float* rs, const float* rs2, float cscale, int cs_upto, int gt, int GT) {
    const int nitem = Ndst * (K >> 3);
    const int nb8 = Ndst >> 3;
    for (int it = gt; it < nitem; it += GT) { const int rest = it >> 6, n = (rest % nb8) * 8 + ((it >> 3) & 7), k0 = ((rest / nb8) * 8 + (it & 7)) * 8; const int src = colmap(map, n); const float cs = (n < cs_upto) ? cscale : 1.f; float v[8];
#pragma unroll
        for (int e = 0; e < 8; ++e) { const int k = k0 + e; float w = (src >= 0) ? W[(size_t)k * Nsrc + src] : 0.f; if (rs) w *= (rs2 && k >= 512) ? rs2[k - 512] : rs[k]; v[e] = w * cs; }
        u32x4 o; o.x = cvt_pk_bf16(v[0], v[1]); o.y = cvt_pk_bf16(v[2], v[3]); o.z = cvt_pk_bf16(v[4], v[5]); o.w = cvt_pk_bf16(v[6], v[7]);
        *(u32x4*)(WT + (size_t)n * K + k0) = o; }
}
__device__ __forceinline__ void conv_flat(const float* src, bf16_t* dst, size_t n8, int gt, int GT) {
    size_t i = gt;
    for (; i + 3 * (size_t)GT < n8; i += 4 * (size_t)GT) { f32x4 a[4], b[4];
#pragma unroll
        for (int j = 0; j < 4; ++j) { a[j] = __builtin_nontemporal_load((const f32x4*)(src + (i + j * (size_t)GT) * 8)); b[j] = __builtin_nontemporal_load((const f32x4*)(src + (i + j * (size_t)GT) * 8 + 4)); }
#pragma unroll
        for (int j = 0; j < 4; ++j) *(u32x4*)(dst + (i + j * (size_t)GT) * 8) = pack8(a[j], b[j]); }
    for (; i < n8; i += GT) { const f32x4 a = *(const f32x4*)(src + i * 8), b = *(const f32x4*)(src + i * 8 + 4); *(u32x4*)(dst + i * 8) = pack8(a, b); }
}

struct Args { const void* in[25]; float* out; unsigned char* ws; };

__device__ __forceinline__ int kappa(int r) { return (r & ~12) | ((r & 4) << 1) | ((r & 8) >> 1); }
constexpr int EK_ROW = 72, EK_BUF = 64 * EK_ROW * 2, EV_STAGE = 4 * EK_BUF + 256;
__device__ __forceinline__ void even_item(int wsg, unsigned char* lds, const bf16_t* H0, const int* pos, const float* sink, const float* convw, bf16_t* Y0, int b, int q0) {
    int tid_ = tid_from(wsg); asm volatile("" : "+v"(tid_));
    const int tid = tid_, lane = tid & 63, wid = tid >> 6, r32 = lane & 31, hi = lane >> 5;
    const int h = wid, kvh = h >> 2;
    const size_t tb = (size_t)b * SEQ;
    bf16x8 qf[2][4]; float posq[2];
#pragma unroll
    for (int qb = 0; qb < 2; ++qb) { const size_t t = tb + q0 + 32 * qb + r32; posq[qb] = (float)pos[t];
#pragma unroll
        for (int ks = 0; ks < 4; ++ks) qf[qb][ks] = *(const bf16x8*)(H0 + t * EV_IN + h * 64 + 16 * ks + 8 * hi); }
    const float slope2 = exp2f(-(float)(h + 1)) * LOG2E, sink2 = sink[h] * LOG2E;
    f32x16 O[2][2]; float mrun[2], lrun[2];
#pragma unroll
    for (int qb = 0; qb < 2; ++qb) { mrun[qb] = sink2; lrun[qb] = (hi == 0) ? 1.f : 0.f; O[qb][0] = (f32x16){}; O[qb][1] = (f32x16){}; }
    u32x4 gk[2], gv[2]; float gp = 0.f;
#define EV_ISSUE(j_) do { const int kbase_ = q0 - 128 + 64 * (j_); \
        _Pragma("unroll") for (int i = 0; i < 2; ++i) { const int c = tid + i * 512; \
            { const int key = (c >> 3) & 63, ch = c & 7, kg = min(max(kbase_ + key, 0), SEQ - 1); gk[i] = *(const u32x4*)(H0 + (tb + kg) * EV_IN + 512 + i * 64 + ch * 8); } \
            { const int key = c & 63, ch = (c >> 6) & 7, kg = min(max(kbase_ + key, 0), SEQ - 1); gv[i] = *(const u32x4*)(H0 + (tb + kg) * EV_IN + 640 + i * 64 + ch * 8); } } \
        { const int kg = min(max(kbase_ + (tid & 63), 0), SEQ - 1); gp = (float)pos[tb + kg]; } } while (0)
#define EV_COMMIT(p_) do { unsigned char* base_ = lds + (p_) * EV_STAGE; \
        _Pragma("unroll") for (int i = 0; i < 2; ++i) { const int c = tid + i * 512; \
            { const int key = (c >> 3) & 63, ch = c & 7; *(u32x4*)(base_ + i * EK_BUF + (key * EK_ROW + ch * 8) * 2) = gk[i]; } \
            { const int key = c & 63, ch = (c >> 6) & 7; const u32x4 v = gv[i]; bf16_t* vt = (bf16_t*)(base_ + 2 * EK_BUF + i * EK_BUF) + (ch * 8) * EK_ROW + key; \
              vt[0 * EK_ROW] = (bf16_t)(v.x & 0xffffu); vt[1 * EK_ROW] = (bf16_t)(v.x >> 16); vt[2 * EK_ROW] = (bf16_t)(v.y & 0xffffu); vt[3 * EK_ROW] = (bf16_t)(v.y >> 16); \
              vt[4 * EK_ROW] = (bf16_t)(v.z & 0xffffu); vt[5 * EK_ROW] = (bf16_t)(v.z >> 16); vt[6 * EK_ROW] = (bf16_t)(v.w & 0xffffu); vt[7 * EK_ROW] = (bf16_t)(v.w >> 16); } } \
        ((float*)(base_ + 4 * EK_BUF))[tid & 63] = gp; } while (0)
    __syncthreads();
    EV_ISSUE(0); EV_COMMIT(0);
    __syncthreads();
#pragma unroll 1
    for (int j = 0; j < 5; ++j) {
        const int kbase = q0 - 128 + 64 * j; const int pbuf = j & 1;
        if (j + 1 < 5) EV_ISSUE(j + 1);
        const unsigned char* KLp = lds + pbuf * EV_STAGE; const unsigned char* VTp = KLp + 2 * EK_BUF; const float* posK = (const float*)(KLp + 4 * EK_BUF);
        const unsigned char* kb = KLp + kvh * EK_BUF; const unsigned char* vb = VTp + kvh * EK_BUF;
        f32x16 S[2][2];
#pragma unroll
        for (int rb = 0; rb < 2; ++rb) { bf16x8 kf[4];
#pragma unroll
            for (int ks = 0; ks < 4; ++ks) kf[ks] = *(const bf16x8*)(kb + ((kappa(r32) + 32 * rb) * EK_ROW + 16 * ks + 8 * hi) * 2);
#pragma unroll
            for (int qb = 0; qb < 2; ++qb) { f32x16 a = (f32x16){};
#pragma unroll
                for (int ks = 0; ks < 4; ++ks) a = __builtin_amdgcn_mfma_f32_32x32x16_bf16(kf[ks], qf[qb][ks], a, 0, 0, 0);
                S[qb][rb] = a; } }
#pragma unroll
        for (int qb = 0; qb < 2; ++qb) { const int qg = q0 + 32 * qb + r32; float mx = -1e30f;
            const int lo = max(-kbase, qg - 128 - kbase) - 8 * hi; const unsigned span = (unsigned)(min(SEQ - 1 - kbase, qg + 128 - kbase) - 8 * hi - lo);
            const float* pk_ = posK + 8 * hi;
#pragma unroll
            for (int rb = 0; rb < 2; ++rb)
#pragma unroll
                for (int r = 0; r < 16; ++r) { const int c = 32 * rb + (r & 7) + 16 * (r >> 3);
                    const bool valid = (unsigned)(c - lo) <= span;
                    const float sv = valid ? (S[qb][rb][r] - slope2 * fabsf(posq[qb] - pk_[c])) : -1e30f; S[qb][rb][r] = sv; mx = fmaxf(mx, sv); }
            mx = xor32_max(mx);
            const float mnew = fmaxf(mrun[qb], mx), alpha = __builtin_amdgcn_exp2f(mrun[qb] - mnew); mrun[qb] = mnew; float ps = 0.f;
#pragma unroll
            for (int rb = 0; rb < 2; ++rb)
#pragma unroll
                for (int r = 0; r < 16; ++r) { const float p = __builtin_amdgcn_exp2f(S[qb][rb][r] - mnew); S[qb][rb][r] = p; ps += p; }
            lrun[qb] = lrun[qb] * alpha + ps;
#pragma unroll
            for (int db = 0; db < 2; ++db) O[qb][db] *= alpha; }
#pragma unroll
        for (int mm = 0; mm < 4; ++mm) { bf16x8 pf[2];
#pragma unroll
            for (int qb = 0; qb < 2; ++qb) { const f32x16& s = S[qb][mm >> 1]; const int o = 8 * (mm & 1); u32x4 w;
                w.x = cvt_pk_bf16(s[o + 0], s[o + 1]); w.y = cvt_pk_bf16(s[o + 2], s[o + 3]); w.z = cvt_pk_bf16(s[o + 4], s[o + 5]); w.w = cvt_pk_bf16(s[o + 6], s[o + 7]); pf[qb] = __builtin_bit_cast(bf16x8, w); }
#pragma unroll
            for (int db = 0; db < 2; ++db) { const bf16x8 vf = *(const bf16x8*)(vb + ((32 * db + r32) * EK_ROW + 16 * mm + 8 * hi) * 2);
#pragma unroll
                for (int qb = 0; qb < 2; ++qb) O[qb][db] = __builtin_amdgcn_mfma_f32_32x32x16_bf16(vf, pf[qb], O[qb][db], 0, 0, 0); } }
        if (j + 1 < 5) EV_COMMIT(pbuf ^ 1);
        __syncthreads();
    }
#undef EV_ISSUE
#undef EV_COMMIT
    float* ssq = (float*)lds;
#pragma unroll
    for (int qb = 0; qb < 2; ++qb) { float l = lrun[qb]; l = xor32_add(l); const float il = 1.f / l; float q = 0.f;
#pragma unroll
        for (int db = 0; db < 2; ++db) { O[qb][db] *= il;
#pragma unroll
            for (int r = 0; r < 16; ++r) q += O[qb][db][r] * O[qb][db][r]; }
        q = xor32_add(q); if (hi == 0) ssq[h * 64 + 32 * qb + r32] = q; }
    __syncthreads();
#pragma unroll
    for (int qb = 0; qb < 2; ++qb) { float s = 0.f;
#pragma unroll
        for (int hh = 0; hh < 8; ++hh) s += ssq[hh * 64 + 32 * qb + r32];
        const float ra = rsqrtf(s * (1.f / 512.f) + EPS); const size_t t = tb + q0 + 32 * qb + r32;
#pragma unroll
        for (int kp = 0; kp < 4; ++kp) {
            const int db = kp >> 1, ga = (2 * kp) & 3, gb = ga + 1, c16 = 16 * kp + 8 * hi;
            u32x4 zq = *(const u32x4*)(H0 + t * EV_IN + 2304 + h * 64 + c16);
            unsigned z0 = zq.x, z1 = zq.y, z2 = zq.z, z3 = zq.w; swap32(z0, z2); swap32(z1, z3); zq = (u32x4){z0, z1, z2, z3};
            unsigned a0 = cvt_pk_bf16(O[qb][db][4 * ga + 0] * ra * siluf(bflo(zq.x)), O[qb][db][4 * ga + 1] * ra * siluf(bfhi(zq.x))), a1 = cvt_pk_bf16(O[qb][db][4 * ga + 2] * ra * siluf(bflo(zq.y)), O[qb][db][4 * ga + 3] * ra * siluf(bfhi(zq.y)));
            unsigned b0 = cvt_pk_bf16(O[qb][db][4 * gb + 0] * ra * siluf(bflo(zq.z)), O[qb][db][4 * gb + 1] * ra * siluf(bfhi(zq.z))), b1 = cvt_pk_bf16(O[qb][db][4 * gb + 2] * ra * siluf(bflo(zq.w)), O[qb][db][4 * gb + 3] * ra * siluf(bfhi(zq.w)));
            swap32(a0, b0); swap32(a1, b1);
            *(u32x4*)(Y0 + t * DM + h * 64 + c16) = (u32x4){a0, a1, b0, b1}; } }
    { const int c0 = lane * 8; float cw[3][8];
#pragma unroll
        for (int jj = 0; jj < 3; ++jj) { const f32x4 a = *(const f32x4*)(convw + jj * 512 + c0), bq = *(const f32x4*)(convw + jj * 512 + c0 + 4);
#pragma unroll
            for (int e = 0; e < 4; ++e) { cw[jj][e] = a[e]; cw[jj][4 + e] = bq[e]; } }
        const int t0 = q0 + wid * 8; float zp[8], zc[8], zn[8];
#define EV_Z(dst, tt) do { if ((tt) >= 0 && (tt) < SEQ) { const u32x4 cg_ = *(const u32x4*)(H0 + (tb + (tt)) * EV_IN + 1280 + c0), xi_ = *(const u32x4*)(H0 + (tb + (tt)) * EV_IN + 1792 + c0); \
            dst[0] = bflo(cg_.x) * bflo(xi_.x); dst[1] = bfhi(cg_.x) * bfhi(xi_.x); dst[2] = bflo(cg_.y) * bflo(xi_.y); dst[3] = bfhi(cg_.y) * bfhi(xi_.y); \
            dst[4] = bflo(cg_.z) * bflo(xi_.z); dst[5] = bfhi(cg_.z) * bfhi(xi_.z); dst[6] = bflo(cg_.w) * bflo(xi_.w); dst[7] = bfhi(cg_.w) * bfhi(xi_.w); } \
          else { _Pragma("unroll") for (int e_ = 0; e_ < 8; ++e_) dst[e_] = 0.f; } } while (0)
        EV_Z(zp, t0 - 1); EV_Z(zc, t0);
        for (int i = 0; i < 8; ++i) { const int t = t0 + i; EV_Z(zn, t + 1);
            const u32x4 bgw = *(const u32x4*)(H0 + (tb + t) * EV_IN + 768 + c0), zw = *(const u32x4*)(H0 + (tb + t) * EV_IN + 2304 + 512 + c0);
            const float bg[8] = {bflo(bgw.x), bfhi(bgw.x), bflo(bgw.y), bfhi(bgw.y), bflo(bgw.z), bfhi(bgw.z), bflo(bgw.w), bfhi(bgw.w)};
            const float zz[8] = {siluf(bflo(zw.x)), siluf(bfhi(zw.x)), siluf(bflo(zw.y)), siluf(bfhi(zw.y)), siluf(bflo(zw.z)), siluf(bfhi(zw.z)), siluf(bflo(zw.w)), siluf(bfhi(zw.w))};
            float y[8], q = 0.f;
#pragma unroll
            for (int e = 0; e < 8; ++e) { y[e] = bg[e] * (cw[0][e] * zp[e] + cw[1][e] * zc[e] + cw[2][e] * zn[e]); q += y[e] * y[e]; }
            q += swz_xor<1>(q); q += swz_xor<2>(q); q += swz_xor<4>(q); q += swz_xor<8>(q); q += swz_xor<16>(q); q = xor32_add(q);
            const float rb = rsqrtf(q * (1.f / 512.f) + EPS); u32x4 w;
            w.x = cvt_pk_bf16(y[0] * rb * zz[0], y[1] * rb * zz[1]); w.y = cvt_pk_bf16(y[2] * rb * zz[2], y[3] * rb * zz[3]);
            w.z = cvt_pk_bf16(y[4] * rb * zz[4], y[5] * rb * zz[5]); w.w = cvt_pk_bf16(y[6] * rb * zz[6], y[7] * rb * zz[7]);
            *(u32x4*)(Y0 + (tb + t) * DM + 512 + c0) = w;
#pragma unroll
            for (int e = 0; e < 8; ++e) { zp[e] = zc[e]; zc[e] = zn[e]; } }
#undef EV_Z
    }
}

constexpr int GV_ROW = 136, GV_BUF = 128 * GV_ROW * 2;
__device__ __forceinline__ void gmlp_item(int wsg, unsigned char* lds, const bf16_t* H1, const f32x2* statV, const float* lng, const float* lnb, const bf16_t* WSb, const float* bs, bf16_t* Y1, int chunk) {
    int tid_ = tid_from(wsg); asm volatile("" : "+v"(tid_));
    const int tid = tid_, lane = tid & 63, wid = tid >> 6, fr = lane & 15, fq = lane >> 4;
    f32x2* mr = (f32x2*)(lds + 2 * GV_BUF);
    const size_t row0 = (size_t)chunk * 128;
    __syncthreads();
    if (tid < 128) { const f32x2* p = statV + (row0 + tid) * 8; float s = 0.f, q = 0.f;
#pragma unroll
        for (int i = 0; i < 8; ++i) { const f32x2 v = p[i]; s += v.x; q += v.y; }
        const float mean = s * (1.f / 512.f), var = q * (1.f / 512.f) - mean * mean; mr[tid] = (f32x2){mean, rsqrtf(fmaxf(var, 0.f) + EPS)}; }
    const int st_s = (tid >> 2) & 127, st_cl = tid & 3;
    u32x4 gst[4];
#define GM_ISSUE(g_) do { _Pragma("unroll") for (int i = 0; i < 4; ++i) gst[i] = *(const u32x4*)(H1 + (row0 + st_s) * OD_IN + 1024 + (g_) * 128 + (st_cl + 4 * i) * 8); } while (0)
#define GM_COMMIT(g_, buf_) do { bf16_t* VnT_ = (bf16_t*)(lds + (buf_) * GV_BUF); const f32x2 st = mr[st_s]; \
        _Pragma("unroll") for (int i = 0; i < 4; ++i) { const int ch = st_cl + 4 * i, cb = (g_) * 128 + ch * 8; const u32x4 v = gst[i]; \
            const f32x4 ga = *(const f32x4*)(lng + cb), gb = *(const f32x4*)(lng + cb + 4), ba = *(const f32x4*)(lnb + cb), bb = *(const f32x4*)(lnb + cb + 4); \
            const float x[8] = {bflo(v.x), bfhi(v.x), bflo(v.y), bfhi(v.y), bflo(v.z), bfhi(v.z), bflo(v.w), bfhi(v.w)}; \
            const float gg[8] = {ga[0], ga[1], ga[2], ga[3], gb[0], gb[1], gb[2], gb[3]}, bbv[8] = {ba[0], ba[1], ba[2], ba[3], bb[0], bb[1], bb[2], bb[3]}; \
            _Pragma("unroll") for (int e = 0; e < 8; ++e) VnT_[(ch * 8 + e) * GV_ROW + st_s] = f2bf((x[e] - st.x) * st.y * gg[e] + bbv[e]); } } while (0)
    unsigned ydp[4][8][2]; float q = 0.f;
    const size_t trow = row0 + 16 * wid + fr;
    GM_ISSUE(0);
    __syncthreads();
    GM_COMMIT(0, 0);
    __syncthreads();
#pragma unroll
    for (int g = 0; g < 4; ++g) {
        if (g < 3) GM_ISSUE(g + 1);
        const bf16_t* VnT = (const bf16_t*)(lds + (g & 1) * GV_BUF);
        bf16x8 wf[4];
#pragma unroll
        for (int ks = 0; ks < 4; ++ks) wf[ks] = *(const bf16x8*)(WSb + ((size_t)g * 128 + 16 * wid + fr) * 128 + 32 * ks + 8 * fq);
        const float bsv = bs[g * 128 + 16 * wid + fr];
#pragma unroll
        for (int nb = 0; nb < 8; ++nb) { f32x4 a = (f32x4){0.f, 0.f, 0.f, 0.f};
#pragma unroll
            for (int ks = 0; ks < 4; ++ks) { const bf16x8 vf = *(const bf16x8*)(VnT + (16 * nb + fr) * GV_ROW + 32 * ks + 8 * fq); a = __builtin_amdgcn_mfma_f32_16x16x32_bf16(vf, wf[ks], a, 0, 0, 0); }
            const int d = g * 128 + 16 * nb + 4 * fq; const u32x2 uw = *(const u32x2*)(H1 + trow * OD_IN + 512 + d);
            const float y0 = bflo(uw.x) * (a[0] + bsv), y1 = bfhi(uw.x) * (a[1] + bsv), y2 = bflo(uw.y) * (a[2] + bsv), y3 = bfhi(uw.y) * (a[3] + bsv);
            q += (y0 * y0 + y1 * y1) + (y2 * y2 + y3 * y3); ydp[g][nb][0] = cvt_pk_bf16(y0, y1); ydp[g][nb][1] = cvt_pk_bf16(y2, y3); }
        if (g < 3) GM_COMMIT(g + 1, (g + 1) & 1);
        __syncthreads();
        __builtin_amdgcn_sched_barrier(0);
    }
#undef GM_ISSUE
#undef GM_COMMIT
    q += swz_xor<16>(q); q = xor32_add(q);
    const float rd = rsqrtf(q * (1.f / 512.f) + EPS);
#pragma unroll
    for (int g = 0; g < 4; ++g)
#pragma unroll
        for (int nb = 0; nb < 8; ++nb) { const int d = g * 128 + 16 * nb + 4 * fq; const u32x2 zw = *(const u32x2*)(H1 + trow * OD_IN + 1536 + 512 + d); u32x2 w;
            w.x = cvt_pk_bf16(bflo(ydp[g][nb][0]) * rd * siluf(bflo(zw.x)), bfhi(ydp[g][nb][0]) * rd * siluf(bfhi(zw.x))); w.y = cvt_pk_bf16(bflo(ydp[g][nb][1]) * rd * siluf(bflo(zw.y)), bfhi(ydp[g][nb][1]) * rd * siluf(bfhi(zw.y)));
            *(u32x2*)(Y1 + trow * DM + 512 + d) = w; }
}

constexpr int MK_ROW = 104, MK_BUF = 64 * MK_ROW * 2, MV_ROW = 72, MV_BUF = 64 * MV_ROW * 2;
__device__ __forceinline__ void mla_unit(int wsg, unsigned char* lds, const bf16_t* Qb, const bf16_t* Kb, const bf16_t* Vt, const bf16_t* H1, bf16_t* Y1, float* ssqC, int bh, int qblk) {
    int tid_ = tid_from(wsg); asm volatile("" : "+v"(tid_));
    const int tid = tid_, lane = tid & 63, wid = tid >> 6, r32 = lane & 31, hi = lane >> 5;
    const int b = bh >> 3, h = bh & 7;
    const bf16_t* Kg = Kb + (size_t)bh * SEQ * 96; const bf16_t* Vg = Vt + (size_t)bh * 64 * SEQ;
    const int qrow0 = qblk * 512 + wid * 64;
    bf16x8 qf[2][6];
#pragma unroll
    for (int qb = 0; qb < 2; ++qb)
#pragma unroll
        for (int ks = 0; ks < 6; ++ks) qf[qb][ks] = *(const bf16x8*)(Qb + ((size_t)bh * SEQ + qrow0 + 32 * qb + r32) * 96 + 16 * ks + 8 * hi);
    f32x16 O[2][2]; float mrun[2], lrun[2];
#pragma unroll
    for (int qb = 0; qb < 2; ++qb) { mrun[qb] = -1e30f; lrun[qb] = 0.f; O[qb][0] = (f32x16){}; O[qb][1] = (f32x16){}; }
    const int kc0 = tid, kc1 = tid + 512; const int vc = (tid >= 256) ? tid - 256 : tid + 256;
    const int k0_key = kc0 / 12, k0_ch = kc0 - k0_key * 12, k1_key = kc1 / 12, k1_ch = kc1 - k1_key * 12;
    const unsigned k0_l = (k0_key * MK_ROW + k0_ch * 8) * 2, k1_l = (k1_key * MK_ROW + k1_ch * 8) * 2, v_l = ((vc >> 3) * MV_ROW + (vc & 7) * 8) * 2;
    const bf16_t* vsrc = Vg + (size_t)(vc >> 3) * SEQ + (vc & 7) * 8;
    u32x4 g0, g1, g2 = (u32x4){0u, 0u, 0u, 0u};
#define MLA_ISSUE(t) do { g0 = *(const u32x4*)(Kg + (size_t)(t) * 64 * 96 + kc0 * 8); if (tid < 256) { g1 = *(const u32x4*)(Kg + (size_t)(t) * 64 * 96 + kc1 * 8); g2 = *(const u32x4*)(vsrc + (t) * 64); } else { g1 = *(const u32x4*)(vsrc + (t) * 64); } } while (0)
#define MLA_COMMIT(p) do { unsigned char* kb_ = lds + (p) * MK_BUF; unsigned char* vb_ = lds + 2 * MK_BUF + (p) * MV_BUF; *(u32x4*)(kb_ + k0_l) = g0; \
        if (tid < 256) { *(u32x4*)(kb_ + k1_l) = g1; *(u32x4*)(vb_ + v_l) = g2; } else { *(u32x4*)(vb_ + v_l) = g1; } } while (0)
    __syncthreads();
    MLA_ISSUE(0); MLA_COMMIT(0);
    __syncthreads();
    const int krow = kappa(r32);
    for (int t = 0; t < 64; ++t) {
        const int p = t & 1;
        if (t + 1 < 64) MLA_ISSUE(t + 1);
        const unsigned char* kb = lds + p * MK_BUF; const unsigned char* vb = lds + 2 * MK_BUF + p * MV_BUF;
        f32x16 S[2][2];
#pragma unroll
        for (int rb = 0; rb < 2; ++rb) { bf16x8 kf[6];
#pragma unroll
            for (int ks = 0; ks < 6; ++ks) kf[ks] = *(const bf16x8*)(kb + ((krow + 32 * rb) * MK_ROW + 16 * ks + 8 * hi) * 2);
#pragma unroll
            for (int qb = 0; qb < 2; ++qb) { f32x16 a = (f32x16){};
#pragma unroll
                for (int ks = 0; ks < 6; ++ks) a = __builtin_amdgcn_mfma_f32_32x32x16_bf16(kf[ks], qf[qb][ks], a, 0, 0, 0);
                S[qb][rb] = a; } }
#pragma unroll
        for (int qb = 0; qb < 2; ++qb) { float mx = -1e30f;
#pragma unroll
            for (int rb = 0; rb < 2; ++rb)
#pragma unroll
                for (int r = 0; r < 16; ++r) mx = fmaxf(mx, S[qb][rb][r]);
            if (__builtin_expect(__builtin_amdgcn_ballot_w64(mx - mrun[qb] > 8.0f) != 0ull, 0)) { mx = xor32_max(mx);
                const float mnew_ = fmaxf(mrun[qb], mx), alpha = __builtin_amdgcn_exp2f(mrun[qb] - mnew_); mrun[qb] = mnew_; lrun[qb] *= alpha;
#pragma unroll
                for (int db = 0; db < 2; ++db) O[qb][db] *= alpha; }
            const float mnew = mrun[qb]; float ps = 0.f;
#pragma unroll
            for (int rb = 0; rb < 2; ++rb)
#pragma unroll
                for (int r = 0; r < 16; ++r) { const float pe = __builtin_amdgcn_exp2f(S[qb][rb][r] - mnew); S[qb][rb][r] = pe; ps += pe; }
            lrun[qb] += ps; }
#pragma unroll
        for (int mm = 0; mm < 4; ++mm) { bf16x8 pf[2];
#pragma unroll
            for (int qb = 0; qb < 2; ++qb) { const f32x16& s = S[qb][mm >> 1]; const int o = 8 * (mm & 1); u32x4 w;
                w.x = cvt_pk_bf16(s[o + 0], s[o + 1]); w.y = cvt_pk_bf16(s[o + 2], s[o + 3]); w.z = cvt_pk_bf16(s[o + 4], s[o + 5]); w.w = cvt_pk_bf16(s[o + 6], s[o + 7]); pf[qb] = __builtin_bit_cast(bf16x8, w); }
#pragma unroll
            for (int db = 0; db < 2; ++db) { const bf16x8 vf = *(const bf16x8*)(vb + ((32 * db + r32) * MV_ROW + 16 * mm + 8 * hi) * 2);
#pragma unroll
                for (int qb = 0; qb < 2; ++qb) O[qb][db] = __builtin_amdgcn_mfma_f32_32x32x16_bf16(vf, pf[qb], O[qb][db], 0, 0, 0); } }
        if (t + 1 < 64) MLA_COMMIT(p ^ 1);
        __syncthreads();
    }
#undef MLA_ISSUE
#undef MLA_COMMIT
#pragma unroll
    for (int qb = 0; qb < 2; ++qb) { float l = lrun[qb]; l = xor32_add(l); const float il = 1.f / l; float q = 0.f;
        const size_t t = (size_t)b * SEQ + qrow0 + 32 * qb + r32;
#pragma unroll
        for (int db = 0; db < 2; ++db) { O[qb][db] *= il;
#pragma unroll
            for (int r = 0; r < 16; ++r) q += O[qb][db][r] * O[qb][db][r]; }
        q = xor32_add(q); if (hi == 0) ssqC[t * 8 + h] = q;
#pragma unroll
        for (int kp = 0; kp < 4; ++kp) {
            const int db = kp >> 1, ga = (2 * kp) & 3, gb = ga + 1, c16 = 16 * kp + 8 * hi;
            u32x4 zq = *(const u32x4*)(H1 + t * OD_IN + 1536 + h * 64 + c16);
            unsigned z0 = zq.x, z1 = zq.y, z2 = zq.z, z3 = zq.w; swap32(z0, z2); swap32(z1, z3); zq = (u32x4){z0, z1, z2, z3};
            unsigned a0 = cvt_pk_bf16(O[qb][db][4 * ga + 0] * siluf(bflo(zq.x)), O[qb][db][4 * ga + 1] * siluf(bfhi(zq.x))), a1 = cvt_pk_bf16(O[qb][db][4 * ga + 2] * siluf(bflo(zq.y)), O[qb][db][4 * ga + 3] * siluf(bfhi(zq.y)));
            unsigned b0 = cvt_pk_bf16(O[qb][db][4 * gb + 0] * siluf(bflo(zq.z)), O[qb][db][4 * gb + 1] * siluf(bfhi(zq.z))), b1 = cvt_pk_bf16(O[qb][db][4 * gb + 2] * siluf(bflo(zq.w)), O[qb][db][4 * gb + 3] * siluf(bfhi(zq.w)));
            swap32(a0, b0); swap32(a1, b1);
            *(u32x4*)(Y1 + t * DM + h * 64 + c16) = (u32x4){a0, a1, b0, b1}; } }
}

#define XB_TMO      128
#define XB_XCNT(j)  (256  + 64 * (j))
#define XB_XSUB(j)  (1280 + 64 * (j))
#define XB_XGEN(j)  (2304 + 64 * (j))
#define XB_TOP      3328
#define XB_TOPGEN   3392
#define XCD_BAR_WORDS 3456
#define XB_SPIN_CAP (1u << 18)
__device__ __forceinline__ unsigned xb_ld(unsigned* p)              { return __hip_atomic_load(p, __ATOMIC_RELAXED, __HIP_MEMORY_SCOPE_AGENT); }
__device__ __forceinline__ unsigned xb_add(unsigned* p, unsigned v) { return __hip_atomic_fetch_add(p, v, __ATOMIC_RELAXED, __HIP_MEMORY_SCOPE_AGENT); }
__device__ __forceinline__ unsigned xb_xcc_id() { return (unsigned)__builtin_amdgcn_s_getreg((3 << 11) | 20) & 0xFu; }
#define XB_SPIN(cond, bar) do { unsigned _sp = 0; while (cond) { __builtin_amdgcn_s_sleep(1); \
    if ((++_sp & 255u) == 0u) { if (xb_ld(&(bar)[XB_TMO])) break; if (_sp > XB_SPIN_CAP) { atomicAdd(&(bar)[XB_TMO], 1u); break; } } } } while (0)
__device__ __forceinline__ void xcd_barrier_complete(unsigned* bar, unsigned x, unsigned& nloc, unsigned& nx) {
    const unsigned G = gridDim.x * gridDim.y * gridDim.z;
    unsigned sum, cnt, mine, sp = 0u;
    for (;;) {
        sum = 0u; cnt = 0u; mine = 0u;
#pragma unroll
        for (unsigned j = 0; j < 16; ++j) { const unsigned c = xb_ld(&bar[XB_XCNT(j)]); sum += c; cnt += (c > 0u) ? 1u : 0u; mine = (j == x) ? c : mine; }
        if (sum == G) break;
        __builtin_amdgcn_s_sleep(1);
        if ((++sp & 255u) == 0u) { if (xb_ld(&bar[XB_TMO])) break; if (sp > XB_SPIN_CAP) { atomicAdd(&bar[XB_TMO], 1u); break; } }
    }
    nloc = mine > 0u ? mine : 1u; nx = cnt > 0u ? cnt : 1u;
}
__device__ __forceinline__ void xcd_barrier(unsigned* bar, volatile LAS unsigned* st, int wsg) {
    asm volatile("s_waitcnt vmcnt(0)" ::: "memory");
    __syncthreads();
    if (tid_from(wsg) == 0) {
        __builtin_amdgcn_s_waitcnt(0);
        const unsigned x = xb_xcc_id();
        unsigned nloc = st[0], nx = st[1];
        if (nloc == 0u) { xcd_barrier_complete(bar, x, nloc, nx); st[0] = nloc; st[1] = nx; }
        const unsigned old = xb_add(&bar[XB_XSUB(x)], 1u);
        const unsigned gen = old / nloc;
        if (old + 1u == (gen + 1u) * nloc) {
            __builtin_amdgcn_fence(__ATOMIC_RELEASE, "agent");
            asm volatile("s_waitcnt vmcnt(0)" ::: "memory");
            const unsigned og = xb_add(&bar[XB_TOP], 1u);
            const unsigned tg = og / nx;
            if (og + 1u == (tg + 1u) * nx) xb_add(&bar[XB_TOPGEN], 1u);
            else XB_SPIN(xb_ld(&bar[XB_TOPGEN]) == tg, bar);
            __builtin_amdgcn_fence(__ATOMIC_ACQUIRE, "agent");
            xb_add(&bar[XB_XGEN(x)], 1u);
            asm volatile("s_waitcnt vmcnt(0)" ::: "memory");
        } else {
            XB_SPIN(xb_ld(&bar[XB_XGEN(x)]) == gen, bar);
            __builtin_amdgcn_fence(__ATOMIC_ACQUIRE, "agent");
            asm volatile("s_waitcnt vmcnt(0)" ::: "memory");
        }
    }
    __syncthreads();
}

constexpr int LDS_BYTES = 147456;
#ifndef PHMASK
#define PHMASK 0x3ff
#endif
#ifndef DUPMASK
#define DUPMASK 0x000
#endif
#define PH(k) for (int rep_ = 0; rep_ < (((DUPMASK >> (k)) & 1) ? 2 : 1); ++rep_) if constexpr ((PHMASK >> (k)) & 1)
__global__ void __launch_bounds__(512, 2) mega(Args a) {
    extern __shared__ __attribute__((aligned(16))) unsigned char lds_raw[];
    cg::grid_group grid = cg::this_grid();
    LAS unsigned char* lds3 = (LAS unsigned char*)lds_raw;
    unsigned char* lds = lds_raw;
    const int wsg = __builtin_amdgcn_readfirstlane(threadIdx.x >> 6);
    volatile LAS unsigned* xb_st = (volatile LAS unsigned*)(lds3 + (LDS_BYTES - 16));
    if (threadIdx.x < 4) xb_st[threadIdx.x] = 0u;
    __syncthreads();
    if (threadIdx.x == 0) (void)xb_add((unsigned*)(a.ws + WS_BAR) + XB_XCNT(xb_xcc_id()), 1u);
#define SEAM() xcd_barrier((unsigned*)(a.ws + WS_BAR), xb_st, wsg)
#define PHASE_VARS int bid = blockIdx.x, G = gridDim.x; asm volatile("" : "+s"(bid), "+s"(G));
#define INF(i) ((const float*)a.in[i])
#define x_in (INF(0))
#define p_in (INF(1))
#define pos ((const int*)a.in[2])
#define ev_w_in INF(3)
#define ev_conv_w INF(4)
#define ev_sink INF(5)
#define ev_a_norm INF(6)
#define ev_b_norm INF(7)
#define ev_w_out INF(8)
#define od_w_in INF(9)
#define od_q_norm INF(10)
#define od_w_uq INF(11)
#define od_kv_norm INF(12)
#define od_w_ukv INF(13)
#define od_v_ln_g INF(14)
#define od_v_ln_b INF(15)
#define od_w_s INF(16)
#define od_b_s INF(17)
#define od_c_norm INF(18)
#define od_d_norm INF(19)
#define od_w_out INF(20)
#define post_ln_g INF(21)
#define post_ln_b INF(22)
#define ple_proj INF(23)
#define ple_gate INF(24)
#define WSP(T, off) ((T*)(a.ws + (off)))
#define WT_IN0 WSP(bf16_t, WS_WT_IN0)
#define WT_OUT0 WSP(bf16_t, WS_WT_OUT0)
#define WT_GATE0 WSP(bf16_t, WS_WT_GATE0)
#define WT_GATE1 WSP(bf16_t, WS_WT_GATE1)
#define WT_PROJ0 WSP(bf16_t, WS_WT_PROJ0)
#define WT_PROJ1 WSP(bf16_t, WS_WT_PROJ1)
#define WT_IN1 WSP(bf16_t, WS_WT_IN1)
#define WT_UQ WSP(bf16_t, WS_WT_UQ)
#define WT_UK WSP(bf16_t, WS_WT_UK)
#define WT_UV WSP(bf16_t, WS_WT_UV)
#define WT_OUT1 WSP(bf16_t, WS_WT_OUT1)
#define WSB WSP(bf16_t, WS_WSB)
#define GV WSP(float, WS_GV)
#define CS WSP(f32x2, WS_CS)
#define PART WSP(f32x2, WS_PART)
#define STATQ WSP(float, WS_STATQ)
#define STATKV WSP(float, WS_STATKV)
#define STATV WSP(f32x2, WS_STATV)
#define SSQC WSP(float, WS_SSQC)
#define MRBLK WSP(f32x2, WS_MRBLK)
#define XB WSP(bf16_t, WS_XB)
#define PB WSP(bf16_t, WS_PB)
#define PP WSP(bf16_t, WS_PP)
#define QB WSP(bf16_t, WS_PP)
#define H0 WSP(bf16_t, WS_HR)
#define H1 WSP(bf16_t, WS_HR)
#define UB WSP(bf16_t, WS_HR)
#define Y1B ((bf16_t*)a.out)
#define KB WSP(bf16_t, WS_KV)
#define VT WSP(bf16_t, WS_KV + 48 * MiB)

    PH(0) { PHASE_VARS const int tid = tid_from(wsg); const int gt = bid * 512 + tid, GT = G * 512;
        if (G >= 256 && bid < 256) {
            const int layer = bid >> 7, c = (bid & 127) * 8 + (tid & 7), ks = tid >> 3; const float* gate = ple_gate + (size_t)layer * DM * DM; const float* lg = post_ln_g + layer * DM; const float* lb = post_ln_b + layer * DM;
            float s1 = 0.f, s0 = 0.f;
#pragma unroll
            for (int k = ks * 16; k < ks * 16 + 16; ++k) { const float w = gate[(size_t)k * DM + c]; s1 += bf2f(f2bf(w * lg[k])); s0 += w * lb[k]; }
            float* red = (float*)lds; red[tid * 2] = s1; red[tid * 2 + 1] = s0;
            __syncthreads();
            if (tid < 8) { float t1 = 0.f, t0 = 0.f;
                for (int i = 0; i < 64; ++i) { t1 += red[(i * 8 + tid) * 2]; t0 += red[(i * 8 + tid) * 2 + 1]; }
                GV[layer * 2048 + c] = t1; GV[layer * 2048 + 1024 + c] = t0; }
            __syncthreads();
        } else if (G < 256 && bid < 32) {
            const int layer = bid >> 4, c = (bid & 15) * 64 + (tid & 63), kq = tid >> 6; const float* gate = ple_gate + (size_t)layer * DM * DM; const float* lg = post_ln_g + layer * DM; const float* lb = post_ln_b + layer * DM;
            float s1 = 0.f, s0 = 0.f;
            for (int k = kq * 128; k < kq * 128 + 128; ++k) { const float w = gate[(size_t)k * DM + c]; s1 += bf2f(f2bf(w * lg[k])); s0 += w * lb[k]; }
            float* red = (float*)lds; red[(kq * 64 + (tid & 63)) * 2] = s1; red[(kq * 64 + (tid & 63)) * 2 + 1] = s0;
            __syncthreads();
            if (tid < 64) { float t1 = 0.f, t0 = 0.f;
                for (int i = 0; i < 8; ++i) { t1 += red[(i * 64 + tid) * 2]; t0 += red[(i * 64 + tid) * 2 + 1]; }
                GV[layer * 2048 + c] = t1; GV[layer * 2048 + 1024 + c] = t0; }
            __syncthreads();
        }
        conv_w(ev_w_in, WT_IN0, 1024, EV_IN, EV_IN, 0, nullptr, nullptr, 0.125f * LOG2E, 512, gt, GT);
        conv_w(ev_w_out, WT_OUT0, 1024, 1024, 1024, 0, ev_a_norm, ev_b_norm, 1.f, 0, gt, GT);
        conv_w(ple_gate, WT_GATE0, 1024, 1024, 1024, 0, post_ln_g, nullptr, 1.f, 0, gt, GT);
        conv_w(ple_gate + (size_t)DM * DM, WT_GATE1, 1024, 1024, 1024, 0, post_ln_g + DM, nullptr, 1.f, 0, gt, GT);
        conv_w(ple_proj, WT_PROJ0, 256, 1024, 1024, 0, nullptr, nullptr, 1.f, 0, gt, GT);
        conv_w(ple_proj + 256 * DM, WT_PROJ1, 256, 1024, 1024, 0, nullptr, nullptr, 1.f, 0, gt, GT);
        conv_w(od_w_in, WT_IN1, 1024, OD_IN_SRC, OD_IN, 1, nullptr, nullptr, 1.f, 0, gt, GT);
        conv_w(od_w_uq, WT_UQ, 256, 768, 768, 2, od_q_norm, nullptr, 0.10206207261596577f * LOG2E, 768, gt, GT);
        conv_w(od_w_ukv, WT_UK, 128, 1024, 512, 3, od_kv_norm, nullptr, 1.f, 0, gt, GT);
        conv_w(od_w_ukv, WT_UV, 128, 1024, 512, 4, od_kv_norm, nullptr, 1.f, 0, gt, GT);
        conv_w(od_w_out, WT_OUT1, 1024, 1024, 1024, 0, od_c_norm, od_d_norm, 1.f, 0, gt, GT);
        conv_flat(od_w_s, WSB, (size_t)4 * 128 * 128 / 8, gt, GT);
        conv_flat(x_in, XB, (size_t)M * DM / 8, gt, GT);
        conv_flat(p_in, PB, (size_t)2 * M * 256 / 8, gt, GT);
        for (int i = gt; i < M * 16; i += GT) { const int row = i >> 4, j = i & 15; const float inv = exp2f(-(float)j * (13.287712379549449f / 16.f));
            double rev = (double)pos[row] * (double)inv * 0.15915494309189535; rev -= rint(rev); const float rf = (float)rev;
            CS[i] = (f32x2){__builtin_amdgcn_cosf(rf), __builtin_amdgcn_sinf(rf)}; }
    }
    if (a.ws == nullptr) grid.sync();
    SEAM();
    PH(1) { PHASE_VARS
        pg8::StaticOrder S; S.init(M, EV_IN, G, bid); pg8::Gemm g{XB, WT_IN0, M, EV_IN, 1024, 1024, 1024}; EpiStore E{H0, EV_IN, 1000};
        pg8::gemm_phase(wsg, lds3, g, S, E);
        pg8::StaticOrder S2; if (G == 256) S2.init(M, 1024, 128, bid - 128); else S2.init(M, 1024, G, bid);
        pg8::Gemm g2{PB, WT_PROJ0, M, 1024, 256, 256, 256}; EpiStore E2{PP, 1024, 1000};
        if (G != 256 || bid >= 128) pg8::gemm_phase(wsg, lds3, g2, S2, E2);
    }
    SEAM();
    PH(2) { PHASE_VARS for (int it = bid; it < 512; it += G) even_item(wsg, lds, H0, pos, ev_sink, ev_conv_w, XB, it >> 6, (it & 63) * 64); }
    SEAM();
    PH(3) { PHASE_VARS
        pg8::StaticOrder S; S.init(M, 1024, G, bid); pg8::Gemm g{XB, WT_OUT0, M, 1024, 1024, 1024, 1024}; EpiOut<false, false> E{x_in, UB, PART, nullptr};
        pg8::gemm_phase(wsg, lds3, g, S, E);
    }
    SEAM();
#define GATE_PHASE(WTG, LAYER, OUTF, XBOUT) do { \
        pg8::StaticOrder S; S.init(M, 1024, G, bid); \
        { int tq_ = tid_from(wsg); asm volatile("" : "+v"(tq_)); pg8::Unit u_; for (int i_ = tq_ >> 8; i_ < MR_UMAX && S.next(i_, u_); i_ += 2) { const int row_ = u_.pm * 256 + (tq_ & 255); const f32x4* pp_ = (const f32x4*)(PART + (size_t)row_ * 16); float s_ = 0.f, q_ = 0.f; \
              _Pragma("unroll") for (int j_ = 0; j_ < 8; ++j_) { const f32x4 v_ = pp_[j_]; s_ += v_[0] + v_[2]; q_ += v_[1] + v_[3]; } \
              const float mean_ = s_ * (1.f / 1024.f), var_ = q_ * (1.f / 1024.f) - mean_ * mean_; MRBLK[((size_t)bid * MR_UMAX + i_) * 256 + (tq_ & 255)] = (f32x2){mean_, rsqrtf(fmaxf(var_, 0.f) + EPS)}; } } \
        __threadfence_block(); __syncthreads(); \
        pg8::Gemm g{UB, WTG, M, 1024, 1024, 1024, 1024}; \
        EpiGate E{UB, MRBLK + (size_t)bid * MR_UMAX * 256, post_ln_g + (LAYER) * DM, post_ln_b + (LAYER) * DM, GV + (LAYER) * 2048, GV + (LAYER) * 2048 + 1024, PP, OUTF, XBOUT}; \
        pg8::gemm_phase(wsg, lds3, g, S, E); } while (0)
    PH(4) { PHASE_VARS GATE_PHASE(WT_GATE0, 0, (float*)nullptr, XB); }
    SEAM();
    PH(5) { PHASE_VARS
        pg8::StaticOrder S; S.init(M, OD_IN, G, bid); pg8::Gemm g{XB, WT_IN1, M, OD_IN, 1024, 1024, 1024}; EpiH1 E{H1, STATQ, STATKV, STATV, CS, KB};
        pg8::gemm_phase(wsg, lds3, g, S, E);
    }
    SEAM();
    PH(6) { PHASE_VARS
#ifndef P6MASK
#define P6MASK 15
#endif
        if constexpr (P6MASK & 1) { pg8::StaticOrder S; S.init(M, 768, G, bid); pg8::Gemm g{H1, WT_UQ, M, 768, 256, OD_IN, 256}; EpiQ E{STATQ, CS, QB}; pg8::gemm_phase(wsg, lds3, g, S, E); }
        if constexpr (P6MASK & 2) { pg8::StaticOrder S; S.init(M, 512, G, bid); pg8::Gemm g{H1 + 256, WT_UK, M, 512, 128, OD_IN, 128}; EpiK E{STATKV, KB}; pg8::gemm_phase(wsg, lds3, g, S, E); }
        if constexpr (P6MASK & 4) { pg8::StaticOrder S; S.init(512, M, G, bid); pg8::Gemm g{WT_UV, H1 + 256, 512, M, 128, 128, OD_IN}; EpiVT E{STATKV, VT}; pg8::gemm_phase(wsg, lds3, g, S, E); }
        if constexpr (P6MASK & 8) for (int it = bid; it < 256; it += G) gmlp_item(wsg, lds, H1, STATV, od_v_ln_g, od_v_ln_b, WSB, od_b_s, Y1B, it);
    }
    SEAM();
    PH(7) { PHASE_VARS for (int it = bid; it < 512; it += G) { const int xcd = it & 7, idx = it >> 3; mla_unit(wsg, lds, QB, KB, VT, H1, Y1B, SSQC, xcd * 8 + (idx >> 3), idx & 7); } }
    SEAM();
    PH(8) { PHASE_VARS
        pg8::StaticOrder S; S.init(M, 1024, G, bid); pg8::Gemm g{Y1B, WT_OUT1, M, 1024, 1024, 1024, 1024}; EpiOut<true, true> E{XB, UB, PART, SSQC};
        pg8::gemm_phase(wsg, lds3, g, S, E);
        pg8::StaticOrder S2; S2.init(M, 1024, G, bid); pg8::Gemm g2{PB + (size_t)M * 256, WT_PROJ1, M, 1024, 256, 256, 256}; EpiStore E2{PP, 1024, 1000};
        pg8::gemm_phase(wsg, lds3, g2, S2, E2);
    }
    SEAM();
    PH(9) { PHASE_VARS GATE_PHASE(WT_GATE1, 1, a.out, (bf16_t*)nullptr); }
}

extern "C" void kernel_launch(void* const* d_in, const int* in_sizes, int n_in, void* d_out, int out_size, void* d_ws, size_t ws_size, hipStream_t stream) {
    static int grid = 0;
    if (grid == 0) {
        if (n_in != 25 || out_size != M * DM || ws_size < WS_END) { fprintf(stderr, "kernel_launch: unexpected problem (n_in %d out %d ws %zu)\n", n_in, out_size, ws_size); grid = -1; return; }
        int dev = 0, cus = 0, per_cu = 0;
        (void)hipGetDevice(&dev);
        (void)hipDeviceGetAttribute(&cus, hipDeviceAttributeMultiprocessorCount, dev);
        (void)hipFuncSetAttribute((const void*)mega, hipFuncAttributeMaxDynamicSharedMemorySize, LDS_BYTES);
        (void)hipOccupancyMaxActiveBlocksPerMultiprocessor(&per_cu, (const void*)mega, 512, LDS_BYTES);
        if (per_cu < 1) { fprintf(stderr, "kernel_launch: occupancy query reports %d blocks per CU\n", per_cu); }
        grid = cus;
    }
    if (grid < 0) return;
    Args a{};
    for (int i = 0; i < 25; ++i) a.in[i] = d_in[i];
    a.out = (float*)d_out; a.ws = (unsigned char*)d_ws;
    (void)hipMemsetAsync((unsigned char*)d_ws + WS_BAR, 0, XCD_BAR_WORDS * 4, stream);
    void* args[] = {&a};
    hipError_t e = hipLaunchCooperativeKernel((const void*)mega, dim3(grid), dim3(512), args, LDS_BYTES, stream);
    if (e != hipSuccess) fprintf(stderr, "cooperative launch failed: %s (grid %d)\n", hipGetErrorString(e), grid);
}
```

```cpp
#include <hip/hip_runtime.h>
#include <hip/hip_cooperative_groups.h>
#include <cstdio>
#include <cstdint>
namespace cg = cooperative_groups;

#define LAS __attribute__((address_space(3)))
typedef unsigned short bf16_t;
typedef short bf16x8 __attribute__((ext_vector_type(8)));
typedef float f32x4 __attribute__((ext_vector_type(4)));
typedef float f32x2 __attribute__((ext_vector_type(2)));
typedef float f32x16 __attribute__((ext_vector_type(16)));
typedef unsigned u32x4 __attribute__((ext_vector_type(4)));
typedef unsigned u32x2 __attribute__((ext_vector_type(2)));

constexpr int BATCH = 8, SEQ = 4096, DM = 1024, M = BATCH * SEQ;
constexpr int EV_IN = 3328, OD_IN_SRC = 2464, OD_IN = 2560;
constexpr float EPS = 1e-6f, LOG2E = 1.4426950408889634f;
constexpr float DN_ALPHA = 1.4142135623730951f;
constexpr size_t MiB = 1u << 20;
constexpr size_t WS_WT_IN0 = 0, WS_WT_OUT0 = 7 * MiB, WS_WT_GATE0 = 9 * MiB, WS_WT_GATE1 = 11 * MiB, WS_WT_PROJ0 = 13 * MiB, WS_WT_PROJ1 = 13 * MiB + 512 * 1024,
                 WS_WT_IN1 = 14 * MiB, WS_WT_UQ = 19 * MiB, WS_WT_UK = 19 * MiB + 512 * 1024, WS_WT_UV = 19 * MiB + 768 * 1024, WS_WT_OUT1 = 20 * MiB,
                 WS_WSB = 22 * MiB, WS_GV = 22 * MiB + 512 * 1024, WS_CS = 23 * MiB, WS_PART = 27 * MiB, WS_STATQ = 31 * MiB, WS_STATKV = 31 * MiB + 512 * 1024,
                 WS_STATV = 32 * MiB, WS_SSQC = 34 * MiB, WS_MRBLK = 35 * MiB, WS_BAR = 39 * MiB,
                 WS_XB = 40 * MiB, WS_PB = 104 * MiB, WS_PP = 136 * MiB, WS_HR = 200 * MiB, WS_KV = 408 * MiB, WS_END = 488 * MiB;
constexpr int MR_UMAX = 8;

__device__ __forceinline__ unsigned cvt_pk_bf16(float lo, float hi) { unsigned r; asm volatile("v_cvt_pk_bf16_f32 %0, %1, %2" : "=v"(r) : "v"(lo), "v"(hi)); return r; }
__device__ __forceinline__ float bflo(unsigned w) { return __uint_as_float(w << 16); }
__device__ __forceinline__ float bfhi(unsigned w) { return __uint_as_float(w & 0xffff0000u); }
__device__ __forceinline__ float bf2f(bf16_t v) { return __uint_as_float((unsigned)v << 16); }
__device__ __forceinline__ bf16_t f2bf(float f) { return (bf16_t)(cvt_pk_bf16(f, 0.f) & 0xffffu); }
__device__ __forceinline__ float sigm(float x) { return __builtin_amdgcn_rcpf(1.f + __expf(-x)); }
__device__ __forceinline__ float siluf(float x) { return x * sigm(x); }
__device__ __forceinline__ float geluf(float x) { return x * sigm(1.5957691216057308f * (x + 0.044715f * x * x * x)); }
__device__ __forceinline__ u32x4 pack8(const f32x4 a, const f32x4 b) { u32x4 w; w.x = cvt_pk_bf16(a[0], a[1]); w.y = cvt_pk_bf16(a[2], a[3]); w.z = cvt_pk_bf16(b[0], b[1]); w.w = cvt_pk_bf16(b[2], b[3]); return w; }

template <int X> __device__ __forceinline__ float swz_xor(float v) { return __int_as_float(__builtin_amdgcn_ds_swizzle(__float_as_int(v), (X << 10) | 0x1f)); }
__device__ __forceinline__ float xor32_add(float v) { auto rr = __builtin_amdgcn_permlane32_swap(__float_as_uint(v), __float_as_uint(v), false, false); return __uint_as_float(rr[0]) + __uint_as_float(rr[1]); }
__device__ __forceinline__ float xor32_max(float v) { auto rr = __builtin_amdgcn_permlane32_swap(__float_as_uint(v), __float_as_uint(v), false, false); return fmaxf(__uint_as_float(rr[0]), __uint_as_float(rr[1])); }
__device__ __forceinline__ int lane_id_v() { int l; asm volatile("v_mbcnt_lo_u32_b32 %0, -1, 0\n\tv_mbcnt_hi_u32_b32 %0, -1, %0" : "=v"(l)); return l; }
__device__ __forceinline__ int tid_from(int wsg) { int l; asm volatile("v_mbcnt_lo_u32_b32 %0, -1, 0\n\tv_mbcnt_hi_u32_b32 %0, -1, %0" : "=v"(l)); return (wsg << 6) | l; }
__device__ __forceinline__ void swap32(unsigned& a, unsigned& b) { auto r = __builtin_amdgcn_permlane32_swap(a, b, false, false); a = r[0]; b = r[1]; }
namespace pg8 {
constexpr int BM = 256, BK = 64, HALF = 128, HTB = HALF * BK * 2, STAGE_BYTES = 8 * HTB, NXCD = 8, WGM = 8;
__host__ __device__ __forceinline__ int lds_byte(int r, int c) { const int st = (r >> 4) * 2 + (c >> 5), rr = r & 15, cc = c & 31, ob = rr * 64 + cc * 2; return st * 1024 + (ob ^ (((ob >> 9) & 1) << 5)); }
__host__ __device__ __forceinline__ void stage_rc(int b, int& R, int& C) { const int st = b / 1024, sb = b % 1024, swz = sb ^ (((sb >> 9) & 1) << 5); R = (st >> 1) * 16 + swz / 64; C = (st & 1) * 32 + (swz % 64) / 2; }
__host__ __device__ __forceinline__ int perm32(int rho) { const int n = rho >> 4, i = rho & 15; return 8 * (i >> 2) + 4 * n + (i & 3); }
struct Unit { int pm, pn, idx; };
struct Gemm { const bf16_t* A; const bf16_t* Bt; int M, N, K, lda, ldb; };
struct StaticOrder {
    int nM, nN, nwg, G, c;
    __device__ __forceinline__ void init(int M_, int N_, int G_, int c_) { nM = M_ / BM; nN = N_ / BM; nwg = nM * nN; G = G_; c = c_; }
    __device__ __forceinline__ bool next(int i, Unit& u) const {
        const long L = (long)i * G + c; if (L >= nwg) return false;
        int wgid = (int)L; { const int q = nwg / NXCD, r = nwg % NXCD, xcd = wgid % NXCD, off = wgid / NXCD; wgid = (xcd < r ? xcd * (q + 1) : r * (q + 1) + (xcd - r) * q) + off; }
        const int nig = WGM * nN, gid = wgid / nig, fm = gid * WGM, gsz = (nM - fm) < WGM ? (nM - fm) : WGM;
        u.pm = fm + ((wgid % nig) % gsz); u.pn = (wgid % nig) / gsz; u.idx = i; return true;
    }
};
template <class Epi, class Sched>
__device__ __forceinline__ void gemm_phase(int wsg, LAS unsigned char* lds, const Gemm g, const Sched& S, const Epi& E) {
    int tid_ = tid_from(wsg); asm volatile("" : "+v"(tid_));
    const int tid = tid_, wid = __builtin_amdgcn_readfirstlane(tid >> 6), lane = tid & 63, wr = wid >> 2, wc = wid & 3, fr = lane & 15, fq = lane >> 4;
    const int K = g.K, nt = K / BK;
    unsigned voffA[2], voffB[2];
#pragma unroll
    for (int i = 0; i < 2; ++i) { int R, C; stage_rc(tid * 16 + i * 8192, R, C); const int Rb = (R & ~31) + perm32(R & 31);
        voffA[i] = (unsigned)(R * g.lda + C) * 2u; voffB[i] = (unsigned)(Rb * g.ldb + C) * 2u; }
    const size_t kstep = (size_t)(BK * 2);
    const size_t hstepA = (size_t)HALF * g.lda * 2, hstepB = (size_t)HALF * g.ldb * 2;
    const size_t tstepA = 2 * hstepA, tstepB = 2 * hstepB;
    const unsigned ldsw = (unsigned)wid * 1024u;
    const int aoff = lds_byte(wr * 64 + fr, fq * 8), boff = lds_byte(wc * 32 + fr, fq * 8);
#define PG8_SA(b, h) (((b) * 2 + (h)) * HTB)
#define PG8_SB(b, h) ((4 + (b) * 2 + (h)) * HTB)
#define PG8_STAGE(bufoff, gbase, voff) do { _Pragma("unroll") for (int _i = 0; _i < 2; ++_i) \
        __builtin_amdgcn_global_load_lds((const unsigned*)((const char*)(gbase) + (voff)[_i]), (LAS unsigned*)(lds + (bufoff) + ldsw + _i * 8192), 16, 0, 0); } while (0)
#define PG8_LDA(dst, b, h) do { _Pragma("unroll") for (int m = 0; m < 4; ++m) _Pragma("unroll") for (int k = 0; k < 2; ++k) dst[m][k] = *(const LAS bf16x8*)(lds + PG8_SA(b, h) + aoff + m * 2048 + k * 1024); } while (0)
#define PG8_LDB(dst, b, h) do { _Pragma("unroll") for (int n = 0; n < 2; ++n) _Pragma("unroll") for (int k = 0; k < 2; ++k) dst[n][k] = *(const LAS bf16x8*)(lds + PG8_SB(b, h) + boff + n * 2048 + k * 1024); } while (0)
#define PG8_MMA(ai, bj, At, Bt) do { __builtin_amdgcn_s_setprio(1); _Pragma("unroll") for (int m = 0; m < 4; ++m) _Pragma("unroll") for (int n = 0; n < 2; ++n) _Pragma("unroll") for (int k = 0; k < 2; ++k) \
        acc[ai][bj][m][n] = __builtin_amdgcn_mfma_f32_16x16x32_bf16(Bt[n][k], At[m][k], acc[ai][bj][m][n], 0, 0, 0); __builtin_amdgcn_s_setprio(0); } while (0)
#define PG8_WAIT_V(n) asm volatile("s_waitcnt vmcnt(" #n ")" ::: "memory")
#define PG8_WAIT_L(n) asm volatile("s_waitcnt lgkmcnt(" #n ")" ::: "memory")
#define PG8_BAR __builtin_amdgcn_s_barrier()
#define PG8_SCHED __builtin_amdgcn_sched_barrier(0)
    Unit cur, nxt; int ui = 0;
    if (!S.next(0, cur)) return;
    f32x4 acc[2][2][4][2];
#pragma unroll
    for (int a = 0; a < 2; ++a)
#pragma unroll
        for (int b = 0; b < 2; ++b)
#pragma unroll
            for (int m = 0; m < 4; ++m)
#pragma unroll
                for (int n = 0; n < 2; ++n) acc[a][b][m][n] = (f32x4){0.f, 0.f, 0.f, 0.f};
    bf16x8 At[4][2], B0[2][2], B1[2][2];
    const char* cA = (const char*)g.A + (size_t)cur.pm * tstepA; const char* cB = (const char*)g.Bt + (size_t)cur.pn * tstepB;
    PG8_STAGE(PG8_SB(0, 0), cB, voffB); PG8_STAGE(PG8_SB(0, 1), cB + hstepB, voffB); PG8_STAGE(PG8_SA(0, 0), cA, voffA); PG8_STAGE(PG8_SA(0, 1), cA + hstepA, voffA);
    if (wr == 1) PG8_BAR;
    PG8_WAIT_V(2); PG8_BAR;
    PG8_STAGE(PG8_SB(1, 0), cB + kstep, voffB); PG8_STAGE(PG8_SA(1, 0), cA + kstep, voffA); PG8_STAGE(PG8_SB(1, 1), cB + hstepB + kstep, voffB);
    PG8_WAIT_V(6); PG8_BAR;
    for (;;) {
        const bool has_next = S.next(ui + 1, nxt);
        const char* nA = has_next ? (const char*)g.A + (size_t)nxt.pm * tstepA : cA; const char* nB = has_next ? (const char*)g.Bt + (size_t)nxt.pn * tstepB : cB;
        for (int t = 0; t < nt; t += 2) {
            const bool last = (t == nt - 2);
            const char* a1 = cA + (size_t)(t + 1) * kstep;
            const char* a2 = last ? nA : cA + (size_t)(t + 2) * kstep; const char* b2 = last ? nB : cB + (size_t)(t + 2) * kstep;
            const char* a3 = a2 + kstep; const char* b3 = b2 + kstep;
            if constexpr (Epi::MID) { if (t == (nt >> 1)) E.mid(acc, cur, wr, lane_id_v() & 15); }
            PG8_LDB(B0, 0, 0); PG8_LDB(B1, 0, 1); PG8_SCHED; PG8_LDA(At, 0, 0); PG8_STAGE(PG8_SA(1, 1), a1 + hstepA, voffA);
            PG8_WAIT_V(8); PG8_WAIT_L(0); PG8_BAR; PG8_MMA(0, 0, At, B0); PG8_MMA(0, 1, At, B1); PG8_BAR; PG8_SCHED;
            PG8_LDA(At, 0, 1); PG8_STAGE(PG8_SB(0, 0), b2, voffB); PG8_STAGE(PG8_SB(0, 1), b2 + hstepB, voffB); PG8_STAGE(PG8_SA(0, 0), a2, voffA);
            PG8_WAIT_V(8); PG8_WAIT_L(0); PG8_BAR; PG8_MMA(1, 0, At, B0); PG8_MMA(1, 1, At, B1); PG8_BAR; PG8_SCHED;
            PG8_LDB(B0, 1, 0); PG8_LDB(B1, 1, 1); PG8_SCHED; PG8_LDA(At, 1, 0); PG8_STAGE(PG8_SA(0, 1), a2 + hstepA, voffA);
            PG8_WAIT_V(8); PG8_WAIT_L(0); PG8_BAR; PG8_MMA(0, 0, At, B0); PG8_MMA(0, 1, At, B1); PG8_BAR; PG8_SCHED;
            PG8_LDA(At, 1, 1); PG8_STAGE(PG8_SB(1, 0), b3, voffB); PG8_STAGE(PG8_SB(1, 1), b3 + hstepB, voffB); PG8_STAGE(PG8_SA(1, 0), a3, voffA);
            PG8_WAIT_V(8); PG8_WAIT_L(0); PG8_BAR; PG8_MMA(1, 0, At, B0); PG8_MMA(1, 1, At, B1); PG8_BAR; PG8_SCHED;
        }
        if (wr == 0) PG8_BAR;
        { const int l_e = lane_id_v(); E(acc, cur, wr, wc, l_e & 15, l_e >> 4); }
        if (!has_next) break;
#pragma unroll
        for (int a = 0; a < 2; ++a)
#pragma unroll
            for (int b = 0; b < 2; ++b)
#pragma unroll
                for (int m = 0; m < 4; ++m)
#pragma unroll
                    for (int n = 0; n < 2; ++n) acc[a][b][m][n] = (f32x4){0.f, 0.f, 0.f, 0.f};
        cur = nxt; cA = nA; cB = nB; ++ui;
        if (wr == 1) PG8_BAR;
    }
    PG8_WAIT_V(0);
    PG8_BAR;
#undef PG8_SA
#undef PG8_SB
#undef PG8_STAGE
#undef PG8_LDA
#undef PG8_LDB
#undef PG8_MMA
#undef PG8_WAIT_V
#undef PG8_WAIT_L
#undef PG8_BAR
#undef PG8_SCHED
}
}
using pg8::Unit;
typedef f32x4 AccT[2][2][4][2];
#define EPI_ROW(u, ai, m) ((u).pm * 256 + (ai) * 128 + wr * 64 + (m) * 16 + fr)
#define EPI_LCOL(bj) ((bj) * 128 + wc * 32 + 8 * fq)

struct EpiStore {
    static constexpr bool MID = false;
    bf16_t* O; int ldc; int silu_pn;
    __device__ __forceinline__ void operator()(const AccT& acc, const Unit& u, int wr, int wc, int fr, int fq) const {
        const bool act = u.pn >= silu_pn;
#pragma unroll
        for (int ai = 0; ai < 2; ++ai)
#pragma unroll
            for (int m = 0; m < 4; ++m) { bf16_t* rowp = O + (size_t)EPI_ROW(u, ai, m) * ldc + u.pn * 256;
#pragma unroll
                for (int bj = 0; bj < 2; ++bj) { f32x4 v0 = acc[ai][bj][m][0], v1 = acc[ai][bj][m][1];
                    if (act) {
#pragma unroll
                        for (int e = 0; e < 4; ++e) { v0[e] = siluf(v0[e]); v1[e] = siluf(v1[e]); } }
                    *(u32x4*)(rowp + EPI_LCOL(bj)) = pack8(v0, v1); }
                asm volatile("" ::: "memory"); }
    }
};
template <bool MIDSCALE, bool RESBF> struct EpiOut {
    static constexpr bool MID = MIDSCALE;
    const void* res; bf16_t* Ub; f32x2* part; const float* ssqC;
    __device__ __forceinline__ void mid(AccT& acc, const Unit& u, int wr, int fr) const {
#pragma unroll
        for (int ai = 0; ai < 2; ++ai)
#pragma unroll
            for (int m = 0; m < 4; ++m) { const int row = EPI_ROW(u, ai, m); const f32x4 a = *(const f32x4*)(ssqC + (size_t)row * 8), b = *(const f32x4*)(ssqC + (size_t)row * 8 + 4);
                const float s = ((a[0] + a[1]) + (a[2] + a[3])) + ((b[0] + b[1]) + (b[2] + b[3])); const float rc = rsqrtf(s * (1.f / 512.f) + EPS);
#pragma unroll
                for (int bj = 0; bj < 2; ++bj)
#pragma unroll
                    for (int n = 0; n < 2; ++n) acc[ai][bj][m][n] *= rc; }
    }
    __device__ __forceinline__ void operator()(const AccT& acc, const Unit& u, int wr, int wc, int fr, int fq) const {
#pragma unroll
        for (int ai = 0; ai < 2; ++ai)
#pragma unroll
            for (int m = 0; m < 4; ++m) { const int row = EPI_ROW(u, ai, m); const size_t off = (size_t)row * DM + u.pn * 256; float s = 0.f, q = 0.f;
#pragma unroll
                for (int bj = 0; bj < 2; ++bj) { const size_t o = off + EPI_LCOL(bj); f32x4 r0, r1;
                    if constexpr (RESBF) { const u32x4 rw = *(const u32x4*)((const bf16_t*)res + o); r0 = (f32x4){bflo(rw.x), bfhi(rw.x), bflo(rw.y), bfhi(rw.y)}; r1 = (f32x4){bflo(rw.z), bfhi(rw.z), bflo(rw.w), bfhi(rw.w)}; }
                    else { r0 = *(const f32x4*)((const float*)res + o); r1 = *(const f32x4*)((const float*)res + o + 4); }
                    const f32x4 u0 = r0 * DN_ALPHA + acc[ai][bj][m][0], u1 = r1 * DN_ALPHA + acc[ai][bj][m][1];
                    *(u32x4*)(Ub + o) = pack8(u0, u1);
                    s += ((u0[0] + u0[1]) + (u0[2] + u0[3])) + ((u1[0] + u1[1]) + (u1[2] + u1[3]));
                    q += ((u0[0] * u0[0] + u0[1] * u0[1]) + (u0[2] * u0[2] + u0[3] * u0[3])) + ((u1[0] * u1[0] + u1[1] * u1[1]) + (u1[2] * u1[2] + u1[3] * u1[3])); }
                s += swz_xor<16>(s); s = xor32_add(s); q += swz_xor<16>(q); q = xor32_add(q);
                if (fq == 0) part[(size_t)row * 16 + u.pn * 4 + wc] = (f32x2){s, q};
                asm volatile("" ::: "memory"); }
    }
};
struct EpiGate {
    static constexpr bool MID = false;
    const bf16_t* Ub; const f32x2* mr; const float* lng; const float* lnb; const float* G1; const float* G0; const bf16_t* pp; float* out; bf16_t* xb;
    __device__ __forceinline__ void operator()(const AccT& acc, const Unit& u, int wr, int wc, int fr, int fq) const {
#pragma unroll
        for (int bj = 0; bj < 2; ++bj) { const int col = u.pn * 256 + EPI_LCOL(bj);
            f32x4 g[2], b[2], g1[2], g0[2];
#pragma unroll
            for (int n = 0; n < 2; ++n) { g[n] = *(const f32x4*)(lng + col + 4 * n); b[n] = *(const f32x4*)(lnb + col + 4 * n); g1[n] = *(const f32x4*)(G1 + col + 4 * n); g0[n] = *(const f32x4*)(G0 + col + 4 * n); }
#pragma unroll
            for (int ai = 0; ai < 2; ++ai)
#pragma unroll
                for (int m = 0; m < 4; ++m) { const int rl = ai * 128 + wr * 64 + m * 16 + fr; const f32x2 st = mr[u.idx * 256 + rl]; const size_t o = (size_t)(u.pm * 256 + rl) * DM + col;
                    const u32x4 pw = *(const u32x4*)(pp + o), uw = *(const u32x4*)(Ub + o); f32x4 ov[2];
                    const float ppv[8] = {bflo(pw.x), bfhi(pw.x), bflo(pw.y), bfhi(pw.y), bflo(pw.z), bfhi(pw.z), bflo(pw.w), bfhi(pw.w)};
                    const float uv[8] = {bflo(uw.x), bfhi(uw.x), bflo(uw.y), bfhi(uw.y), bflo(uw.z), bfhi(uw.z), bflo(uw.w), bfhi(uw.w)};
#pragma unroll
                    for (int n = 0; n < 2; ++n) {
#pragma unroll
                        for (int e = 0; e < 4; ++e) { const float h = (uv[4 * n + e] - st.x) * st.y * g[n][e] + b[n][e]; const float t = st.y * (acc[ai][bj][m][n][e] - st.x * g1[n][e]) + g0[n][e];
                            ov[n][e] = h + sigm(t) * ppv[4 * n + e]; } }
                    if (out) { __builtin_nontemporal_store(ov[0], (f32x4*)(out + o)); __builtin_nontemporal_store(ov[1], (f32x4*)(out + o + 4)); }
                    if (xb) *(u32x4*)(xb + o) = pack8(ov[0], ov[1]);
                    asm volatile("" ::: "memory"); } }
    }
};
struct EpiH1 {
    static constexpr bool MID = false;
    bf16_t* H1; float* statQ; float* statKV; f32x2* statV; const f32x2* cs; bf16_t* Kb;
    __device__ __forceinline__ void operator()(const AccT& acc, const Unit& u, int wr, int wc, int fr, int fq) const {
        const int pn = u.pn;
#pragma unroll
        for (int ai = 0; ai < 2; ++ai)
#pragma unroll
            for (int m = 0; m < 4; ++m) { const int row = EPI_ROW(u, ai, m); bf16_t* rowp = H1 + (size_t)row * OD_IN + pn * 256;
                if (pn == 0) { float q = 0.f;
#pragma unroll
                    for (int bj = 0; bj < 2; ++bj) { const f32x4 v0 = acc[ai][bj][m][0], v1 = acc[ai][bj][m][1]; *(u32x4*)(rowp + EPI_LCOL(bj)) = pack8(v0, v1);
                        q += ((v0[0] * v0[0] + v0[1] * v0[1]) + (v0[2] * v0[2] + v0[3] * v0[3])) + ((v1[0] * v1[0] + v1[1] * v1[1]) + (v1[2] * v1[2] + v1[3] * v1[3])); }
                    q += swz_xor<16>(q); q = xor32_add(q); if (fq == 0) statQ[(size_t)row * 4 + wc] = q;
                } else if (pn == 1) {
                    { const f32x4 v0 = acc[ai][0][m][0], v1 = acc[ai][0][m][1]; *(u32x4*)(rowp + EPI_LCOL(0)) = pack8(v0, v1);
                      float q = ((v0[0] * v0[0] + v0[1] * v0[1]) + (v0[2] * v0[2] + v0[3] * v0[3])) + ((v1[0] * v1[0] + v1[1] * v1[1]) + (v1[2] * v1[2] + v1[3] * v1[3]));
                      q += swz_xor<16>(q); q = xor32_add(q); if (fq == 0) statKV[(size_t)row * 4 + wc] = q; }
                    if (wc == 0) { const f32x4 v0 = acc[ai][1][m][0], v1 = acc[ai][1][m][1]; const float x[8] = {v0[0], v0[1], v0[2], v0[3], v1[0], v1[1], v1[2], v1[3]};
                        const f32x4 c01 = *(const f32x4*)(cs + (size_t)row * 16 + 4 * fq), c23 = *(const f32x4*)(cs + (size_t)row * 16 + 4 * fq + 2);
                        const float cc[4] = {c01[0], c01[2], c23[0], c23[2]}, ss[4] = {c01[1], c01[3], c23[1], c23[3]}; float o[8];
#pragma unroll
                        for (int e = 0; e < 4; ++e) { o[2 * e] = x[2 * e] * cc[e] - x[2 * e + 1] * ss[e]; o[2 * e + 1] = x[2 * e] * ss[e] + x[2 * e + 1] * cc[e]; }
                        u32x4 w; w.x = cvt_pk_bf16(o[0], o[1]); w.y = cvt_pk_bf16(o[2], o[3]); w.z = cvt_pk_bf16(o[4], o[5]); w.w = cvt_pk_bf16(o[6], o[7]);
                        const int b = row >> 12, s = row & 4095;
#pragma unroll
                        for (int h = 0; h < 8; ++h) *(u32x4*)(Kb + ((size_t)(b * 8 + h) * SEQ + s) * 96 + 64 + 8 * fq) = w; }
                } else if (pn < 6) { float s = 0.f, q = 0.f;
#pragma unroll
                    for (int bj = 0; bj < 2; ++bj) { f32x4 v0 = acc[ai][bj][m][0], v1 = acc[ai][bj][m][1];
#pragma unroll
                        for (int e = 0; e < 4; ++e) { v0[e] = geluf(v0[e]); v1[e] = geluf(v1[e]); }
                        *(u32x4*)(rowp + EPI_LCOL(bj)) = pack8(v0, v1);
                        s += ((v0[0] + v0[1]) + (v0[2] + v0[3])) + ((v1[0] + v1[1]) + (v1[2] + v1[3]));
                        q += ((v0[0] * v0[0] + v0[1] * v0[1]) + (v0[2] * v0[2] + v0[3] * v0[3])) + ((v1[0] * v1[0] + v1[1] * v1[1]) + (v1[2] * v1[2] + v1[3] * v1[3])); }
                    if (pn >= 4) { s += swz_xor<16>(s); s = xor32_add(s); q += swz_xor<16>(q); q = xor32_add(q);
                        if (fq == 0) statV[(size_t)row * 8 + (pn - 4) * 4 + wc] = (f32x2){s, q}; }
                } else {
#pragma unroll
                    for (int bj = 0; bj < 2; ++bj) *(u32x4*)(rowp + EPI_LCOL(bj)) = pack8(acc[ai][bj][m][0], acc[ai][bj][m][1]); }
                asm volatile("" ::: "memory"); }
    }
};
struct EpiQ {
    static constexpr bool MID = false;
    const float* statQ; const f32x2* cs; bf16_t* Qb;
    __device__ __forceinline__ void operator()(const AccT& acc, const Unit& u, int wr, int wc, int fr, int fq) const {
#pragma unroll
        for (int ai = 0; ai < 2; ++ai)
#pragma unroll
            for (int m = 0; m < 4; ++m) { const int row = EPI_ROW(u, ai, m); const f32x4 sq = *(const f32x4*)(statQ + (size_t)row * 4);
                const float rq = rsqrtf(((sq[0] + sq[1]) + (sq[2] + sq[3])) * (1.f / 256.f) + EPS); const int b = row >> 12, s = row & 4095;
#pragma unroll
                for (int bj = 0; bj < 2; ++bj) { const int col = u.pn * 256 + EPI_LCOL(bj), h = col / 96, j = col - h * 96;
                    const f32x4 v0 = acc[ai][bj][m][0] * rq, v1 = acc[ai][bj][m][1] * rq; u32x4 w;
                    if (j >= 64) { const int i0 = (j - 64) >> 1; const float x[8] = {v0[0], v0[1], v0[2], v0[3], v1[0], v1[1], v1[2], v1[3]};
                        const f32x4 c01 = *(const f32x4*)(cs + (size_t)row * 16 + i0), c23 = *(const f32x4*)(cs + (size_t)row * 16 + i0 + 2);
                        const float cc[4] = {c01[0], c01[2], c23[0], c23[2]}, ss[4] = {c01[1], c01[3], c23[1], c23[3]}; float o[8];
#pragma unroll
                        for (int e = 0; e < 4; ++e) { o[2 * e] = x[2 * e] * cc[e] - x[2 * e + 1] * ss[e]; o[2 * e + 1] = x[2 * e] * ss[e] + x[2 * e + 1] * cc[e]; }
                        w.x = cvt_pk_bf16(o[0], o[1]); w.y = cvt_pk_bf16(o[2], o[3]); w.z = cvt_pk_bf16(o[4], o[5]); w.w = cvt_pk_bf16(o[6], o[7]);
                    } else w = pack8(v0, v1);
                    *(u32x4*)(Qb + ((size_t)(b * 8 + h) * SEQ + s) * 96 + j) = w; }
                asm volatile("" ::: "memory"); }
    }
};
struct EpiK {
    static constexpr bool MID = false;
    const float* statKV; bf16_t* Kb;
    __device__ __forceinline__ void operator()(const AccT& acc, const Unit& u, int wr, int wc, int fr, int fq) const {
#pragma unroll
        for (int ai = 0; ai < 2; ++ai)
#pragma unroll
            for (int m = 0; m < 4; ++m) { const int row = EPI_ROW(u, ai, m); const f32x4 sq = *(const f32x4*)(statKV + (size_t)row * 4);
                const float rk = rsqrtf(((sq[0] + sq[1]) + (sq[2] + sq[3])) * (1.f / 128.f) + EPS); const int b = row >> 12, s = row & 4095;
#pragma unroll
                for (int bj = 0; bj < 2; ++bj) { const int col = u.pn * 256 + EPI_LCOL(bj), h = col >> 6, j = col & 63;
                    *(u32x4*)(Kb + ((size_t)(b * 8 + h) * SEQ + s) * 96 + j) = pack8(acc[ai][bj][m][0] * rk, acc[ai][bj][m][1] * rk); }
                asm volatile("" ::: "memory"); }
    }
};
struct EpiVT {
    static constexpr bool MID = false;
    const float* statKV; bf16_t* Vt;
    __device__ __forceinline__ void operator()(const AccT& acc, const Unit& u, int wr, int wc, int fr, int fq) const {
#pragma unroll
        for (int bj = 0; bj < 2; ++bj) { const int tok = u.pn * 256 + EPI_LCOL(bj), b = tok >> 12, s = tok & 4095; float rk[8];
#pragma unroll
            for (int e = 0; e < 8; ++e) { const f32x4 sq = *(const f32x4*)(statKV + (size_t)(tok + e) * 4); rk[e] = rsqrtf(((sq[0] + sq[1]) + (sq[2] + sq[3])) * (1.f / 128.f) + EPS); }
#pragma unroll
            for (int ai = 0; ai < 2; ++ai)
#pragma unroll
                for (int m = 0; m < 4; ++m) { const int hd = EPI_ROW(u, ai, m); f32x4 v0 = acc[ai][bj][m][0], v1 = acc[ai][bj][m][1];
#pragma unroll
                    for (int e = 0; e < 4; ++e) { v0[e] *= rk[e]; v1[e] *= rk[4 + e]; }
                    *(u32x4*)(Vt + ((size_t)b * 512 + hd) * SEQ + s) = pack8(v0, v1);
                    asm volatile("" ::: "memory"); } }
    }
};

__device__ __forceinline__ int colmap(int map, int n) {
    switch (map) {
    case 1: { if (n < 384) return n; if (n < 416) { const int j = n - 384, i = j >> 1; return 384 + ((j & 1) ? i + 16 : i); } if (n < 512) return -1; if (n < 1024) return 416 + (n - 512); if (n < 1536) return 928 + (n - 1024); return 1440 + (n - 1536); }
    case 2: { const int h = n / 96, j = n - h * 96; if (j < 64) return n; const int jj = j - 64, i = jj >> 1; return h * 96 + 64 + ((jj & 1) ? i + 16 : i); }
    case 3: return (n >> 6) * 128 + (n & 63);
    case 4: return (n >> 6) * 128 + 64 + (n & 63);
    default: return n;
    }
}
__device__ __forceinline__ void conv_w(const float* W, bf16_t* WT, int K, int Nsrc, int Ndst, int map, const float* rs, const float* rs2, float cscale, int cs_upto, int gt, int GT) {
    const int nitem = Ndst * (K >> 3);
    const int nb8 = Ndst >> 3;
    for (int it = gt; it < nitem; it += GT) { const int rest = it >> 6, n = (rest % nb8) * 8 + ((it >> 3) & 7), k0 = ((rest / nb8) * 8 + (it & 7)) * 8; const int src = colmap(map, n); const float cs = (n < cs_upto) ? cscale : 1.f; float v[8];
#pragma unroll
        for (int e = 0; e < 8; ++e) { const int k = k0 + e; float w = (src >= 0) ? W[(size_t)k * Nsrc + src] : 0.f; if (rs) w *= (rs2 && k >= 512) ? rs2[k - 512] : rs[k]; v[e] = w * cs; }
        u32x4 o; o.x = cvt_pk_bf16(v[0], v[1]); o.y = cvt_pk_bf16(v[2], v[3]); o.z = cvt_pk_bf16(v[4], v[5]); o.w = cvt_pk_bf16(v[6], v[7]);
        *(u32x4*)(WT + (size_t)n * K + k0) = o; }
}
__device__ __forceinline__ void conv_flat(const float* src, bf16_t* dst, size_t n8, int gt, int GT) {
    size_t i = gt;
    for (; i + 3 * (size_t)GT < n8; i += 4 * (size_t)GT) { f32x4 a[4], b[4];
#pragma unroll
        for (int j = 0; j < 4; ++j) { a[j] = __builtin_nontemporal_load((const f32x4*)(src + (i + j * (size_t)GT) * 8)); b[j] = __builtin_nontemporal_load((const f32x4*)(src + (i + j * (size_t)GT) * 8 + 4)); }
#pragma unroll
        for (int j = 0; j < 4; ++j) *(u32x4*)(dst + (i + j * (size_t)GT) * 8) = pack8(a[j], b[j]); }
    for (; i < n8; i += GT) { const f32x4 a = *(const f32x4*)(src + i * 8), b = *(const f32x4*)(src + i * 8 + 4); *(u32x4*)(dst + i * 8) = pack8(a, b); }
}

struct Args { const void* in[25]; float* out; unsigned char* ws; };

__device__ __forceinline__ int kappa(int r) { return (r & ~12) | ((r & 4) << 1) | ((r & 8) >> 1); }
constexpr int EK_ROW = 72, EK_BUF = 64 * EK_ROW * 2, EV_STAGE = 4 * EK_BUF + 256;
__device__ __forceinline__ void even_item(int wsg, unsigned char* lds, const bf16_t* H0, const int* pos, const float* sink, const float* convw, bf16_t* Y0, int b, int q0) {
    int tid_ = tid_from(wsg); asm volatile("" : "+v"(tid_));
    const int tid = tid_, lane = tid & 63, wid = tid >> 6, r32 = lane & 31, hi = lane >> 5;
    const int h = wid, kvh = h >> 2;
    const size_t tb = (size_t)b * SEQ;
    bf16x8 qf[2][4]; float posq[2];
#pragma unroll
    for (int qb = 0; qb < 2; ++qb) { const size_t t = tb + q0 + 32 * qb + r32; posq[qb] = (float)pos[t];
#pragma unroll
        for (int ks = 0; ks < 4; ++ks) qf[qb][ks] = *(const bf16x8*)(H0 + t * EV_IN + h * 64 + 16 * ks + 8 * hi); }
    const float slope2 = exp2f(-(float)(h + 1)) * LOG2E, sink2 = sink[h] * LOG2E;
    f32x16 O[2][2]; float mrun[2], lrun[2];
#pragma unroll
    for (int qb = 0; qb < 2; ++qb) { mrun[qb] = sink2; lrun[qb] = (hi == 0) ? 1.f : 0.f; O[qb][0] = (f32x16){}; O[qb][1] = (f32x16){}; }
    u32x4 gk[2], gv[2]; float gp = 0.f;
#define EV_ISSUE(j_) do { const int kbase_ = q0 - 128 + 64 * (j_); \
        _Pragma("unroll") for (int i = 0; i < 2; ++i) { const int c = tid + i * 512; \
            { const int key = (c >> 3) & 63, ch = c & 7, kg = min(max(kbase_ + key, 0), SEQ - 1); gk[i] = *(const u32x4*)(H0 + (tb + kg) * EV_IN + 512 + i * 64 + ch * 8); } \
            { const int key = c & 63, ch = (c >> 6) & 7, kg = min(max(kbase_ + key, 0), SEQ - 1); gv[i] = *(const u32x4*)(H0 + (tb + kg) * EV_IN + 640 + i * 64 + ch * 8); } } \
        { const int kg = min(max(kbase_ + (tid & 63), 0), SEQ - 1); gp = (float)pos[tb + kg]; } } while (0)
#define EV_COMMIT(p_) do { unsigned char* base_ = lds + (p_) * EV_STAGE; \
        _Pragma("unroll") for (int i = 0; i < 2; ++i) { const int c = tid + i * 512; \
            { const int key = (c >> 3) & 63, ch = c & 7; *(u32x4*)(base_ + i * EK_BUF + (key * EK_ROW + ch * 8) * 2) = gk[i]; } \
            { const int key = c & 63, ch = (c >> 6) & 7; const u32x4 v = gv[i]; bf16_t* vt = (bf16_t*)(base_ + 2 * EK_BUF + i * EK_BUF) + (ch * 8) * EK_ROW + key; \
              vt[0 * EK_ROW] = (bf16_t)(v.x & 0xffffu); vt[1 * EK_ROW] = (bf16_t)(v.x >> 16); vt[2 * EK_ROW] = (bf16_t)(v.y & 0xffffu); vt[3 * EK_ROW] = (bf16_t)(v.y >> 16); \
              vt[4 * EK_ROW] = (bf16_t)(v.z & 0xffffu); vt[5 * EK_ROW] = (bf16_t)(v.z >> 16); vt[6 * EK_ROW] = (bf16_t)(v.w & 0xffffu); vt[7 * EK_ROW] = (bf16_t)(v.w >> 16); } } \
        ((float*)(base_ + 4 * EK_BUF))[tid & 63] = gp; } while (0)
    __syncthreads();
    EV_ISSUE(0); EV_COMMIT(0);
    __syncthreads();
#pragma unroll 1
    for (int j = 0; j < 5; ++j) {
        const int kbase = q0 - 128 + 64 * j; const int pbuf = j & 1;
        if (j + 1 < 5) EV_ISSUE(j + 1);
        const unsigned char* KLp = lds + pbuf * EV_STAGE; const unsigned char* VTp = KLp + 2 * EK_BUF; const float* posK = (const float*)(KLp + 4 * EK_BUF);
        const unsigned char* kb = KLp + kvh * EK_BUF; const unsigned char* vb = VTp + kvh * EK_BUF;
        f32x16 S[2][2];
#pragma unroll
        for (int rb = 0; rb < 2; ++rb) { bf16x8 kf[4];
#pragma unroll
            for (int ks = 0; ks < 4; ++ks) kf[ks] = *(const bf16x8*)(kb + ((kappa(r32) + 32 * rb) * EK_ROW + 16 * ks + 8 * hi) * 2);
#pragma unroll
            for (int qb = 0; qb < 2; ++qb) { f32x16 a = (f32x16){};
#pragma unroll
                for (int ks = 0; ks < 4; ++ks) a = __builtin_amdgcn_mfma_f32_32x32x16_bf16(kf[ks], qf[qb][ks], a, 0, 0, 0);
                S[qb][rb] = a; } }
#pragma unroll
        for (int qb = 0; qb < 2; ++qb) { const int qg = q0 + 32 * qb + r32; float mx = -1e30f;
            const int lo = max(-kbase, qg - 128 - kbase) - 8 * hi; const unsigned span = (unsigned)(min(SEQ - 1 - kbase, qg + 128 - kbase) - 8 * hi - lo);
            const float* pk_ = posK + 8 * hi;
#pragma unroll
            for (int rb = 0; rb < 2; ++rb)
#pragma unroll
                for (int hf = 0; hf < 2; ++hf) {
                    const f32x4 pa = *(const f32x4*)(pk_ + 32 * rb + 16 * hf), pb = *(const f32x4*)(pk_ + 32 * rb + 16 * hf + 4);
                    const float pkv[8] = {pa[0], pa[1], pa[2], pa[3], pb[0], pb[1], pb[2], pb[3]};
#pragma unroll
                    for (int i = 0; i < 8; ++i) { const int r = 8 * hf + i, c = 32 * rb + i + 16 * hf;
                        const float bias = slope2 * fabsf(posq[qb] - pkv[i]); const float sv0 = S[qb][rb][r] - bias;
                        const bool valid = (unsigned)(c - lo) <= span;
                        const float sv = valid ? sv0 : -1e30f; S[qb][rb][r] = sv; mx = fmaxf(mx, sv); }
                    __builtin_amdgcn_sched_barrier(0); }
            mx = xor32_max(mx);
            const float mnew = fmaxf(mrun[qb], mx), alpha = __builtin_amdgcn_exp2f(mrun[qb] - mnew); mrun[qb] = mnew; float ps = 0.f;
#pragma unroll
            for (int rb = 0; rb < 2; ++rb)
#pragma unroll
                for (int r = 0; r < 16; ++r) { const float p = __builtin_amdgcn_exp2f(S[qb][rb][r] - mnew); S[qb][rb][r] = p; ps += p; }
            lrun[qb] = lrun[qb] * alpha + ps;
#pragma unroll
            for (int db = 0; db < 2; ++db) O[qb][db] *= alpha; }
#pragma unroll
        for (int mm = 0; mm < 4; ++mm) { bf16x8 pf[2];
#pragma unroll
            for (int qb = 0; qb < 2; ++qb) { const f32x16& s = S[qb][mm >> 1]; const int o = 8 * (mm & 1); u32x4 w;
                w.x = cvt_pk_bf16(s[o + 0], s[o + 1]); w.y = cvt_pk_bf16(s[o + 2], s[o + 3]); w.z = cvt_pk_bf16(s[o + 4], s[o + 5]); w.w = cvt_pk_bf16(s[o + 6], s[o + 7]); pf[qb] = __builtin_bit_cast(bf16x8, w); }
#pragma unroll
            for (int db = 0; db < 2; ++db) { const bf16x8 vf = *(const bf16x8*)(vb + ((32 * db + r32) * EK_ROW + 16 * mm + 8 * hi) * 2);
#pragma unroll
                for (int qb = 0; qb < 2; ++qb) O[qb][db] = __builtin_amdgcn_mfma_f32_32x32x16_bf16(vf, pf[qb], O[qb][db], 0, 0, 0); } }
        if (j + 1 < 5) EV_COMMIT(pbuf ^ 1);
        __syncthreads();
    }
#undef EV_ISSUE
#undef EV_COMMIT
    float* ssq = (float*)lds;
#pragma unroll
    for (int qb = 0; qb < 2; ++qb) { float l = lrun[qb]; l = xor32_add(l); const float il = 1.f / l; float q = 0.f;
#pragma unroll
        for (int db = 0; db < 2; ++db) { O[qb][db] *= il;
#pragma unroll
            for (int r = 0; r < 16; ++r) q += O[qb][db][r] * O[qb][db][r]; }
        q = xor32_add(q); if (hi == 0) ssq[h * 64 + 32 * qb + r32] = q; }
    __syncthreads();
#pragma unroll
    for (int qb = 0; qb < 2; ++qb) { float s = 0.f;
#pragma unroll
        for (int hh = 0; hh < 8; ++hh) s += ssq[hh * 64 + 32 * qb + r32];
        const float ra = rsqrtf(s * (1.f / 512.f) + EPS); const size_t t = tb + q0 + 32 * qb + r32;
#pragma unroll
        for (int kp = 0; kp < 4; ++kp) {
            const int db = kp >> 1, ga = (2 * kp) & 3, gb = ga + 1, c16 = 16 * kp + 8 * hi;
            u32x4 zq = *(const u32x4*)(H0 + t * EV_IN + 2304 + h * 64 + c16);
            unsigned z0 = zq.x, z1 = zq.y, z2 = zq.z, z3 = zq.w; swap32(z0, z2); swap32(z1, z3); zq = (u32x4){z0, z1, z2, z3};
            unsigned a0 = cvt_pk_bf16(O[qb][db][4 * ga + 0] * ra * siluf(bflo(zq.x)), O[qb][db][4 * ga + 1] * ra * siluf(bfhi(zq.x))), a1 = cvt_pk_bf16(O[qb][db][4 * ga + 2] * ra * siluf(bflo(zq.y)), O[qb][db][4 * ga + 3] * ra * siluf(bfhi(zq.y)));
            unsigned b0 = cvt_pk_bf16(O[qb][db][4 * gb + 0] * ra * siluf(bflo(zq.z)), O[qb][db][4 * gb + 1] * ra * siluf(bfhi(zq.z))), b1 = cvt_pk_bf16(O[qb][db][4 * gb + 2] * ra * siluf(bflo(zq.w)), O[qb][db][4 * gb + 3] * ra * siluf(bfhi(zq.w)));
            swap32(a0, b0); swap32(a1, b1);
            *(u32x4*)(Y0 + t * DM + h * 64 + c16) = (u32x4){a0, a1, b0, b1}; } }
    { const int c0 = lane * 8; float cw[3][8];
#pragma unroll
        for (int jj = 0; jj < 3; ++jj) { const f32x4 a = *(const f32x4*)(convw + jj * 512 + c0), bq = *(const f32x4*)(convw + jj * 512 + c0 + 4);
#pragma unroll
            for (int e = 0; e < 4; ++e) { cw[jj][e] = a[e]; cw[jj][4 + e] = bq[e]; } }
        const int t0 = q0 + wid * 8; float zp[8], zc[8], zn[8];
#define EV_Z(dst, tt) do { if ((tt) >= 0 && (tt) < SEQ) { const u32x4 cg_ = *(const u32x4*)(H0 + (tb + (tt)) * EV_IN + 1280 + c0), xi_ = *(const u32x4*)(H0 + (tb + (tt)) * EV_IN + 1792 + c0); \
            dst[0] = bflo(cg_.x) * bflo(xi_.x); dst[1] = bfhi(cg_.x) * bfhi(xi_.x); dst[2] = bflo(cg_.y) * bflo(xi_.y); dst[3] = bfhi(cg_.y) * bfhi(xi_.y); \
            dst[4] = bflo(cg_.z) * bflo(xi_.z); dst[5] = bfhi(cg_.z) * bfhi(xi_.z); dst[6] = bflo(cg_.w) * bflo(xi_.w); dst[7] = bfhi(cg_.w) * bfhi(xi_.w); } \
          else { _Pragma("unroll") for (int e_ = 0; e_ < 8; ++e_) dst[e_] = 0.f; } } while (0)
        EV_Z(zp, t0 - 1); EV_Z(zc, t0);
        for (int i = 0; i < 8; ++i) { const int t = t0 + i; EV_Z(zn, t + 1);
            const u32x4 bgw = *(const u32x4*)(H0 + (tb + t) * EV_IN + 768 + c0), zw = *(const u32x4*)(H0 + (tb + t) * EV_IN + 2304 + 512 + c0);
            const float bg[8] = {bflo(bgw.x), bfhi(bgw.x), bflo(bgw.y), bfhi(bgw.y), bflo(bgw.z), bfhi(bgw.z), bflo(bgw.w), bfhi(bgw.w)};
            const float zz[8] = {siluf(bflo(zw.x)), siluf(bfhi(zw.x)), siluf(bflo(zw.y)), siluf(bfhi(zw.y)), siluf(bflo(zw.z)), siluf(bfhi(zw.z)), siluf(bflo(zw.w)), siluf(bfhi(zw.w))};
            float y[8], q = 0.f;
#pragma unroll
            for (int e = 0; e < 8; ++e) { y[e] = bg[e] * (cw[0][e] * zp[e] + cw[1][e] * zc[e] + cw[2][e] * zn[e]); q += y[e] * y[e]; }
            q += swz_xor<1>(q); q += swz_xor<2>(q); q += swz_xor<4>(q); q += swz_xor<8>(q); q += swz_xor<16>(q); q = xor32_add(q);
            const float rb = rsqrtf(q * (1.f / 512.f) + EPS); u32x4 w;
            w.x = cvt_pk_bf16(y[0] * rb * zz[0], y[1] * rb * zz[1]); w.y = cvt_pk_bf16(y[2] * rb * zz[2], y[3] * rb * zz[3]);
            w.z = cvt_pk_bf16(y[4] * rb * zz[4], y[5] * rb * zz[5]); w.w = cvt_pk_bf16(y[6] * rb * zz[6], y[7] * rb * zz[7]);
            *(u32x4*)(Y0 + (tb + t) * DM + 512 + c0) = w;
#pragma unroll
            for (int e = 0; e < 8; ++e) { zp[e] = zc[e]; zc[e] = zn[e]; } }
#undef EV_Z
    }
}

constexpr int GV_ROW = 136, GV_BUF = 128 * GV_ROW * 2;
__device__ __forceinline__ void gmlp_item(int wsg, unsigned char* lds, const bf16_t* H1, const f32x2* statV, const float* lng, const float* lnb, const bf16_t* WSb, const float* bs, bf16_t* Y1, int chunk) {
    int tid_ = tid_from(wsg); asm volatile("" : "+v"(tid_));
    const int tid = tid_, lane = tid & 63, wid = tid >> 6, fr = lane & 15, fq = lane >> 4;
    f32x2* mr = (f32x2*)(lds + 2 * GV_BUF);
    const size_t row0 = (size_t)chunk * 128;
    __syncthreads();
    if (tid < 128) { const f32x2* p = statV + (row0 + tid) * 8; float s = 0.f, q = 0.f;
#pragma unroll
        for (int i = 0; i < 8; ++i) { const f32x2 v = p[i]; s += v.x; q += v.y; }
        const float mean = s * (1.f / 512.f), var = q * (1.f / 512.f) - mean * mean; mr[tid] = (f32x2){mean, rsqrtf(fmaxf(var, 0.f) + EPS)}; }
    const int st_s = (tid >> 2) & 127, st_cl = tid & 3;
    u32x4 gst[4];
#define GM_ISSUE(g_) do { _Pragma("unroll") for (int i = 0; i < 4; ++i) gst[i] = *(const u32x4*)(H1 + (row0 + st_s) * OD_IN + 1024 + (g_) * 128 + (st_cl + 4 * i) * 8); } while (0)
#define GM_COMMIT(g_, buf_) do { bf16_t* VnT_ = (bf16_t*)(lds + (buf_) * GV_BUF); const f32x2 st = mr[st_s]; \
        _Pragma("unroll") for (int i = 0; i < 4; ++i) { const int ch = st_cl + 4 * i, cb = (g_) * 128 + ch * 8; const u32x4 v = gst[i]; \
            const f32x4 ga = *(const f32x4*)(lng + cb), gb = *(const f32x4*)(lng + cb + 4), ba = *(const f32x4*)(lnb + cb), bb = *(const f32x4*)(lnb + cb + 4); \
            const float x[8] = {bflo(v.x), bfhi(v.x), bflo(v.y), bfhi(v.y), bflo(v.z), bfhi(v.z), bflo(v.w), bfhi(v.w)}; \
            const float gg[8] = {ga[0], ga[1], ga[2], ga[3], gb[0], gb[1], gb[2], gb[3]}, bbv[8] = {ba[0], ba[1], ba[2], ba[3], bb[0], bb[1], bb[2], bb[3]}; \
            _Pragma("unroll") for (int e = 0; e < 8; ++e) VnT_[(ch * 8 + e) * GV_ROW + st_s] = f2bf((x[e] - st.x) * st.y * gg[e] + bbv[e]); } } while (0)
    unsigned ydp[4][8][2]; float q = 0.f;
    const size_t trow = row0 + 16 * wid + fr;
    GM_ISSUE(0);
    __syncthreads();
    GM_COMMIT(0, 0);
    __syncthreads();
#pragma unroll
    for (int g = 0; g < 4; ++g) {
        if (g < 3) GM_ISSUE(g + 1);
        const bf16_t* VnT = (const bf16_t*)(lds + (g & 1) * GV_BUF);
        bf16x8 wf[4];
#pragma unroll
        for (int ks = 0; ks < 4; ++ks) wf[ks] = *(const bf16x8*)(WSb + ((size_t)g * 128 + 16 * wid + fr) * 128 + 32 * ks + 8 * fq);
        const float bsv = bs[g * 128 + 16 * wid + fr];
#pragma unroll
        for (int nb = 0; nb < 8; ++nb) { f32x4 a = (f32x4){0.f, 0.f, 0.f, 0.f};
#pragma unroll
            for (int ks = 0; ks < 4; ++ks) { const bf16x8 vf = *(const bf16x8*)(VnT + (16 * nb + fr) * GV_ROW + 32 * ks + 8 * fq); a = __builtin_amdgcn_mfma_f32_16x16x32_bf16(vf, wf[ks], a, 0, 0, 0); }
            const int d = g * 128 + 16 * nb + 4 * fq; const u32x2 uw = *(const u32x2*)(H1 + trow * OD_IN + 512 + d);
            const float y0 = bflo(uw.x) * (a[0] + bsv), y1 = bfhi(uw.x) * (a[1] + bsv), y2 = bflo(uw.y) * (a[2] + bsv), y3 = bfhi(uw.y) * (a[3] + bsv);
            q += (y0 * y0 + y1 * y1) + (y2 * y2 + y3 * y3); ydp[g][nb][0] = cvt_pk_bf16(y0, y1); ydp[g][nb][1] = cvt_pk_bf16(y2, y3); }
        if (g < 3) GM_COMMIT(g + 1, (g + 1) & 1);
        __syncthreads();
        __builtin_amdgcn_sched_barrier(0);
    }
#undef GM_ISSUE
#undef GM_COMMIT
    q += swz_xor<16>(q); q = xor32_add(q);
    const float rd = rsqrtf(q * (1.f / 512.f) + EPS);
#pragma unroll
    for (int g = 0; g < 4; ++g)
#pragma unroll
        for (int nb = 0; nb < 8; ++nb) { const int d = g * 128 + 16 * nb + 4 * fq; const u32x2 zw = *(const u32x2*)(H1 + trow * OD_IN + 1536 + 512 + d); u32x2 w;
            w.x = cvt_pk_bf16(bflo(ydp[g][nb][0]) * rd * siluf(bflo(zw.x)), bfhi(ydp[g][nb][0]) * rd * siluf(bfhi(zw.x))); w.y = cvt_pk_bf16(bflo(ydp[g][nb][1]) * rd * siluf(bflo(zw.y)), bfhi(ydp[g][nb][1]) * rd * siluf(bfhi(zw.y)));
            *(u32x2*)(Y1 + trow * DM + 512 + d) = w; }
}

constexpr int MK_ROW = 104, MK_BUF = 64 * MK_ROW * 2, MV_ROW = 72, MV_BUF = 64 * MV_ROW * 2;
__device__ __forceinline__ void mla_unit(int wsg, unsigned char* lds, const bf16_t* Qb, const bf16_t* Kb, const bf16_t* Vt, const bf16_t* H1, bf16_t* Y1, float* ssqC, int bh, int qblk) {
    int tid_ = tid_from(wsg); asm volatile("" : "+v"(tid_));
    const int tid = tid_, lane = tid & 63, wid = tid >> 6, r32 = lane & 31, hi = lane >> 5;
    const int b = bh >> 3, h = bh & 7;
    const bf16_t* Kg = Kb + (size_t)bh * SEQ * 96; const bf16_t* Vg = Vt + (size_t)bh * 64 * SEQ;
    const int qrow0 = qblk * 512 + wid * 64;
    bf16x8 qf[2][6];
#pragma unroll
    for (int qb = 0; qb < 2; ++qb)
#pragma unroll
        for (int ks = 0; ks < 6; ++ks) qf[qb][ks] = *(const bf16x8*)(Qb + ((size_t)bh * SEQ + qrow0 + 32 * qb + r32) * 96 + 16 * ks + 8 * hi);
    f32x16 O[2][2]; float mrun[2], lrun[2];
#pragma unroll
    for (int qb = 0; qb < 2; ++qb) { mrun[qb] = -1e30f; lrun[qb] = 0.f; O[qb][0] = (f32x16){}; O[qb][1] = (f32x16){}; }
    const int kc0 = tid, kc1 = tid + 512; const int vc = (tid >= 256) ? tid - 256 : tid + 256;
    const int k0_key = kc0 / 12, k0_ch = kc0 - k0_key * 12, k1_key = kc1 / 12, k1_ch = kc1 - k1_key * 12;
    const unsigned k0_l = (k0_key * MK_ROW + k0_ch * 8) * 2, k1_l = (k1_key * MK_ROW + k1_ch * 8) * 2, v_l = ((vc >> 3) * MV_ROW + (vc & 7) * 8) * 2;
    const bf16_t* vsrc = Vg + (size_t)(vc >> 3) * SEQ + (vc & 7) * 8;
    u32x4 g0, g1, g2 = (u32x4){0u, 0u, 0u, 0u};
#define MLA_ISSUE(t) do { g0 = *(const u32x4*)(Kg + (size_t)(t) * 64 * 96 + kc0 * 8); if (tid < 256) { g1 = *(const u32x4*)(Kg + (size_t)(t) * 64 * 96 + kc1 * 8); g2 = *(const u32x4*)(vsrc + (t) * 64); } else { g1 = *(const u32x4*)(vsrc + (t) * 64); } } while (0)
#define MLA_COMMIT(p) do { unsigned char* kb_ = lds + (p) * MK_BUF; unsigned char* vb_ = lds + 2 * MK_BUF + (p) * MV_BUF; *(u32x4*)(kb_ + k0_l) = g0; \
        if (tid < 256) { *(u32x4*)(kb_ + k1_l) = g1; *(u32x4*)(vb_ + v_l) = g2; } else { *(u32x4*)(vb_ + v_l) = g1; } } while (0)
    __syncthreads();
    MLA_ISSUE(0); MLA_COMMIT(0);
    __syncthreads();
    const int krow = kappa(r32);
    for (int t = 0; t < 64; ++t) {
        const int p = t & 1;
        if (t + 1 < 64) MLA_ISSUE(t + 1);
        const unsigned char* kb = lds + p * MK_BUF; const unsigned char* vb = lds + 2 * MK_BUF + p * MV_BUF;
        f32x16 S[2][2];
#pragma unroll
        for (int rb = 0; rb < 2; ++rb) { bf16x8 kf[6];
#pragma unroll
            for (int ks = 0; ks < 6; ++ks) kf[ks] = *(const bf16x8*)(kb + ((krow + 32 * rb) * MK_ROW + 16 * ks + 8 * hi) * 2);
#pragma unroll
            for (int qb = 0; qb < 2; ++qb) { f32x16 a = (f32x16){};
#pragma unroll
                for (int ks = 0; ks < 6; ++ks) a = __builtin_amdgcn_mfma_f32_32x32x16_bf16(kf[ks], qf[qb][ks], a, 0, 0, 0);
                S[qb][rb] = a; } }
#pragma unroll
        for (int qb = 0; qb < 2; ++qb) { float mx = -1e30f;
#pragma unroll
            for (int rb = 0; rb < 2; ++rb)
#pragma unroll
                for (int r = 0; r < 16; ++r) mx = fmaxf(mx, S[qb][rb][r]);
            if (__builtin_expect(__builtin_amdgcn_ballot_w64(mx - mrun[qb] > 8.0f) != 0ull, 0)) { mx = xor32_max(mx);
                const float mnew_ = fmaxf(mrun[qb], mx), alpha = __builtin_amdgcn_exp2f(mrun[qb] - mnew_); mrun[qb] = mnew_; lrun[qb] *= alpha;
#pragma unroll
                for (int db = 0; db < 2; ++db) O[qb][db] *= alpha; }
            const float mnew = mrun[qb]; float ps = 0.f;
#pragma unroll
            for (int rb = 0; rb < 2; ++rb)
#pragma unroll
                for (int r = 0; r < 16; ++r) { const float pe = __builtin_amdgcn_exp2f(S[qb][rb][r] - mnew); S[qb][rb][r] = pe; ps += pe; }
            lrun[qb] += ps; }
#pragma unroll
        for (int mm = 0; mm < 4; ++mm) { bf16x8 pf[2];
#pragma unroll
            for (int qb = 0; qb < 2; ++qb) { const f32x16& s = S[qb][mm >> 1]; const int o = 8 * (mm & 1); u32x4 w;
                w.x = cvt_pk_bf16(s[o + 0], s[o + 1]); w.y = cvt_pk_bf16(s[o + 2], s[o + 3]); w.z = cvt_pk_bf16(s[o + 4], s[o + 5]); w.w = cvt_pk_bf16(s[o + 6], s[o + 7]); pf[qb] = __builtin_bit_cast(bf16x8, w); }
#pragma unroll
            for (int db = 0; db < 2; ++db) { const bf16x8 vf = *(const bf16x8*)(vb + ((32 * db + r32) * MV_ROW + 16 * mm + 8 * hi) * 2);
#pragma unroll
                for (int qb = 0; qb < 2; ++qb) O[qb][db] = __builtin_amdgcn_mfma_f32_32x32x16_bf16(vf, pf[qb], O[qb][db], 0, 0, 0); } }
        if (t + 1 < 64) MLA_COMMIT(p ^ 1);
        __syncthreads();
    }
#undef MLA_ISSUE
#undef MLA_COMMIT
#pragma unroll
    for (int qb = 0; qb < 2; ++qb) { float l = lrun[qb]; l = xor32_add(l); const float il = 1.f / l; float q = 0.f;
        const size_t t = (size_t)b * SEQ + qrow0 + 32 * qb + r32;
#pragma unroll
        for (int db = 0; db < 2; ++db) { O[qb][db] *= il;
#pragma unroll
            for (int r = 0; r < 16; ++r) q += O[qb][db][r] * O[qb][db][r]; }
        q = xor32_add(q); if (hi == 0) ssqC[t * 8 + h] = q;
#pragma unroll
        for (int kp = 0; kp < 4; ++kp) {
            const int db = kp >> 1, ga = (2 * kp) & 3, gb = ga + 1, c16 = 16 * kp + 8 * hi;
            u32x4 zq = *(const u32x4*)(H1 + t * OD_IN + 1536 + h * 64 + c16);
            unsigned z0 = zq.x, z1 = zq.y, z2 = zq.z, z3 = zq.w; swap32(z0, z2); swap32(z1, z3); zq = (u32x4){z0, z1, z2, z3};
            unsigned a0 = cvt_pk_bf16(O[qb][db][4 * ga + 0] * siluf(bflo(zq.x)), O[qb][db][4 * ga + 1] * siluf(bfhi(zq.x))), a1 = cvt_pk_bf16(O[qb][db][4 * ga + 2] * siluf(bflo(zq.y)), O[qb][db][4 * ga + 3] * siluf(bfhi(zq.y)));
            unsigned b0 = cvt_pk_bf16(O[qb][db][4 * gb + 0] * siluf(bflo(zq.z)), O[qb][db][4 * gb + 1] * siluf(bfhi(zq.z))), b1 = cvt_pk_bf16(O[qb][db][4 * gb + 2] * siluf(bflo(zq.w)), O[qb][db][4 * gb + 3] * siluf(bfhi(zq.w)));
            swap32(a0, b0); swap32(a1, b1);
            *(u32x4*)(Y1 + t * DM + h * 64 + c16) = (u32x4){a0, a1, b0, b1}; } }
}

#define XB_TMO      128
#define XB_XCNT(j)  (256  + 64 * (j))
#define XB_XSUB(j)  (1280 + 64 * (j))
#define XB_XGEN(j)  (2304 + 64 * (j))
#define XB_TOP      3328
#define XB_TOPGEN   3392
#define XCD_BAR_WORDS 3456
#define XB_SPIN_CAP (1u << 18)
__device__ __forceinline__ unsigned xb_ld(unsigned* p)              { return __hip_atomic_load(p, __ATOMIC_RELAXED, __HIP_MEMORY_SCOPE_AGENT); }
__device__ __forceinline__ unsigned xb_add(unsigned* p, unsigned v) { return __hip_atomic_fetch_add(p, v, __ATOMIC_RELAXED, __HIP_MEMORY_SCOPE_AGENT); }
__device__ __forceinline__ unsigned xb_xcc_id() { return (unsigned)__builtin_amdgcn_s_getreg((3 << 11) | 20) & 0xFu; }
#define XB_SPIN(cond, bar) do { unsigned _sp = 0; while (cond) { __builtin_amdgcn_s_sleep(1); \
    if ((++_sp & 255u) == 0u) { if (xb_ld(&(bar)[XB_TMO])) break; if (_sp > XB_SPIN_CAP) { atomicAdd(&(bar)[XB_TMO], 1u); break; } } } } while (0)
__device__ __forceinline__ void xcd_barrier_complete(unsigned* bar, unsigned x, unsigned& nloc, unsigned& nx) {
    const unsigned G = gridDim.x * gridDim.y * gridDim.z;
    unsigned sum, cnt, mine, sp = 0u;
    for (;;) {
        sum = 0u; cnt = 0u; mine = 0u;
#pragma unroll
        for (unsigned j = 0; j < 16; ++j) { const unsigned c = xb_ld(&bar[XB_XCNT(j)]); sum += c; cnt += (c > 0u) ? 1u : 0u; mine = (j == x) ? c : mine; }
        if (sum == G) break;
        __builtin_amdgcn_s_sleep(1);
        if ((++sp & 255u) == 0u) { if (xb_ld(&bar[XB_TMO])) break; if (sp > XB_SPIN_CAP) { atomicAdd(&bar[XB_TMO], 1u); break; } }
    }
    nloc = mine > 0u ? mine : 1u; nx = cnt > 0u ? cnt : 1u;
}
__device__ __forceinline__ void xcd_barrier(unsigned* bar, volatile LAS unsigned* st, int wsg) {
    asm volatile("s_waitcnt vmcnt(0)" ::: "memory");
    __syncthreads();
    if (tid_from(wsg) == 0) {
        __builtin_amdgcn_s_waitcnt(0);
        const unsigned x = xb_xcc_id();
        unsigned nloc = st[0], nx = st[1];
        if (nloc == 0u) { xcd_barrier_complete(bar, x, nloc, nx); st[0] = nloc; st[1] = nx; }
        const unsigned old = xb_add(&bar[XB_XSUB(x)], 1u);
        const unsigned gen = old / nloc;
        if (old + 1u == (gen + 1u) * nloc) {
            __builtin_amdgcn_fence(__ATOMIC_RELEASE, "agent");
            asm volatile("s_waitcnt vmcnt(0)" ::: "memory");
            const unsigned og = xb_add(&bar[XB_TOP], 1u);
            const unsigned tg = og / nx;
            if (og + 1u == (tg + 1u) * nx) xb_add(&bar[XB_TOPGEN], 1u);
            else XB_SPIN(xb_ld(&bar[XB_TOPGEN]) == tg, bar);
            __builtin_amdgcn_fence(__ATOMIC_ACQUIRE, "agent");
            xb_add(&bar[XB_XGEN(x)], 1u);
            asm volatile("s_waitcnt vmcnt(0)" ::: "memory");
        } else {
            XB_SPIN(xb_ld(&bar[XB_XGEN(x)]) == gen, bar);
            __builtin_amdgcn_fence(__ATOMIC_ACQUIRE, "agent");
            asm volatile("s_waitcnt vmcnt(0)" ::: "memory");
        }
    }
    __syncthreads();
}

constexpr int LDS_BYTES = 147456;
#ifndef PHMASK
#define PHMASK 0x3ff
#endif
#ifndef DUPMASK
#define DUPMASK 0x000
#endif
#define PH(k) for (int rep_ = 0; rep_ < (((DUPMASK >> (k)) & 1) ? 2 : 1); ++rep_) if constexpr ((PHMASK >> (k)) & 1)
__global__ void __launch_bounds__(512, 2) mega(Args a) {
    extern __shared__ __attribute__((aligned(16))) unsigned char lds_raw[];
    cg::grid_group grid = cg::this_grid();
    LAS unsigned char* lds3 = (LAS unsigned char*)lds_raw;
    unsigned char* lds = lds_raw;
    const int wsg = __builtin_amdgcn_readfirstlane(threadIdx.x >> 6);
    volatile LAS unsigned* xb_st = (volatile LAS unsigned*)(lds3 + (LDS_BYTES - 16));
    if (threadIdx.x < 4) xb_st[threadIdx.x] = 0u;
    __syncthreads();
    if (threadIdx.x == 0) (void)xb_add((unsigned*)(a.ws + WS_BAR) + XB_XCNT(xb_xcc_id()), 1u);
#define SEAM() xcd_barrier((unsigned*)(a.ws + WS_BAR), xb_st, wsg)
#define PHASE_VARS int bid = blockIdx.x, G = gridDim.x; asm volatile("" : "+s"(bid), "+s"(G));
#define INF(i) ((const float*)a.in[i])
#define x_in (INF(0))
#define p_in (INF(1))
#define pos ((const int*)a.in[2])
#define ev_w_in INF(3)
#define ev_conv_w INF(4)
#define ev_sink INF(5)
#define ev_a_norm INF(6)
#define ev_b_norm INF(7)
#define ev_w_out INF(8)
#define od_w_in INF(9)
#define od_q_norm INF(10)
#define od_w_uq INF(11)
#define od_kv_norm INF(12)
#define od_w_ukv INF(13)
#define od_v_ln_g INF(14)
#define od_v_ln_b INF(15)
#define od_w_s INF(16)
#define od_b_s INF(17)
#define od_c_norm INF(18)
#define od_d_norm INF(19)
#define od_w_out INF(20)
#define post_ln_g INF(21)
#define post_ln_b INF(22)
#define ple_proj INF(23)
#define ple_gate INF(24)
#define WSP(T, off) ((T*)(a.ws + (off)))
#define WT_IN0 WSP(bf16_t, WS_WT_IN0)
#define WT_OUT0 WSP(bf16_t, WS_WT_OUT0)
#define WT_GATE0 WSP(bf16_t, WS_WT_GATE0)
#define WT_GATE1 WSP(bf16_t, WS_WT_GATE1)
#define WT_PROJ0 WSP(bf16_t, WS_WT_PROJ0)
#define WT_PROJ1 WSP(bf16_t, WS_WT_PROJ1)
#define WT_IN1 WSP(bf16_t, WS_WT_IN1)
#define WT_UQ WSP(bf16_t, WS_WT_UQ)
#define WT_UK WSP(bf16_t, WS_WT_UK)
#define WT_UV WSP(bf16_t, WS_WT_UV)
#define WT_OUT1 WSP(bf16_t, WS_WT_OUT1)
#define WSB WSP(bf16_t, WS_WSB)
#define GV WSP(float, WS_GV)
#define CS WSP(f32x2, WS_CS)
#define PART WSP(f32x2, WS_PART)
#define STATQ WSP(float, WS_STATQ)
#define STATKV WSP(float, WS_STATKV)
#define STATV WSP(f32x2, WS_STATV)
#define SSQC WSP(float, WS_SSQC)
#define MRBLK WSP(f32x2, WS_MRBLK)
#define XB WSP(bf16_t, WS_XB)
#define PB WSP(bf16_t, WS_PB)
#define PP WSP(bf16_t, WS_PP)
#define QB WSP(bf16_t, WS_PP)
#define H0 WSP(bf16_t, WS_HR)
#define H1 WSP(bf16_t, WS_HR)
#define UB WSP(bf16_t, WS_HR)
#define Y1B ((bf16_t*)a.out)
#define KB WSP(bf16_t, WS_KV)
#define VT WSP(bf16_t, WS_KV + 48 * MiB)

    PH(0) { PHASE_VARS const int tid = tid_from(wsg); const int gt = bid * 512 + tid, GT = G * 512;
        if (G >= 256 && bid < 256) {
            const int layer = bid >> 7, c = (bid & 127) * 8 + (tid & 7), ks = tid >> 3; const float* gate = ple_gate + (size_t)layer * DM * DM; const float* lg = post_ln_g + layer * DM; const float* lb = post_ln_b + layer * DM;
            float s1 = 0.f, s0 = 0.f;
#pragma unroll
            for (int k = ks * 16; k < ks * 16 + 16; ++k) { const float w = gate[(size_t)k * DM + c]; s1 += bf2f(f2bf(w * lg[k])); s0 += w * lb[k]; }
            float* red = (float*)lds; red[tid * 2] = s1; red[tid * 2 + 1] = s0;
            __syncthreads();
            if (tid < 8) { float t1 = 0.f, t0 = 0.f;
                for (int i = 0; i < 64; ++i) { t1 += red[(i * 8 + tid) * 2]; t0 += red[(i * 8 + tid) * 2 + 1]; }
                GV[layer * 2048 + c] = t1; GV[layer * 2048 + 1024 + c] = t0; }
            __syncthreads();
        } else if (G < 256 && bid < 32) {
            const int layer = bid >> 4, c = (bid & 15) * 64 + (tid & 63), kq = tid >> 6; const float* gate = ple_gate + (size_t)layer * DM * DM; const float* lg = post_ln_g + layer * DM; const float* lb = post_ln_b + layer * DM;
            float s1 = 0.f, s0 = 0.f;
            for (int k = kq * 128; k < kq * 128 + 128; ++k) { const float w = gate[(size_t)k * DM + c]; s1 += bf2f(f2bf(w * lg[k])); s0 += w * lb[k]; }
            float* red = (float*)lds; red[(kq * 64 + (tid & 63)) * 2] = s1; red[(kq * 64 + (tid & 63)) * 2 + 1] = s0;
            __syncthreads();
            if (tid < 64) { float t1 = 0.f, t0 = 0.f;
                for (int i = 0; i < 8; ++i) { t1 += red[(i * 64 + tid) * 2]; t0 += red[(i * 64 + tid) * 2 + 1]; }
                GV[layer * 2048 + c] = t1; GV[layer * 2048 + 1024 + c] = t0; }
            __syncthreads();
        }
        conv_w(ev_w_in, WT_IN0, 1024, EV_IN, EV_IN, 0, nullptr, nullptr, 0.125f * LOG2E, 512, gt, GT);
        conv_w(ev_w_out, WT_OUT0, 1024, 1024, 1024, 0, ev_a_norm, ev_b_norm, 1.f, 0, gt, GT);
        conv_w(ple_gate, WT_GATE0, 1024, 1024, 1024, 0, post_ln_g, nullptr, 1.f, 0, gt, GT);
        conv_w(ple_gate + (size_t)DM * DM, WT_GATE1, 1024, 1024, 1024, 0, post_ln_g + DM, nullptr, 1.f, 0, gt, GT);
        conv_w(ple_proj, WT_PROJ0, 256, 1024, 1024, 0, nullptr, nullptr, 1.f, 0, gt, GT);
        conv_w(ple_proj + 256 * DM, WT_PROJ1, 256, 1024, 1024, 0, nullptr, nullptr, 1.f, 0, gt, GT);
        conv_w(od_w_in, WT_IN1, 1024, OD_IN_SRC, OD_IN, 1, nullptr, nullptr, 1.f, 0, gt, GT);
        conv_w(od_w_uq, WT_UQ, 256, 768, 768, 2, od_q_norm, nullptr, 0.10206207261596577f * LOG2E, 768, gt, GT);
        conv_w(od_w_ukv, WT_UK, 128, 1024, 512, 3, od_kv_norm, nullptr, 1.f, 0, gt, GT);
        conv_w(od_w_ukv, WT_UV, 128, 1024, 512, 4, od_kv_norm, nullptr, 1.f, 0, gt, GT);
        conv_w(od_w_out, WT_OUT1, 1024, 1024, 1024, 0, od_c_norm, od_d_norm, 1.f, 0, gt, GT);
        conv_flat(od_w_s, WSB, (size_t)4 * 128 * 128 / 8, gt, GT);
        conv_flat(x_in, XB, (size_t)M * DM / 8, gt, GT);
        conv_flat(p_in, PB, (size_t)2 * M * 256 / 8, gt, GT);
        for (int i = gt; i < M * 16; i += GT) { const int row = i >> 4, j = i & 15; const float inv = exp2f(-(float)j * (13.287712379549449f / 16.f));
            double rev = (double)pos[row] * (double)inv * 0.15915494309189535; rev -= rint(rev); const float rf = (float)rev;
            CS[i] = (f32x2){__builtin_amdgcn_cosf(rf), __builtin_amdgcn_sinf(rf)}; }
    }
    if (a.ws == nullptr) grid.sync();
    SEAM();
    PH(1) { PHASE_VARS
        pg8::StaticOrder S; S.init(M, EV_IN, G, bid); pg8::Gemm g{XB, WT_IN0, M, EV_IN, 1024, 1024, 1024}; EpiStore E{H0, EV_IN, 1000};
        pg8::gemm_phase(wsg, lds3, g, S, E);
        pg8::StaticOrder S2; if (G == 256) S2.init(M, 1024, 128, bid - 128); else S2.init(M, 1024, G, bid);
        pg8::Gemm g2{PB, WT_PROJ0, M, 1024, 256, 256, 256}; EpiStore E2{PP, 1024, 1000};
        if (G != 256 || bid >= 128) pg8::gemm_phase(wsg, lds3, g2, S2, E2);
    }
    SEAM();
    PH(2) { PHASE_VARS for (int it = bid; it < 512; it += G) even_item(wsg, lds, H0, pos, ev_sink, ev_conv_w, XB, it >> 6, (it & 63) * 64); }
    SEAM();
    PH(3) { PHASE_VARS
        pg8::StaticOrder S; S.init(M, 1024, G, bid); pg8::Gemm g{XB, WT_OUT0, M, 1024, 1024, 1024, 1024}; EpiOut<false, false> E{x_in, UB, PART, nullptr};
        pg8::gemm_phase(wsg, lds3, g, S, E);
    }
    SEAM();
#define GATE_PHASE(WTG, LAYER, OUTF, XBOUT) do { \
        pg8::StaticOrder S; S.init(M, 1024, G, bid); \
        { int tq_ = tid_from(wsg); asm volatile("" : "+v"(tq_)); pg8::Unit u_; for (int i_ = tq_ >> 8; i_ < MR_UMAX && S.next(i_, u_); i_ += 2) { const int row_ = u_.pm * 256 + (tq_ & 255); const f32x4* pp_ = (const f32x4*)(PART + (size_t)row_ * 16); float s_ = 0.f, q_ = 0.f; \
              _Pragma("unroll") for (int j_ = 0; j_ < 8; ++j_) { const f32x4 v_ = pp_[j_]; s_ += v_[0] + v_[2]; q_ += v_[1] + v_[3]; } \
              const float mean_ = s_ * (1.f / 1024.f), var_ = q_ * (1.f / 1024.f) - mean_ * mean_; MRBLK[((size_t)bid * MR_UMAX + i_) * 256 + (tq_ & 255)] = (f32x2){mean_, rsqrtf(fmaxf(var_, 0.f) + EPS)}; } } \
        __threadfence_block(); __syncthreads(); \
        pg8::Gemm g{UB, WTG, M, 1024, 1024, 1024, 1024}; \
        EpiGate E{UB, MRBLK + (size_t)bid * MR_UMAX * 256, post_ln_g + (LAYER) * DM, post_ln_b + (LAYER) * DM, GV + (LAYER) * 2048, GV + (LAYER) * 2048 + 1024, PP, OUTF, XBOUT}; \
        pg8::gemm_phase(wsg, lds3, g, S, E); } while (0)
    PH(4) { PHASE_VARS GATE_PHASE(WT_GATE0, 0, (float*)nullptr, XB); }
    SEAM();
    PH(5) { PHASE_VARS
        pg8::StaticOrder S; S.init(M, OD_IN, G, bid); pg8::Gemm g{XB, WT_IN1, M, OD_IN, 1024, 1024, 1024}; EpiH1 E{H1, STATQ, STATKV, STATV, CS, KB};
        pg8::gemm_phase(wsg, lds3, g, S, E);
    }
    SEAM();
    PH(6) { PHASE_VARS
#ifndef P6MASK
#define P6MASK 15
#endif
        if constexpr (P6MASK & 1) { pg8::StaticOrder S; S.init(M, 768, G, bid); pg8::Gemm g{H1, WT_UQ, M, 768, 256, OD_IN, 256}; EpiQ E{STATQ, CS, QB}; pg8::gemm_phase(wsg, lds3, g, S, E); }
        if constexpr (P6MASK & 2) { pg8::StaticOrder S; S.init(M, 512, G, bid); pg8::Gemm g{H1 + 256, WT_UK, M, 512, 128, OD_IN, 128}; EpiK E{STATKV, KB}; pg8::gemm_phase(wsg, lds3, g, S, E); }
        if constexpr (P6MASK & 4) { pg8::StaticOrder S; S.init(512, M, G, bid); pg8::Gemm g{WT_UV, H1 + 256, 512, M, 128, 128, OD_IN}; EpiVT E{STATKV, VT}; pg8::gemm_phase(wsg, lds3, g, S, E); }
        if constexpr (P6MASK & 8) for (int it = bid; it < 256; it += G) gmlp_item(wsg, lds, H1, STATV, od_v_ln_g, od_v_ln_b, WSB, od_b_s, Y1B, it);
    }
    SEAM();
    PH(7) { PHASE_VARS for (int it = bid; it < 512; it += G) { const int xcd = it & 7, idx = it >> 3; mla_unit(wsg, lds, QB, KB, VT, H1, Y1B, SSQC, xcd * 8 + (idx >> 3), idx & 7); } }
    SEAM();
    PH(8) { PHASE_VARS
        pg8::StaticOrder S; S.init(M, 1024, G, bid); pg8::Gemm g{Y1B, WT_OUT1, M, 1024, 1024, 1024, 1024}; EpiOut<true, true> E{XB, UB, PART, SSQC};
        pg8::gemm_phase(wsg, lds3, g, S, E);
        pg8::StaticOrder S2; S2.init(M, 1024, G, bid); pg8::Gemm g2{PB + (size_t)M * 256, WT_PROJ1, M, 1024, 256, 256, 256}; EpiStore E2{PP, 1024, 1000};
        pg8::gemm_phase(wsg, lds3, g2, S2, E2);
    }
    SEAM();
    PH(9) { PHASE_VARS GATE_PHASE(WT_GATE1, 1, a.out, (bf16_t*)nullptr); }
}

extern "C" void kernel_launch(void* const* d_in, const int* in_sizes, int n_in, void* d_out, int out_size, void* d_ws, size_t ws_size, hipStream_t stream) {
    static int grid = 0;
    if (grid == 0) {
        if (n_in != 25 || out_size != M * DM || ws_size < WS_END) { fprintf(stderr, "kernel_launch: unexpected problem (n_in %d out %d ws %zu)\n", n_in, out_size, ws_size); grid = -1; return; }
        int dev = 0, cus = 0, per_cu = 0;
        (void)hipGetDevice(&dev);
        (void)hipDeviceGetAttribute(&cus, hipDeviceAttributeMultiprocessorCount, dev);
        (void)hipFuncSetAttribute((const void*)mega, hipFuncAttributeMaxDynamicSharedMemorySize, LDS_BYTES);
        (void)hipOccupancyMaxActiveBlocksPerMultiprocessor(&per_cu, (const void*)mega, 512, LDS_BYTES);
        if (per_cu < 1) { fprintf(stderr, "kernel_launch: occupancy query reports %d blocks per CU\n", per_cu); }
        grid = cus;
    }
    if (grid < 0) return;
    Args a{};
    for (int i = 0; i < 25; ++i) a.in[i] = d_in[i];
    a.out = (float*)d_out; a.ws = (unsigned char*)d_ws;
    (void)hipMemsetAsync((unsigned char*)d_ws + WS_BAR, 0, XCD_BAR_WORDS * 4, stream);
    void* args[] = {&a};
    hipError_t e = hipLaunchCooperativeKernel((const void*)mega, dim3(grid), dim3(512), args, LDS_BYTES, stream);
    if (e != hipSuccess) fprintf(stderr, "cooperative launch failed: %s (grid %d)\n", hipGetErrorString(e), grid);
}
```

```cpp
#include <hip/hip_runtime.h>
#include <hip/hip_cooperative_groups.h>
#include <cstdio>
#include <cstdint>
namespace cg = cooperative_groups;

#define LAS __attribute__((address_space(3)))
typedef unsigned short bf16_t;
typedef short bf16x8 __attribute__((ext_vector_type(8)));
typedef float f32x4 __attribute__((ext_vector_type(4)));
typedef float f32x2 __attribute__((ext_vector_type(2)));
typedef float f32x16 __attribute__((ext_vector_type(16)));
typedef unsigned u32x4 __attribute__((ext_vector_type(4)));
typedef unsigned u32x2 __attribute__((ext_vector_type(2)));

constexpr int BATCH = 8, SEQ = 4096, DM = 1024, M = BATCH * SEQ;
constexpr int EV_IN = 3328, OD_IN_SRC = 2464, OD_IN = 2560;
constexpr float EPS = 1e-6f, LOG2E = 1.4426950408889634f;
constexpr float DN_ALPHA = 1.4142135623730951f;
constexpr size_t MiB = 1u << 20;
constexpr size_t WS_WT_IN0 = 0, WS_WT_OUT0 = 7 * MiB, WS_WT_GATE0 = 9 * MiB, WS_WT_GATE1 = 11 * MiB, WS_WT_PROJ0 = 13 * MiB, WS_WT_PROJ1 = 13 * MiB + 512 * 1024,
                 WS_WT_IN1 = 14 * MiB, WS_WT_UQ = 19 * MiB, WS_WT_UK = 19 * MiB + 512 * 1024, WS_WT_UV = 19 * MiB + 768 * 1024, WS_WT_OUT1 = 20 * MiB,
                 WS_WSB = 22 * MiB, WS_GV = 22 * MiB + 512 * 1024, WS_CS = 23 * MiB, WS_PART = 27 * MiB, WS_STATQ = 31 * MiB, WS_STATKV = 31 * MiB + 512 * 1024,
                 WS_STATV = 32 * MiB, WS_SSQC = 34 * MiB, WS_MRBLK = 35 * MiB, WS_BAR = 39 * MiB,
                 WS_XB = 40 * MiB, WS_PB = 104 * MiB, WS_PP = 136 * MiB, WS_HR = 200 * MiB, WS_KV = 408 * MiB, WS_END = 488 * MiB;
constexpr int MR_UMAX = 8;

__device__ __forceinline__ unsigned cvt_pk_bf16(float lo, float hi) { unsigned r; asm volatile("v_cvt_pk_bf16_f32 %0, %1, %2" : "=v"(r) : "v"(lo), "v"(hi)); return r; }
__device__ __forceinline__ float bflo(unsigned w) { return __uint_as_float(w << 16); }
__device__ __forceinline__ float bfhi(unsigned w) { return __uint_as_float(w & 0xffff0000u); }
__device__ __forceinline__ float bf2f(bf16_t v) { return __uint_as_float((unsigned)v << 16); }
__device__ __forceinline__ bf16_t f2bf(float f) { return (bf16_t)(cvt_pk_bf16(f, 0.f) & 0xffffu); }
__device__ __forceinline__ float sigm(float x) { return __builtin_amdgcn_rcpf(1.f + __expf(-x)); }
__device__ __forceinline__ float siluf(float x) { return x * sigm(x); }
__device__ __forceinline__ float geluf(float x) { return x * sigm(1.5957691216057308f * (x + 0.044715f * x * x * x)); }
__device__ __forceinline__ u32x4 pack8(const f32x4 a, const f32x4 b) { u32x4 w; w.x = cvt_pk_bf16(a[0], a[1]); w.y = cvt_pk_bf16(a[2], a[3]); w.z = cvt_pk_bf16(b[0], b[1]); w.w = cvt_pk_bf16(b[2], b[3]); return w; }

template <int X> __device__ __forceinline__ float swz_xor(float v) { return __int_as_float(__builtin_amdgcn_ds_swizzle(__float_as_int(v), (X << 10) | 0x1f)); }
__device__ __forceinline__ float xor32_add(float v) { auto rr = __builtin_amdgcn_permlane32_swap(__float_as_uint(v), __float_as_uint(v), false, false); return __uint_as_float(rr[0]) + __uint_as_float(rr[1]); }
__device__ __forceinline__ float xor32_max(float v) { auto rr = __builtin_amdgcn_permlane32_swap(__float_as_uint(v), __float_as_uint(v), false, false); return fmaxf(__uint_as_float(rr[0]), __uint_as_float(rr[1])); }
__device__ __forceinline__ int lane_id_v() { int l; asm volatile("v_mbcnt_lo_u32_b32 %0, -1, 0\n\tv_mbcnt_hi_u32_b32 %0, -1, %0" : "=v"(l)); return l; }
__device__ __forceinline__ int tid_from(int wsg) { int l; asm volatile("v_mbcnt_lo_u32_b32 %0, -1, 0\n\tv_mbcnt_hi_u32_b32 %0, -1, %0" : "=v"(l)); return (wsg << 6) | l; }
__device__ __forceinline__ void swap32(unsigned& a, unsigned& b) { auto r = __builtin_amdgcn_permlane32_swap(a, b, false, false); a = r[0]; b = r[1]; }
namespace pg8 {
constexpr int BM = 256, BK = 64, HALF = 128, HTB = HALF * BK * 2, STAGE_BYTES = 8 * HTB, NXCD = 8, WGM = 8;
__host__ __device__ __forceinline__ int lds_byte(int r, int c) { const int st = (r >> 4) * 2 + (c >> 5), rr = r & 15, cc = c & 31, ob = rr * 64 + cc * 2; return st * 1024 + (ob ^ (((ob >> 9) & 1) << 5)); }
__host__ __device__ __forceinline__ void stage_rc(int b, int& R, int& C) { const int st = b / 1024, sb = b % 1024, swz = sb ^ (((sb >> 9) & 1) << 5); R = (st >> 1) * 16 + swz / 64; C = (st & 1) * 32 + (swz % 64) / 2; }
__host__ __device__ __forceinline__ int perm32(int rho) { const int n = rho >> 4, i = rho & 15; return 8 * (i >> 2) + 4 * n + (i & 3); }
struct Unit { int pm, pn, idx; };
struct Gemm { const bf16_t* A; const bf16_t* Bt; int M, N, K, lda, ldb; };
struct StaticOrder {
    int nM, nN, nwg, G, c;
    __device__ __forceinline__ void init(int M_, int N_, int G_, int c_) { nM = M_ / BM; nN = N_ / BM; nwg = nM * nN; G = G_; c = c_; }
    __device__ __forceinline__ bool next(int i, Unit& u) const {
        const long L = (long)i * G + c; if (L >= nwg) return false;
        int wgid = (int)L; { const int q = nwg / NXCD, r = nwg % NXCD, xcd = wgid % NXCD, off = wgid / NXCD; wgid = (xcd < r ? xcd * (q + 1) : r * (q + 1) + (xcd - r) * q) + off; }
        const int nig = WGM * nN, gid = wgid / nig, fm = gid * WGM, gsz = (nM - fm) < WGM ? (nM - fm) : WGM;
        u.pm = fm + ((wgid % nig) % gsz); u.pn = (wgid % nig) / gsz; u.idx = i; return true;
    }
};
template <class Epi, class Sched>
__device__ __forceinline__ void gemm_phase(int wsg, LAS unsigned char* lds, const Gemm g, const Sched& S, const Epi& E) {
    int tid_ = tid_from(wsg); asm volatile("" : "+v"(tid_));
    const int tid = tid_, wid = __builtin_amdgcn_readfirstlane(tid >> 6), lane = tid & 63, wr = wid >> 2, wc = wid & 3, fr = lane & 15, fq = lane >> 4;
    const int K = g.K, nt = K / BK;
    unsigned voffA[2], voffB[2];
#pragma unroll
    for (int i = 0; i < 2; ++i) { int R, C; stage_rc(tid * 16 + i * 8192, R, C); const int Rb = (R & ~31) + perm32(R & 31);
        voffA[i] = (unsigned)(R * g.lda + C) * 2u; voffB[i] = (unsigned)(Rb * g.ldb + C) * 2u; }
    const size_t kstep = (size_t)(BK * 2);
    const size_t hstepA = (size_t)HALF * g.lda * 2, hstepB = (size_t)HALF * g.ldb * 2;
    const size_t tstepA = 2 * hstepA, tstepB = 2 * hstepB;
    const unsigned ldsw = (unsigned)wid * 1024u;
    const int aoff = lds_byte(wr * 64 + fr, fq * 8), boff = lds_byte(wc * 32 + fr, fq * 8);
#define PG8_SA(b, h) (((b) * 2 + (h)) * HTB)
#define PG8_SB(b, h) ((4 + (b) * 2 + (h)) * HTB)
#define PG8_STAGE(bufoff, gbase, voff) do { _Pragma("unroll") for (int _i = 0; _i < 2; ++_i) \
        __builtin_amdgcn_global_load_lds((const unsigned*)((const char*)(gbase) + (voff)[_i]), (LAS unsigned*)(lds + (bufoff) + ldsw + _i * 8192), 16, 0, 0); } while (0)
#define PG8_LDA(dst, b, h) do { _Pragma("unroll") for (int m = 0; m < 4; ++m) _Pragma("unroll") for (int k = 0; k < 2; ++k) dst[m][k] = *(const LAS bf16x8*)(lds + PG8_SA(b, h) + aoff + m * 2048 + k * 1024); } while (0)
#define PG8_LDB(dst, b, h) do { _Pragma("unroll") for (int n = 0; n < 2; ++n) _Pragma("unroll") for (int k = 0; k < 2; ++k) dst[n][k] = *(const LAS bf16x8*)(lds + PG8_SB(b, h) + boff + n * 2048 + k * 1024); } while (0)
#define PG8_MMA(ai, bj, At, Bt) do { __builtin_amdgcn_s_setprio(1); _Pragma("unroll") for (int m = 0; m < 4; ++m) _Pragma("unroll") for (int n = 0; n < 2; ++n) _Pragma("unroll") for (int k = 0; k < 2; ++k) \
        acc[ai][bj][m][n] = __builtin_amdgcn_mfma_f32_16x16x32_bf16(Bt[n][k], At[m][k], acc[ai][bj][m][n], 0, 0, 0); __builtin_amdgcn_s_setprio(0); } while (0)
#define PG8_WAIT_V(n) asm volatile("s_waitcnt vmcnt(" #n ")" ::: "memory")
#define PG8_WAIT_L(n) asm volatile("s_waitcnt lgkmcnt(" #n ")" ::: "memory")
#define PG8_BAR __builtin_amdgcn_s_barrier()
#define PG8_SCHED __builtin_amdgcn_sched_barrier(0)
    Unit cur, nxt; int ui = 0;
    if (!S.next(0, cur)) return;
    f32x4 acc[2][2][4][2];
#pragma unroll
    for (int a = 0; a < 2; ++a)
#pragma unroll
        for (int b = 0; b < 2; ++b)
#pragma unroll
            for (int m = 0; m < 4; ++m)
#pragma unroll
                for (int n = 0; n < 2; ++n) acc[a][b][m][n] = (f32x4){0.f, 0.f, 0.f, 0.f};
    bf16x8 At[4][2], B0[2][2], B1[2][2];
    const char* cA = (const char*)g.A + (size_t)cur.pm * tstepA; const char* cB = (const char*)g.Bt + (size_t)cur.pn * tstepB;
    PG8_STAGE(PG8_SB(0, 0), cB, voffB); PG8_STAGE(PG8_SB(0, 1), cB + hstepB, voffB); PG8_STAGE(PG8_SA(0, 0), cA, voffA); PG8_STAGE(PG8_SA(0, 1), cA + hstepA, voffA);
    if (wr == 1) PG8_BAR;
    PG8_WAIT_V(2); PG8_BAR;
    PG8_STAGE(PG8_SB(1, 0), cB + kstep, voffB); PG8_STAGE(PG8_SA(1, 0), cA + kstep, voffA); PG8_STAGE(PG8_SB(1, 1), cB + hstepB + kstep, voffB);
    PG8_WAIT_V(6); PG8_BAR;
    for (;;) {
        const bool has_next = S.next(ui + 1, nxt);
        const char* nA = has_next ? (const char*)g.A + (size_t)nxt.pm * tstepA : cA; const char* nB = has_next ? (const char*)g.Bt + (size_t)nxt.pn * tstepB : cB;
        for (int t = 0; t < nt; t += 2) {
            const bool last = (t == nt - 2);
            const char* a1 = cA + (size_t)(t + 1) * kstep;
            const char* a2 = last ? nA : cA + (size_t)(t + 2) * kstep; const char* b2 = last ? nB : cB + (size_t)(t + 2) * kstep;
            const char* a3 = a2 + kstep; const char* b3 = b2 + kstep;
            if constexpr (Epi::MID) { if (t == (nt >> 1)) E.mid(acc, cur, wr, lane_id_v() & 15); }
            PG8_LDB(B0, 0, 0); PG8_LDB(B1, 0, 1); PG8_SCHED; PG8_LDA(At, 0, 0); PG8_STAGE(PG8_SA(1, 1), a1 + hstepA, voffA);
            PG8_WAIT_V(8); PG8_WAIT_L(0); PG8_BAR; PG8_MMA(0, 0, At, B0); PG8_MMA(0, 1, At, B1); PG8_BAR; PG8_SCHED;
            PG8_LDA(At, 0, 1); PG8_STAGE(PG8_SB(0, 0), b2, voffB); PG8_STAGE(PG8_SB(0, 1), b2 + hstepB, voffB); PG8_STAGE(PG8_SA(0, 0), a2, voffA);
            PG8_WAIT_V(8); PG8_WAIT_L(0); PG8_BAR; PG8_MMA(1, 0, At, B0); PG8_MMA(1, 1, At, B1); PG8_BAR; PG8_SCHED;
            PG8_LDB(B0, 1, 0); PG8_LDB(B1, 1, 1); PG8_SCHED; PG8_LDA(At, 1, 0); PG8_STAGE(PG8_SA(0, 1), a2 + hstepA, voffA);
            PG8_WAIT_V(8); PG8_WAIT_L(0); PG8_BAR; PG8_MMA(0, 0, At, B0); PG8_MMA(0, 1, At, B1); PG8_BAR; PG8_SCHED;
            PG8_LDA(At, 1, 1); PG8_STAGE(PG8_SB(1, 0), b3, voffB); PG8_STAGE(PG8_SB(1, 1), b3 + hstepB, voffB); PG8_STAGE(PG8_SA(1, 0), a3, voffA);
            PG8_WAIT_V(8); PG8_WAIT_L(0); PG8_BAR; PG8_MMA(1, 0, At, B0); PG8_MMA(1, 1, At, B1); PG8_BAR; PG8_SCHED;
        }
        if (wr == 0) PG8_BAR;
        { const int l_e = lane_id_v(); E(acc, cur, wr, wc, l_e & 15, l_e >> 4); }
        if (!has_next) break;
#pragma unroll
        for (int a = 0; a < 2; ++a)
#pragma unroll
            for (int b = 0; b < 2; ++b)
#pragma unroll
                for (int m = 0; m < 4; ++m)
#pragma unroll
                    for (int n = 0; n < 2; ++n) acc[a][b][m][n] = (f32x4){0.f, 0.f, 0.f, 0.f};
        cur = nxt; cA = nA; cB = nB; ++ui;
        if (wr == 1) PG8_BAR;
    }
    PG8_WAIT_V(0);
    PG8_BAR;
#undef PG8_SA
#undef PG8_SB
#undef PG8_STAGE
#undef PG8_LDA
#undef PG8_LDB
#undef PG8_MMA
#undef PG8_WAIT_V
#undef PG8_WAIT_L
#undef PG8_BAR
#undef PG8_SCHED
}
}
using pg8::Unit;
typedef f32x4 AccT[2][2][4][2];
#define EPI_ROW(u, ai, m) ((u).pm * 256 + (ai) * 128 + wr * 64 + (m) * 16 + fr)
#define EPI_LCOL(bj) ((bj) * 128 + wc * 32 + 8 * fq)

struct EpiStore {
    static constexpr bool MID = false;
    bf16_t* O; int ldc; int silu_pn;
    __device__ __forceinline__ void operator()(const AccT& acc, const Unit& u, int wr, int wc, int fr, int fq) const {
        const bool act = u.pn >= silu_pn;
#pragma unroll
        for (int ai = 0; ai < 2; ++ai)
#pragma unroll
            for (int m = 0; m < 4; ++m) { bf16_t* rowp = O + (size_t)EPI_ROW(u, ai, m) * ldc + u.pn * 256;
#pragma unroll
                for (int bj = 0; bj < 2; ++bj) { f32x4 v0 = acc[ai][bj][m][0], v1 = acc[ai][bj][m][1];
                    if (act) {
#pragma unroll
                        for (int e = 0; e < 4; ++e) { v0[e] = siluf(v0[e]); v1[e] = siluf(v1[e]); } }
                    *(u32x4*)(rowp + EPI_LCOL(bj)) = pack8(v0, v1); }
                asm volatile("" ::: "memory"); }
    }
};
template <bool MIDSCALE, bool RESBF> struct EpiOut {
    static constexpr bool MID = MIDSCALE;
    const void* res; bf16_t* Ub; f32x2* part; const float* ssqC;
    __device__ __forceinline__ void mid(AccT& acc, const Unit& u, int wr, int fr) const {
#pragma unroll
        for (int ai = 0; ai < 2; ++ai)
#pragma unroll
            for (int m = 0; m < 4; ++m) { const int row = EPI_ROW(u, ai, m); const f32x4 a = *(const f32x4*)(ssqC + (size_t)row * 8), b = *(const f32x4*)(ssqC + (size_t)row * 8 + 4);
                const float s = ((a[0] + a[1]) + (a[2] + a[3])) + ((b[0] + b[1]) + (b[2] + b[3])); const float rc = rsqrtf(s * (1.f / 512.f) + EPS);
#pragma unroll
                for (int bj = 0; bj < 2; ++bj)
#pragma unroll
                    for (int n = 0; n < 2; ++n) acc[ai][bj][m][n] *= rc; }
    }
    __device__ __forceinline__ void operator()(const AccT& acc, const Unit& u, int wr, int wc, int fr, int fq) const {
#pragma unroll
        for (int ai = 0; ai < 2; ++ai)
#pragma unroll
            for (int m = 0; m < 4; ++m) { const int row = EPI_ROW(u, ai, m); const size_t off = (size_t)row * DM + u.pn * 256; float s = 0.f, q = 0.f;
#pragma unroll
                for (int bj = 0; bj < 2; ++bj) { const size_t o = off + EPI_LCOL(bj); f32x4 r0, r1;
                    if constexpr (RESBF) { const u32x4 rw = *(const u32x4*)((const bf16_t*)res + o); r0 = (f32x4){bflo(rw.x), bfhi(rw.x), bflo(rw.y), bfhi(rw.y)}; r1 = (f32x4){bflo(rw.z), bfhi(rw.z), bflo(rw.w), bfhi(rw.w)}; }
                    else { r0 = *(const f32x4*)((const float*)res + o); r1 = *(const f32x4*)((const float*)res + o + 4); }
                    const f32x4 u0 = r0 * DN_ALPHA + acc[ai][bj][m][0], u1 = r1 * DN_ALPHA + acc[ai][bj][m][1];
                    *(u32x4*)(Ub + o) = pack8(u0, u1);
                    s += ((u0[0] + u0[1]) + (u0[2] + u0[3])) + ((u1[0] + u1[1]) + (u1[2] + u1[3]));
                    q += ((u0[0] * u0[0] + u0[1] * u0[1]) + (u0[2] * u0[2] + u0[3] * u0[3])) + ((u1[0] * u1[0] + u1[1] * u1[1]) + (u1[2] * u1[2] + u1[3] * u1[3])); }
                s += swz_xor<16>(s); s = xor32_add(s); q += swz_xor<16>(q); q = xor32_add(q);
                if (fq == 0) part[(size_t)row * 16 + u.pn * 4 + wc] = (f32x2){s, q};
                asm volatile("" ::: "memory"); }
    }
};
struct EpiGate {
    static constexpr bool MID = false;
    const bf16_t* Ub; const f32x2* mr; const float* lng; const float* lnb; const float* G1; const float* G0; const bf16_t* pp; float* out; bf16_t* xb;
    __device__ __forceinline__ void operator()(const AccT& acc, const Unit& u, int wr, int wc, int fr, int fq) const {
#pragma unroll
        for (int bj = 0; bj < 2; ++bj) { const int col = u.pn * 256 + EPI_LCOL(bj);
            f32x4 g[2], b[2], g1[2], g0[2];
#pragma unroll
            for (int n = 0; n < 2; ++n) { g[n] = *(const f32x4*)(lng + col + 4 * n); b[n] = *(const f32x4*)(lnb + col + 4 * n); g1[n] = *(const f32x4*)(G1 + col + 4 * n); g0[n] = *(const f32x4*)(G0 + col + 4 * n); }
#pragma unroll
            for (int ai = 0; ai < 2; ++ai)
#pragma unroll
                for (int m = 0; m < 4; ++m) { const int rl = ai * 128 + wr * 64 + m * 16 + fr; const f32x2 st = mr[u.idx * 256 + rl]; const size_t o = (size_t)(u.pm * 256 + rl) * DM + col;
                    const u32x4 pw = *(const u32x4*)(pp + o), uw = *(const u32x4*)(Ub + o); f32x4 ov[2];
                    const float ppv[8] = {bflo(pw.x), bfhi(pw.x), bflo(pw.y), bfhi(pw.y), bflo(pw.z), bfhi(pw.z), bflo(pw.w), bfhi(pw.w)};
                    const float uv[8] = {bflo(uw.x), bfhi(uw.x), bflo(uw.y), bfhi(uw.y), bflo(uw.z), bfhi(uw.z), bflo(uw.w), bfhi(uw.w)};
#pragma unroll
                    for (int n = 0; n < 2; ++n) {
#pragma unroll
                        for (int e = 0; e < 4; ++e) { const float h = (uv[4 * n + e] - st.x) * st.y * g[n][e] + b[n][e]; const float t = st.y * (acc[ai][bj][m][n][e] - st.x * g1[n][e]) + g0[n][e];
                            ov[n][e] = h + sigm(t) * ppv[4 * n + e]; } }
                    if (out) { __builtin_nontemporal_store(ov[0], (f32x4*)(out + o)); __builtin_nontemporal_store(ov[1], (f32x4*)(out + o + 4)); }
                    if (xb) *(u32x4*)(xb + o) = pack8(ov[0], ov[1]);
                    asm volatile("" ::: "memory"); } }
    }
};
struct EpiH1 {
    static constexpr bool MID = false;
    bf16_t* H1; float* statQ; float* statKV; f32x2* statV; const f32x2* cs; bf16_t* Kb;
    __device__ __forceinline__ void operator()(const AccT& acc, const Unit& u, int wr, int wc, int fr, int fq) const {
        const int pn = u.pn;
#pragma unroll
        for (int ai = 0; ai < 2; ++ai)
#pragma unroll
            for (int m = 0; m < 4; ++m) { const int row = EPI_ROW(u, ai, m); bf16_t* rowp = H1 + (size_t)row * OD_IN + pn * 256;
                if (pn == 0) { float q = 0.f;
#pragma unroll
                    for (int bj = 0; bj < 2; ++bj) { const f32x4 v0 = acc[ai][bj][m][0], v1 = acc[ai][bj][m][1]; *(u32x4*)(rowp + EPI_LCOL(bj)) = pack8(v0, v1);
                        q += ((v0[0] * v0[0] + v0[1] * v0[1]) + (v0[2] * v0[2] + v0[3] * v0[3])) + ((v1[0] * v1[0] + v1[1] * v1[1]) + (v1[2] * v1[2] + v1[3] * v1[3])); }
                    q += swz_xor<16>(q); q = xor32_add(q); if (fq == 0) statQ[(size_t)row * 4 + wc] = q;
                } else if (pn == 1) {
                    { const f32x4 v0 = acc[ai][0][m][0], v1 = acc[ai][0][m][1]; *(u32x4*)(rowp + EPI_LCOL(0)) = pack8(v0, v1);
                      float q = ((v0[0] * v0[0] + v0[1] * v0[1]) + (v0[2] * v0[2] + v0[3] * v0[3])) + ((v1[0] * v1[0] + v1[1] * v1[1]) + (v1[2] * v1[2] + v1[3] * v1[3]));
                      q += swz_xor<16>(q); q = xor32_add(q); if (fq == 0) statKV[(size_t)row * 4 + wc] = q; }
                    if (wc == 0) { const f32x4 v0 = acc[ai][1][m][0], v1 = acc[ai][1][m][1]; const float x[8] = {v0[0], v0[1], v0[2], v0[3], v1[0], v1[1], v1[2], v1[3]};
                        const f32x4 c01 = *(const f32x4*)(cs + (size_t)row * 16 + 4 * fq), c23 = *(const f32x4*)(cs + (size_t)row * 16 + 4 * fq + 2);
                        const float cc[4] = {c01[0], c01[2], c23[0], c23[2]}, ss[4] = {c01[1], c01[3], c23[1], c23[3]}; float o[8];
#pragma unroll
                        for (int e = 0; e < 4; ++e) { o[2 * e] = x[2 * e] * cc[e] - x[2 * e + 1] * ss[e]; o[2 * e + 1] = x[2 * e] * ss[e] + x[2 * e + 1] * cc[e]; }
                        u32x4 w; w.x = cvt_pk_bf16(o[0], o[1]); w.y = cvt_pk_bf16(o[2], o[3]); w.z = cvt_pk_bf16(o[4], o[5]); w.w = cvt_pk_bf16(o[6], o[7]);
                        const int b = row >> 12, s = row & 4095;
#pragma unroll
                        for (int h = 0; h < 8; ++h) *(u32x4*)(Kb + ((size_t)(b * 8 + h) * SEQ + s) * 96 + 64 + 8 * fq) = w; }
                } else if (pn < 6) { float s = 0.f, q = 0.f;
#pragma unroll
                    for (int bj = 0; bj < 2; ++bj) { f32x4 v0 = acc[ai][bj][m][0], v1 = acc[ai][bj][m][1];
#pragma unroll
                        for (int e = 0; e < 4; ++e) { v0[e] = geluf(v0[e]); v1[e] = geluf(v1[e]); }
                        *(u32x4*)(rowp + EPI_LCOL(bj)) = pack8(v0, v1);
                        s += ((v0[0] + v0[1]) + (v0[2] + v0[3])) + ((v1[0] + v1[1]) + (v1[2] + v1[3]));
                        q += ((v0[0] * v0[0] + v0[1] * v0[1]) + (v0[2] * v0[2] + v0[3] * v0[3])) + ((v1[0] * v1[0] + v1[1] * v1[1]) + (v1[2] * v1[2] + v1[3] * v1[3])); }
                    if (pn >= 4) { s += swz_xor<16>(s); s = xor32_add(s); q += swz_xor<16>(q); q = xor32_add(q);
                        if (fq == 0) statV[(size_t)row * 8 + (pn - 4) * 4 + wc] = (f32x2){s, q}; }
                } else {
#pragma unroll
                    for (int bj = 0; bj < 2; ++bj) *(u32x4*)(rowp + EPI_LCOL(bj)) = pack8(acc[ai][bj][m][0], acc[ai][bj][m][1]); }
                asm volatile("" ::: "memory"); }
    }
};
struct EpiQ {
    static constexpr bool MID = false;
    const float* statQ; const f32x2* cs; bf16_t* Qb;
    __device__ __forceinline__ void operator()(const AccT& acc, const Unit& u, int wr, int wc, int fr, int fq) const {
#pragma unroll
        for (int ai = 0; ai < 2; ++ai)
#pragma unroll
            for (int m = 0; m < 4; ++m) { const int row = EPI_ROW(u, ai, m); const f32x4 sq = *(const f32x4*)(statQ + (size_t)row * 4);
                const float rq = rsqrtf(((sq[0] + sq[1]) + (sq[2] + sq[3])) * (1.f / 256.f) + EPS); const int b = row >> 12, s = row & 4095;
#pragma unroll
                for (int bj = 0; bj < 2; ++bj) { const int col = u.pn * 256 + EPI_LCOL(bj), h = col / 96, j = col - h * 96;
                    const f32x4 v0 = acc[ai][bj][m][0] * rq, v1 = acc[ai][bj][m][1] * rq; u32x4 w;
                    if (j >= 64) { const int i0 = (j - 64) >> 1; const float x[8] = {v0[0], v0[1], v0[2], v0[3], v1[0], v1[1], v1[2], v1[3]};
                        const f32x4 c01 = *(const f32x4*)(cs + (size_t)row * 16 + i0), c23 = *(const f32x4*)(cs + (size_t)row * 16 + i0 + 2);
                        const float cc[4] = {c01[0], c01[2], c23[0], c23[2]}, ss[4] = {c01[1], c01[3], c23[1], c23[3]}; float o[8];
#pragma unroll
                        for (int e = 0; e < 4; ++e) { o[2 * e] = x[2 * e] * cc[e] - x[2 * e + 1] * ss[e]; o[2 * e + 1] = x[2 * e] * ss[e] + x[2 * e + 1] * cc[e]; }
                        w.x = cvt_pk_bf16(o[0], o[1]); w.y = cvt_pk_bf16(o[2], o[3]); w.z = cvt_pk_bf16(o[4], o[5]); w.w = cvt_pk_bf16(o[6], o[7]);
                    } else w = pack8(v0, v1);
                    *(u32x4*)(Qb + ((size_t)(b * 8 + h) * SEQ + s) * 96 + j) = w; }
                asm volatile("" ::: "memory"); }
    }
};
struct EpiK {
    static constexpr bool MID = false;
    const float* statKV; bf16_t* Kb;
    __device__ __forceinline__ void operator()(const AccT& acc, const Unit& u, int wr, int wc, int fr, int fq) const {
#pragma unroll
        for (int ai = 0; ai < 2; ++ai)
#pragma unroll
            for (int m = 0; m < 4; ++m) { const int row = EPI_ROW(u, ai, m); const f32x4 sq = *(const f32x4*)(statKV + (size_t)row * 4);
                const float rk = rsqrtf(((sq[0] + sq[1]) + (sq[2] + sq[3])) * (1.f / 128.f) + EPS); const int b = row >> 12, s = row & 4095;
#pragma unroll
                for (int bj = 0; bj < 2; ++bj) { const int col = u.pn * 256 + EPI_LCOL(bj), h = col >> 6, j = col & 63;
                    *(u32x4*)(Kb + ((size_t)(b * 8 + h) * SEQ + s) * 96 + j) = pack8(acc[ai][bj][m][0] * rk, acc[ai][bj][m][1] * rk); }
                asm volatile("" ::: "memory"); }
    }
};
struct EpiVT {
    static constexpr bool MID = false;
    const float* statKV; bf16_t* Vt;
    __device__ __forceinline__ void operator()(const AccT& acc, const Unit& u, int wr, int wc, int fr, int fq) const {
#pragma unroll
        for (int bj = 0; bj < 2; ++bj) { const int tok = u.pn * 256 + EPI_LCOL(bj), b = tok >> 12, s = tok & 4095; float rk[8];
#pragma unroll
            for (int e = 0; e < 8; ++e) { const f32x4 sq = *(const f32x4*)(statKV + (size_t)(tok + e) * 4); rk[e] = rsqrtf(((sq[0] + sq[1]) + (sq[2] + sq[3])) * (1.f / 128.f) + EPS); }
#pragma unroll
            for (int ai = 0; ai < 2; ++ai)
#pragma unroll
                for (int m = 0; m < 4; ++m) { const int hd = EPI_ROW(u, ai, m); f32x4 v0 = acc[ai][bj][m][0], v1 = acc[ai][bj][m][1];
#pragma unroll
                    for (int e = 0; e < 4; ++e) { v0[e] *= rk[e]; v1[e] *= rk[4 + e]; }
                    *(u32x4*)(Vt + ((size_t)b * 512 + hd) * SEQ + s) = pack8(v0, v1);
                    asm volatile("" ::: "memory"); } }
    }
};

__device__ __forceinline__ int colmap(int map, int n) {
    switch (map) {
    case 1: { if (n < 384) return n; if (n < 416) { const int j = n - 384, i = j >> 1; return 384 + ((j & 1) ? i + 16 : i); } if (n < 512) return -1; if (n < 1024) return 416 + (n - 512); if (n < 1536) return 928 + (n - 1024); return 1440 + (n - 1536); }
    case 2: { const int h = n / 96, j = n - h * 96; if (j < 64) return n; const int jj = j - 64, i = jj >> 1; return h * 96 + 64 + ((jj & 1) ? i + 16 : i); }
    case 3: return (n >> 6) * 128 + (n & 63);
    case 4: return (n >> 6) * 128 + 64 + (n & 63);
    default: return n;
    }
}
__device__ __forceinline__ void conv_w(const float* W, bf16_t* WT, int K, int Nsrc, int Ndst, int map, const float* rs, const float* rs2, float cscale, int cs_upto, int gt, int GT) {
    const int nitem = Ndst * (K >> 3);
    const int nb8 = Ndst >> 3;
    for (int it = gt; it < nitem; it += GT) { const int rest = it >> 6, n = (rest % nb8) * 8 + ((it >> 3) & 7), k0 = ((rest / nb8) * 8 + (it & 7)) * 8; const int src = colmap(map, n); const float cs = (n < cs_upto) ? cscale : 1.f; const int srcc = src < 0 ? 0 : src; const float csz = src < 0 ? 0.f : cs; float v[8];
#pragma unroll
        for (int e = 0; e < 8; ++e) { const int k = k0 + e; const float w = W[(size_t)k * Nsrc + srcc]; v[e] = w * csz; }
        if (rs) { const float* rp = (rs2 && k0 >= 512) ? (rs2 + (k0 - 512)) : (rs + k0); const f32x4 ra = *(const f32x4*)rp, rb4 = *(const f32x4*)(rp + 4);
#pragma unroll
            for (int e = 0; e < 4; ++e) { v[e] *= ra[e]; v[4 + e] *= rb4[e]; } }
        u32x4 o; o.x = cvt_pk_bf16(v[0], v[1]); o.y = cvt_pk_bf16(v[2], v[3]); o.z = cvt_pk_bf16(v[4], v[5]); o.w = cvt_pk_bf16(v[6], v[7]);
        *(u32x4*)(WT + (size_t)n * K + k0) = o; }
}
__device__ __forceinline__ void conv_flat(const float* src, bf16_t* dst, size_t n8, int gt, int GT) {
    size_t i = gt;
    for (; i + 3 * (size_t)GT < n8; i += 4 * (size_t)GT) { f32x4 a[4], b[4];
#pragma unroll
        for (int j = 0; j < 4; ++j) { a[j] = __builtin_nontemporal_load((const f32x4*)(src + (i + j * (size_t)GT) * 8)); b[j] = __builtin_nontemporal_load((const f32x4*)(src + (i + j * (size_t)GT) * 8 + 4)); }
#pragma unroll
        for (int j = 0; j < 4; ++j) *(u32x4*)(dst + (i + j * (size_t)GT) * 8) = pack8(a[j], b[j]); }
    for (; i < n8; i += GT) { const f32x4 a = *(const f32x4*)(src + i * 8), b = *(const f32x4*)(src + i * 8 + 4); *(u32x4*)(dst + i * 8) = pack8(a, b); }
}

struct Args { const void* in[25]; float* out; unsigned char* ws; };

__device__ __forceinline__ int kappa(int r) { return (r & ~12) | ((r & 4) << 1) | ((r & 8) >> 1); }
constexpr int EK_ROW = 72, EK_BUF = 64 * EK_ROW * 2, EV_STAGE = 4 * EK_BUF + 256;
__device__ __forceinline__ void even_item(int wsg, unsigned char* lds, const bf16_t* H0, const int* pos, const float* sink, const float* convw, bf16_t* Y0, int b, int q0) {
    int tid_ = tid_from(wsg); asm volatile("" : "+v"(tid_));
    const int tid = tid_, lane = tid & 63, wid = tid >> 6, r32 = lane & 31, hi = lane >> 5;
    const int h = wid, kvh = h >> 2;
    const size_t tb = (size_t)b * SEQ;
    bf16x8 qf[2][4]; float posq[2];
#pragma unroll
    for (int qb = 0; qb < 2; ++qb) { const size_t t = tb + q0 + 32 * qb + r32; posq[qb] = (float)pos[t];
#pragma unroll
        for (int ks = 0; ks < 4; ++ks) qf[qb][ks] = *(const bf16x8*)(H0 + t * EV_IN + h * 64 + 16 * ks + 8 * hi); }
    const float slope2 = exp2f(-(float)(h + 1)) * LOG2E, sink2 = sink[h] * LOG2E;
    f32x16 O[2][2]; float mrun[2], lrun[2];
#pragma unroll
    for (int qb = 0; qb < 2; ++qb) { mrun[qb] = sink2; lrun[qb] = (hi == 0) ? 1.f : 0.f; O[qb][0] = (f32x16){}; O[qb][1] = (f32x16){}; }
    u32x4 gk[2], gv[2]; float gp = 0.f;
#define EV_ISSUE(j_) do { const int kbase_ = q0 - 128 + 64 * (j_); \
        _Pragma("unroll") for (int i = 0; i < 2; ++i) { const int c = tid + i * 512; \
            { const int key = (c >> 3) & 63, ch = c & 7, kg = min(max(kbase_ + key, 0), SEQ - 1); gk[i] = *(const u32x4*)(H0 + (tb + kg) * EV_IN + 512 + i * 64 + ch * 8); } \
            { const int key = c & 63, ch = (c >> 6) & 7, kg = min(max(kbase_ + key, 0), SEQ - 1); gv[i] = *(const u32x4*)(H0 + (tb + kg) * EV_IN + 640 + i * 64 + ch * 8); } } \
        { const int kg = min(max(kbase_ + (tid & 63), 0), SEQ - 1); gp = (float)pos[tb + kg]; } } while (0)
#define EV_COMMIT(p_) do { unsigned char* base_ = lds + (p_) * EV_STAGE; \
        _Pragma("unroll") for (int i = 0; i < 2; ++i) { const int c = tid + i * 512; \
            { const int key = (c >> 3) & 63, ch = c & 7; *(u32x4*)(base_ + i * EK_BUF + (key * EK_ROW + ch * 8) * 2) = gk[i]; } \
            { const int key = c & 63, ch = (c >> 6) & 7; const u32x4 v = gv[i]; bf16_t* vt = (bf16_t*)(base_ + 2 * EK_BUF + i * EK_BUF) + (ch * 8) * EK_ROW + key; \
              vt[0 * EK_ROW] = (bf16_t)(v.x & 0xffffu); vt[1 * EK_ROW] = (bf16_t)(v.x >> 16); vt[2 * EK_ROW] = (bf16_t)(v.y & 0xffffu); vt[3 * EK_ROW] = (bf16_t)(v.y >> 16); \
              vt[4 * EK_ROW] = (bf16_t)(v.z & 0xffffu); vt[5 * EK_ROW] = (bf16_t)(v.z >> 16); vt[6 * EK_ROW] = (bf16_t)(v.w & 0xffffu); vt[7 * EK_ROW] = (bf16_t)(v.w >> 16); } } \
        ((float*)(base_ + 4 * EK_BUF))[tid & 63] = gp; } while (0)
    __syncthreads();
    EV_ISSUE(0); EV_COMMIT(0);
    __syncthreads();
#pragma unroll 1
    for (int j = 0; j < 5; ++j) {
        const int kbase = q0 - 128 + 64 * j; const int pbuf = j & 1;
        if (j + 1 < 5) EV_ISSUE(j + 1);
        const unsigned char* KLp = lds + pbuf * EV_STAGE; const unsigned char* VTp = KLp + 2 * EK_BUF; const float* posK = (const float*)(KLp + 4 * EK_BUF);
        const unsigned char* kb = KLp + kvh * EK_BUF; const unsigned char* vb = VTp + kvh * EK_BUF;
        f32x16 S[2][2];
#pragma unroll
        for (int rb = 0; rb < 2; ++rb) { bf16x8 kf[4];
#pragma unroll
            for (int ks = 0; ks < 4; ++ks) kf[ks] = *(const bf16x8*)(kb + ((kappa(r32) + 32 * rb) * EK_ROW + 16 * ks + 8 * hi) * 2);
#pragma unroll
            for (int qb = 0; qb < 2; ++qb) { f32x16 a = (f32x16){};
#pragma unroll
                for (int ks = 0; ks < 4; ++ks) a = __builtin_amdgcn_mfma_f32_32x32x16_bf16(kf[ks], qf[qb][ks], a, 0, 0, 0);
                S[qb][rb] = a; } }
#pragma unroll
        for (int qb = 0; qb < 2; ++qb) { const int qg = q0 + 32 * qb + r32; float mx = -1e30f;
            const int lo = max(-kbase, qg - 128 - kbase) - 8 * hi; const unsigned span = (unsigned)(min(SEQ - 1 - kbase, qg + 128 - kbase) - 8 * hi - lo);
            const float* pk_ = posK + 8 * hi;
#pragma unroll
            for (int rb = 0; rb < 2; ++rb)
#pragma unroll
                for (int hf = 0; hf < 2; ++hf) {
                    const f32x4 pa = *(const f32x4*)(pk_ + 32 * rb + 16 * hf), pb = *(const f32x4*)(pk_ + 32 * rb + 16 * hf + 4);
                    const float pkv[8] = {pa[0], pa[1], pa[2], pa[3], pb[0], pb[1], pb[2], pb[3]};
#pragma unroll
                    for (int i = 0; i < 8; ++i) { const int r = 8 * hf + i, c = 32 * rb + i + 16 * hf;
                        const float bias = slope2 * fabsf(posq[qb] - pkv[i]); const float sv0 = S[qb][rb][r] - bias;
                        const bool valid = (unsigned)(c - lo) <= span;
                        const float sv = valid ? sv0 : -1e30f; S[qb][rb][r] = sv; mx = fmaxf(mx, sv); }
                    __builtin_amdgcn_sched_barrier(0); }
            mx = xor32_max(mx);
            const float mnew = fmaxf(mrun[qb], mx), alpha = __builtin_amdgcn_exp2f(mrun[qb] - mnew); mrun[qb] = mnew; float ps = 0.f;
#pragma unroll
            for (int rb = 0; rb < 2; ++rb)
#pragma unroll
                for (int r = 0; r < 16; ++r) { const float p = __builtin_amdgcn_exp2f(S[qb][rb][r] - mnew); S[qb][rb][r] = p; ps += p; }
            lrun[qb] = lrun[qb] * alpha + ps;
#pragma unroll
            for (int db = 0; db < 2; ++db) O[qb][db] *= alpha; }
#pragma unroll
        for (int mm = 0; mm < 4; ++mm) { bf16x8 pf[2];
#pragma unroll
            for (int qb = 0; qb < 2; ++qb) { const f32x16& s = S[qb][mm >> 1]; const int o = 8 * (mm & 1); u32x4 w;
                w.x = cvt_pk_bf16(s[o + 0], s[o + 1]); w.y = cvt_pk_bf16(s[o + 2], s[o + 3]); w.z = cvt_pk_bf16(s[o + 4], s[o + 5]); w.w = cvt_pk_bf16(s[o + 6], s[o + 7]); pf[qb] = __builtin_bit_cast(bf16x8, w); }
#pragma unroll
            for (int db = 0; db < 2; ++db) { const bf16x8 vf = *(const bf16x8*)(vb + ((32 * db + r32) * EK_ROW + 16 * mm + 8 * hi) * 2);
#pragma unroll
                for (int qb = 0; qb < 2; ++qb) O[qb][db] = __builtin_amdgcn_mfma_f32_32x32x16_bf16(vf, pf[qb], O[qb][db], 0, 0, 0); } }
        if (j + 1 < 5) EV_COMMIT(pbuf ^ 1);
        __syncthreads();
    }
#undef EV_ISSUE
#undef EV_COMMIT
    float* ssq = (float*)lds;
#pragma unroll
    for (int qb = 0; qb < 2; ++qb) { float l = lrun[qb]; l = xor32_add(l); const float il = 1.f / l; float q = 0.f;
#pragma unroll
        for (int db = 0; db < 2; ++db) { O[qb][db] *= il;
#pragma unroll
            for (int r = 0; r < 16; ++r) q += O[qb][db][r] * O[qb][db][r]; }
        q = xor32_add(q); if (hi == 0) ssq[h * 64 + 32 * qb + r32] = q; }
    __syncthreads();
#pragma unroll
    for (int qb = 0; qb < 2; ++qb) { float s = 0.f;
#pragma unroll
        for (int hh = 0; hh < 8; ++hh) s += ssq[hh * 64 + 32 * qb + r32];
        const float ra = rsqrtf(s * (1.f / 512.f) + EPS); const size_t t = tb + q0 + 32 * qb + r32;
#pragma unroll
        for (int kp = 0; kp < 4; ++kp) {
            const int db = kp >> 1, ga = (2 * kp) & 3, gb = ga + 1, c16 = 16 * kp + 8 * hi;
            u32x4 zq = *(const u32x4*)(H0 + t * EV_IN + 2304 + h * 64 + c16);
            unsigned z0 = zq.x, z1 = zq.y, z2 = zq.z, z3 = zq.w; swap32(z0, z2); swap32(z1, z3); zq = (u32x4){z0, z1, z2, z3};
            unsigned a0 = cvt_pk_bf16(O[qb][db][4 * ga + 0] * ra * siluf(bflo(zq.x)), O[qb][db][4 * ga + 1] * ra * siluf(bfhi(zq.x))), a1 = cvt_pk_bf16(O[qb][db][4 * ga + 2] * ra * siluf(bflo(zq.y)), O[qb][db][4 * ga + 3] * ra * siluf(bfhi(zq.y)));
            unsigned b0 = cvt_pk_bf16(O[qb][db][4 * gb + 0] * ra * siluf(bflo(zq.z)), O[qb][db][4 * gb + 1] * ra * siluf(bfhi(zq.z))), b1 = cvt_pk_bf16(O[qb][db][4 * gb + 2] * ra * siluf(bflo(zq.w)), O[qb][db][4 * gb + 3] * ra * siluf(bfhi(zq.w)));
            swap32(a0, b0); swap32(a1, b1);
            *(u32x4*)(Y0 + t * DM + h * 64 + c16) = (u32x4){a0, a1, b0, b1}; } }
    { const int c0 = lane * 8; float cw[3][8];
#pragma unroll
        for (int jj = 0; jj < 3; ++jj) { const f32x4 a = *(const f32x4*)(convw + jj * 512 + c0), bq = *(const f32x4*)(convw + jj * 512 + c0 + 4);
#pragma unroll
            for (int e = 0; e < 4; ++e) { cw[jj][e] = a[e]; cw[jj][4 + e] = bq[e]; } }
        const int t0 = q0 + wid * 8; float zp[8], zc[8], zn[8];
#define EV_Z(dst, tt) do { if ((tt) >= 0 && (tt) < SEQ) { const u32x4 cg_ = *(const u32x4*)(H0 + (tb + (tt)) * EV_IN + 1280 + c0), xi_ = *(const u32x4*)(H0 + (tb + (tt)) * EV_IN + 1792 + c0); \
            dst[0] = bflo(cg_.x) * bflo(xi_.x); dst[1] = bfhi(cg_.x) * bfhi(xi_.x); dst[2] = bflo(cg_.y) * bflo(xi_.y); dst[3] = bfhi(cg_.y) * bfhi(xi_.y); \
            dst[4] = bflo(cg_.z) * bflo(xi_.z); dst[5] = bfhi(cg_.z) * bfhi(xi_.z); dst[6] = bflo(cg_.w) * bflo(xi_.w); dst[7] = bfhi(cg_.w) * bfhi(xi_.w); } \
          else { _Pragma("unroll") for (int e_ = 0; e_ < 8; ++e_) dst[e_] = 0.f; } } while (0)
        EV_Z(zp, t0 - 1); EV_Z(zc, t0);
        for (int i = 0; i < 8; ++i) { const int t = t0 + i; EV_Z(zn, t + 1);
            const u32x4 bgw = *(const u32x4*)(H0 + (tb + t) * EV_IN + 768 + c0), zw = *(const u32x4*)(H0 + (tb + t) * EV_IN + 2304 + 512 + c0);
            const float bg[8] = {bflo(bgw.x), bfhi(bgw.x), bflo(bgw.y), bfhi(bgw.y), bflo(bgw.z), bfhi(bgw.z), bflo(bgw.w), bfhi(bgw.w)};
            const float zz[8] = {siluf(bflo(zw.x)), siluf(bfhi(zw.x)), siluf(bflo(zw.y)), siluf(bfhi(zw.y)), siluf(bflo(zw.z)), siluf(bfhi(zw.z)), siluf(bflo(zw.w)), siluf(bfhi(zw.w))};
            float y[8], q = 0.f;
#pragma unroll
            for (int e = 0; e < 8; ++e) { y[e] = bg[e] * (cw[0][e] * zp[e] + cw[1][e] * zc[e] + cw[2][e] * zn[e]); q += y[e] * y[e]; }
            q += swz_xor<1>(q); q += swz_xor<2>(q); q += swz_xor<4>(q); q += swz_xor<8>(q); q += swz_xor<16>(q); q = xor32_add(q);
            const float rb = rsqrtf(q * (1.f / 512.f) + EPS); u32x4 w;
            w.x = cvt_pk_bf16(y[0] * rb * zz[0], y[1] * rb * zz[1]); w.y = cvt_pk_bf16(y[2] * rb * zz[2], y[3] * rb * zz[3]);
            w.z = cvt_pk_bf16(y[4] * rb * zz[4], y[5] * rb * zz[5]); w.w = cvt_pk_bf16(y[6] * rb * zz[6], y[7] * rb * zz[7]);
            *(u32x4*)(Y0 + (tb + t) * DM + 512 + c0) = w;
#pragma unroll
            for (int e = 0; e < 8; ++e) { zp[e] = zc[e]; zc[e] = zn[e]; } }
#undef EV_Z
    }
}

constexpr int GV_ROW = 136, GV_BUF = 128 * GV_ROW * 2;
__device__ __forceinline__ void gmlp_item(int wsg, unsigned char* lds, const bf16_t* H1, const f32x2* statV, const float* lng, const float* lnb, const bf16_t* WSb, const float* bs, bf16_t* Y1, int chunk) {
    int tid_ = tid_from(wsg); asm volatile("" : "+v"(tid_));
    const int tid = tid_, lane = tid & 63, wid = tid >> 6, fr = lane & 15, fq = lane >> 4;
    f32x2* mr = (f32x2*)(lds + 2 * GV_BUF);
    const size_t row0 = (size_t)chunk * 128;
    __syncthreads();
    if (tid < 128) { const f32x2* p = statV + (row0 + tid) * 8; float s = 0.f, q = 0.f;
#pragma unroll
        for (int i = 0; i < 8; ++i) { const f32x2 v = p[i]; s += v.x; q += v.y; }
        const float mean = s * (1.f / 512.f), var = q * (1.f / 512.f) - mean * mean; mr[tid] = (f32x2){mean, rsqrtf(fmaxf(var, 0.f) + EPS)}; }
    const int st_s = (tid >> 2) & 127, st_cl = tid & 3;
    u32x4 gst[4];
#define GM_ISSUE(g_) do { _Pragma("unroll") for (int i = 0; i < 4; ++i) gst[i] = *(const u32x4*)(H1 + (row0 + st_s) * OD_IN + 1024 + (g_) * 128 + (st_cl + 4 * i) * 8); } while (0)
#define GM_COMMIT(g_, buf_) do { bf16_t* VnT_ = (bf16_t*)(lds + (buf_) * GV_BUF); const f32x2 st = mr[st_s]; \
        _Pragma("unroll") for (int i = 0; i < 4; ++i) { const int ch = st_cl + 4 * i, cb = (g_) * 128 + ch * 8; const u32x4 v = gst[i]; \
            const f32x4 ga = *(const f32x4*)(lng + cb), gb = *(const f32x4*)(lng + cb + 4), ba = *(const f32x4*)(lnb + cb), bb = *(const f32x4*)(lnb + cb + 4); \
            const float x[8] = {bflo(v.x), bfhi(v.x), bflo(v.y), bfhi(v.y), bflo(v.z), bfhi(v.z), bflo(v.w), bfhi(v.w)}; \
            const float gg[8] = {ga[0], ga[1], ga[2], ga[3], gb[0], gb[1], gb[2], gb[3]}, bbv[8] = {ba[0], ba[1], ba[2], ba[3], bb[0], bb[1], bb[2], bb[3]}; \
            _Pragma("unroll") for (int e = 0; e < 8; ++e) VnT_[(ch * 8 + e) * GV_ROW + st_s] = f2bf((x[e] - st.x) * st.y * gg[e] + bbv[e]); } } while (0)
    unsigned ydp[4][8][2]; float q = 0.f;
    const size_t trow = row0 + 16 * wid + fr;
    GM_ISSUE(0);
    __syncthreads();
    GM_COMMIT(0, 0);
    __syncthreads();
#pragma unroll
    for (int g = 0; g < 4; ++g) {
        if (g < 3) GM_ISSUE(g + 1);
        const bf16_t* VnT = (const bf16_t*)(lds + (g & 1) * GV_BUF);
        bf16x8 wf[4];
#pragma unroll
        for (int ks = 0; ks < 4; ++ks) wf[ks] = *(const bf16x8*)(WSb + ((size_t)g * 128 + 16 * wid + fr) * 128 + 32 * ks + 8 * fq);
        const float bsv = bs[g * 128 + 16 * wid + fr];
#pragma unroll
        for (int nb = 0; nb < 8; ++nb) { f32x4 a = (f32x4){0.f, 0.f, 0.f, 0.f};
#pragma unroll
            for (int ks = 0; ks < 4; ++ks) { const bf16x8 vf = *(const bf16x8*)(VnT + (16 * nb + fr) * GV_ROW + 32 * ks + 8 * fq); a = __builtin_amdgcn_mfma_f32_16x16x32_bf16(vf, wf[ks], a, 0, 0, 0); }
            const int d = g * 128 + 16 * nb + 4 * fq; const u32x2 uw = *(const u32x2*)(H1 + trow * OD_IN + 512 + d);
            const float y0 = bflo(uw.x) * (a[0] + bsv), y1 = bfhi(uw.x) * (a[1] + bsv), y2 = bflo(uw.y) * (a[2] + bsv), y3 = bfhi(uw.y) * (a[3] + bsv);
            q += (y0 * y0 + y1 * y1) + (y2 * y2 + y3 * y3); ydp[g][nb][0] = cvt_pk_bf16(y0, y1); ydp[g][nb][1] = cvt_pk_bf16(y2, y3); }
        if (g < 3) GM_COMMIT(g + 1, (g + 1) & 1);
        __syncthreads();
        __builtin_amdgcn_sched_barrier(0);
    }
#undef GM_ISSUE
#undef GM_COMMIT
    q += swz_xor<16>(q); q = xor32_add(q);
    const float rd = rsqrtf(q * (1.f / 512.f) + EPS);
#pragma unroll
    for (int g = 0; g < 4; ++g)
#pragma unroll
        for (int nb = 0; nb < 8; ++nb) { const int d = g * 128 + 16 * nb + 4 * fq; const u32x2 zw = *(const u32x2*)(H1 + trow * OD_IN + 1536 + 512 + d); u32x2 w;
            w.x = cvt_pk_bf16(bflo(ydp[g][nb][0]) * rd * siluf(bflo(zw.x)), bfhi(ydp[g][nb][0]) * rd * siluf(bfhi(zw.x))); w.y = cvt_pk_bf16(bflo(ydp[g][nb][1]) * rd * siluf(bflo(zw.y)), bfhi(ydp[g][nb][1]) * rd * siluf(bfhi(zw.y)));
            *(u32x2*)(Y1 + trow * DM + 512 + d) = w; }
}

constexpr int MK_ROW = 104, MK_BUF = 64 * MK_ROW * 2, MV_ROW = 72, MV_BUF = 64 * MV_ROW * 2;
__device__ __forceinline__ void mla_unit(int wsg, unsigned char* lds, const bf16_t* Qb, const bf16_t* Kb, const bf16_t* Vt, const bf16_t* H1, bf16_t* Y1, float* ssqC, int bh, int qblk) {
    int tid_ = tid_from(wsg); asm volatile("" : "+v"(tid_));
    const int tid = tid_, lane = tid & 63, wid = tid >> 6, r32 = lane & 31, hi = lane >> 5;
    const int b = bh >> 3, h = bh & 7;
    const bf16_t* Kg = Kb + (size_t)bh * SEQ * 96; const bf16_t* Vg = Vt + (size_t)bh * 64 * SEQ;
    const int qrow0 = qblk * 512 + wid * 64;
    bf16x8 qf[2][6];
#pragma unroll
    for (int qb = 0; qb < 2; ++qb)
#pragma unroll
        for (int ks = 0; ks < 6; ++ks) qf[qb][ks] = *(const bf16x8*)(Qb + ((size_t)bh * SEQ + qrow0 + 32 * qb + r32) * 96 + 16 * ks + 8 * hi);
    f32x16 O[2][2]; float mrun[2], lrun[2];
#pragma unroll
    for (int qb = 0; qb < 2; ++qb) { mrun[qb] = -1e30f; lrun[qb] = 0.f; O[qb][0] = (f32x16){}; O[qb][1] = (f32x16){}; }
    const int kc0 = tid, kc1 = tid + 512; const int vc = (tid >= 256) ? tid - 256 : tid + 256;
    const int k0_key = kc0 / 12, k0_ch = kc0 - k0_key * 12, k1_key = kc1 / 12, k1_ch = kc1 - k1_key * 12;
    const unsigned k0_l = (k0_key * MK_ROW + k0_ch * 8) * 2, k1_l = (k1_key * MK_ROW + k1_ch * 8) * 2, v_l = ((vc >> 3) * MV_ROW + (vc & 7) * 8) * 2;
    const bf16_t* vsrc = Vg + (size_t)(vc >> 3) * SEQ + (vc & 7) * 8;
    u32x4 g0, g1, g2 = (u32x4){0u, 0u, 0u, 0u};
#define MLA_ISSUE(t) do { g0 = *(const u32x4*)(Kg + (size_t)(t) * 64 * 96 + kc0 * 8); if (tid < 256) { g1 = *(const u32x4*)(Kg + (size_t)(t) * 64 * 96 + kc1 * 8); g2 = *(const u32x4*)(vsrc + (t) * 64); } else { g1 = *(const u32x4*)(vsrc + (t) * 64); } } while (0)
#define MLA_COMMIT(p) do { unsigned char* kb_ = lds + (p) * MK_BUF; unsigned char* vb_ = lds + 2 * MK_BUF + (p) * MV_BUF; *(u32x4*)(kb_ + k0_l) = g0; \
        if (tid < 256) { *(u32x4*)(kb_ + k1_l) = g1; *(u32x4*)(vb_ + v_l) = g2; } else { *(u32x4*)(vb_ + v_l) = g1; } } while (0)
    __syncthreads();
    MLA_ISSUE(0); MLA_COMMIT(0);
    __syncthreads();
    const int krow = kappa(r32);
    for (int t = 0; t < 64; ++t) {
        const int p = t & 1;
        if (t + 1 < 64) MLA_ISSUE(t + 1);
        const unsigned char* kb = lds + p * MK_BUF; const unsigned char* vb = lds + 2 * MK_BUF + p * MV_BUF;
        f32x16 S[2][2];
#pragma unroll
        for (int rb = 0; rb < 2; ++rb) { bf16x8 kf[6];
#pragma unroll
            for (int ks = 0; ks < 6; ++ks) kf[ks] = *(const bf16x8*)(kb + ((krow + 32 * rb) * MK_ROW + 16 * ks + 8 * hi) * 2);
#pragma unroll
            for (int qb = 0; qb < 2; ++qb) { f32x16 a = (f32x16){};
#pragma unroll
                for (int ks = 0; ks < 6; ++ks) a = __builtin_amdgcn_mfma_f32_32x32x16_bf16(kf[ks], qf[qb][ks], a, 0, 0, 0);
                S[qb][rb] = a; } }
#pragma unroll
        for (int qb = 0; qb < 2; ++qb) { float mx = -1e30f;
#pragma unroll
            for (int rb = 0; rb < 2; ++rb)
#pragma unroll
                for (int r = 0; r < 16; ++r) mx = fmaxf(mx, S[qb][rb][r]);
            if (__builtin_expect(__builtin_amdgcn_ballot_w64(mx - mrun[qb] > 8.0f) != 0ull, 0)) { mx = xor32_max(mx);
                const float mnew_ = fmaxf(mrun[qb], mx), alpha = __builtin_amdgcn_exp2f(mrun[qb] - mnew_); mrun[qb] = mnew_; lrun[qb] *= alpha;
#pragma unroll
                for (int db = 0; db < 2; ++db) O[qb][db] *= alpha; }
            const float mnew = mrun[qb]; float ps = 0.f;
#pragma unroll
            for (int rb = 0; rb < 2; ++rb)
#pragma unroll
                for (int r = 0; r < 16; ++r) { const float pe = __builtin_amdgcn_exp2f(S[qb][rb][r] - mnew); S[qb][rb][r] = pe; ps += pe; }
            lrun[qb] += ps; }
#pragma unroll
        for (int mm = 0; mm < 4; ++mm) { bf16x8 pf[2];
#pragma unroll
            for (int qb = 0; qb < 2; ++qb) { const f32x16& s = S[qb][mm >> 1]; const int o = 8 * (mm & 1); u32x4 w;
                w.x = cvt_pk_bf16(s[o + 0], s[o + 1]); w.y = cvt_pk_bf16(s[o + 2], s[o + 3]); w.z = cvt_pk_bf16(s[o + 4], s[o + 5]); w.w = cvt_pk_bf16(s[o + 6], s[o + 7]); pf[qb] = __builtin_bit_cast(bf16x8, w); }
#pragma unroll
            for (int db = 0; db < 2; ++db) { const bf16x8 vf = *(const bf16x8*)(vb + ((32 * db + r32) * MV_ROW + 16 * mm + 8 * hi) * 2);
#pragma unroll
                for (int qb = 0; qb < 2; ++qb) O[qb][db] = __builtin_amdgcn_mfma_f32_32x32x16_bf16(vf, pf[qb], O[qb][db], 0, 0, 0); } }
        if (t + 1 < 64) MLA_COMMIT(p ^ 1);
        __syncthreads();
    }
#undef MLA_ISSUE
#undef MLA_COMMIT
#pragma unroll
    for (int qb = 0; qb < 2; ++qb) { float l = lrun[qb]; l = xor32_add(l); const float il = 1.f / l; float q = 0.f;
        const size_t t = (size_t)b * SEQ + qrow0 + 32 * qb + r32;
#pragma unroll
        for (int db = 0; db < 2; ++db) { O[qb][db] *= il;
#pragma unroll
            for (int r = 0; r < 16; ++r) q += O[qb][db][r] * O[qb][db][r]; }
        q = xor32_add(q); if (hi == 0) ssqC[t * 8 + h] = q;
#pragma unroll
        for (int kp = 0; kp < 4; ++kp) {
            const int db = kp >> 1, ga = (2 * kp) & 3, gb = ga + 1, c16 = 16 * kp + 8 * hi;
            u32x4 zq = *(const u32x4*)(H1 + t * OD_IN + 1536 + h * 64 + c16);
            unsigned z0 = zq.x, z1 = zq.y, z2 = zq.z, z3 = zq.w; swap32(z0, z2); swap32(z1, z3); zq = (u32x4){z0, z1, z2, z3};
            unsigned a0 = cvt_pk_bf16(O[qb][db][4 * ga + 0] * siluf(bflo(zq.x)), O[qb][db][4 * ga + 1] * siluf(bfhi(zq.x))), a1 = cvt_pk_bf16(O[qb][db][4 * ga + 2] * siluf(bflo(zq.y)), O[qb][db][4 * ga + 3] * siluf(bfhi(zq.y)));
            unsigned b0 = cvt_pk_bf16(O[qb][db][4 * gb + 0] * siluf(bflo(zq.z)), O[qb][db][4 * gb + 1] * siluf(bfhi(zq.z))), b1 = cvt_pk_bf16(O[qb][db][4 * gb + 2] * siluf(bflo(zq.w)), O[qb][db][4 * gb + 3] * siluf(bfhi(zq.w)));
            swap32(a0, b0); swap32(a1, b1);
            *(u32x4*)(Y1 + t * DM + h * 64 + c16) = (u32x4){a0, a1, b0, b1}; } }
}

#define XB_TMO      128
#define XB_XCNT(j)  (256  + 64 * (j))
#define XB_XSUB(j)  (1280 + 64 * (j))
#define XB_XGEN(j)  (2304 + 64 * (j))
#define XB_TOP      3328
#define XB_TOPGEN   3392
#define XCD_BAR_WORDS 3456
#define XB_SPIN_CAP (1u << 18)
__device__ __forceinline__ unsigned xb_ld(unsigned* p)              { return __hip_atomic_load(p, __ATOMIC_RELAXED, __HIP_MEMORY_SCOPE_AGENT); }
__device__ __forceinline__ unsigned xb_add(unsigned* p, unsigned v) { return __hip_atomic_fetch_add(p, v, __ATOMIC_RELAXED, __HIP_MEMORY_SCOPE_AGENT); }
__device__ __forceinline__ unsigned xb_xcc_id() { return (unsigned)__builtin_amdgcn_s_getreg((3 << 11) | 20) & 0xFu; }
#define XB_SPIN(cond, bar) do { unsigned _sp = 0; while (cond) { __builtin_amdgcn_s_sleep(1); \
    if ((++_sp & 255u) == 0u) { if (xb_ld(&(bar)[XB_TMO])) break; if (_sp > XB_SPIN_CAP) { atomicAdd(&(bar)[XB_TMO], 1u); break; } } } } while (0)
__device__ __forceinline__ void xcd_barrier_complete(unsigned* bar, unsigned x, unsigned& nloc, unsigned& nx) {
    const unsigned G = gridDim.x * gridDim.y * gridDim.z;
    unsigned sum, cnt, mine, sp = 0u;
    for (;;) {
        sum = 0u; cnt = 0u; mine = 0u;
#pragma unroll
        for (unsigned j = 0; j < 16; ++j) { const unsigned c = xb_ld(&bar[XB_XCNT(j)]); sum += c; cnt += (c > 0u) ? 1u : 0u; mine = (j == x) ? c : mine; }
        if (sum == G) break;
        __builtin_amdgcn_s_sleep(1);
        if ((++sp & 255u) == 0u) { if (xb_ld(&bar[XB_TMO])) break; if (sp > XB_SPIN_CAP) { atomicAdd(&bar[XB_TMO], 1u); break; } }
    }
    nloc = mine > 0u ? mine : 1u; nx = cnt > 0u ? cnt : 1u;
}
__device__ __forceinline__ void xcd_barrier(unsigned* bar, volatile LAS unsigned* st, int wsg) {
    asm volatile("s_waitcnt vmcnt(0)" ::: "memory");
    __syncthreads();
    if (tid_from(wsg) == 0) {
        __builtin_amdgcn_s_waitcnt(0);
        const unsigned x = xb_xcc_id();
        unsigned nloc = st[0], nx = st[1];
        if (nloc == 0u) { xcd_barrier_complete(bar, x, nloc, nx); st[0] = nloc; st[1] = nx; }
        const unsigned old = xb_add(&bar[XB_XSUB(x)], 1u);
        const unsigned gen = old / nloc;
        if (old + 1u == (gen + 1u) * nloc) {
            __builtin_amdgcn_fence(__ATOMIC_RELEASE, "agent");
            asm volatile("s_waitcnt vmcnt(0)" ::: "memory");
            const unsigned og = xb_add(&bar[XB_TOP], 1u);
            const unsigned tg = og / nx;
            if (og + 1u == (tg + 1u) * nx) xb_add(&bar[XB_TOPGEN], 1u);
            else XB_SPIN(xb_ld(&bar[XB_TOPGEN]) == tg, bar);
            __builtin_amdgcn_fence(__ATOMIC_ACQUIRE, "agent");
            xb_add(&bar[XB_XGEN(x)], 1u);
            asm volatile("s_waitcnt vmcnt(0)" ::: "memory");
        } else {
            XB_SPIN(xb_ld(&bar[XB_XGEN(x)]) == gen, bar);
            __builtin_amdgcn_fence(__ATOMIC_ACQUIRE, "agent");
            asm volatile("s_waitcnt vmcnt(0)" ::: "memory");
        }
    }
    __syncthreads();
}

constexpr int LDS_BYTES = 147456;
#ifndef PHMASK
#define PHMASK 0x3ff
#endif
#ifndef DUPMASK
#define DUPMASK 0x000
#endif
#define PH(k) for (int rep_ = 0; rep_ < (((DUPMASK >> (k)) & 1) ? 2 : 1); ++rep_) if constexpr ((PHMASK >> (k)) & 1)
__global__ void __launch_bounds__(512, 2) mega(Args a) {
    extern __shared__ __attribute__((aligned(16))) unsigned char lds_raw[];
    cg::grid_group grid = cg::this_grid();
    LAS unsigned char* lds3 = (LAS unsigned char*)lds_raw;
    unsigned char* lds = lds_raw;
    const int wsg = __builtin_amdgcn_readfirstlane(threadIdx.x >> 6);
    volatile LAS unsigned* xb_st = (volatile LAS unsigned*)(lds3 + (LDS_BYTES - 16));
    if (threadIdx.x < 4) xb_st[threadIdx.x] = 0u;
    __syncthreads();
    if (threadIdx.x == 0) (void)xb_add((unsigned*)(a.ws + WS_BAR) + XB_XCNT(xb_xcc_id()), 1u);
#define SEAM() xcd_barrier((unsigned*)(a.ws + WS_BAR), xb_st, wsg)
#define PHASE_VARS int bid = blockIdx.x, G = gridDim.x; asm volatile("" : "+s"(bid), "+s"(G));
#define INF(i) ((const float*)a.in[i])
#define x_in (INF(0))
#define p_in (INF(1))
#define pos ((const int*)a.in[2])
#define ev_w_in INF(3)
#define ev_conv_w INF(4)
#define ev_sink INF(5)
#define ev_a_norm INF(6)
#define ev_b_norm INF(7)
#define ev_w_out INF(8)
#define od_w_in INF(9)
#define od_q_norm INF(10)
#define od_w_uq INF(11)
#define od_kv_norm INF(12)
#define od_w_ukv INF(13)
#define od_v_ln_g INF(14)
#define od_v_ln_b INF(15)
#define od_w_s INF(16)
#define od_b_s INF(17)
#define od_c_norm INF(18)
#define od_d_norm INF(19)
#define od_w_out INF(20)
#define post_ln_g INF(21)
#define post_ln_b INF(22)
#define ple_proj INF(23)
#define ple_gate INF(24)
#define WSP(T, off) ((T*)(a.ws + (off)))
#define WT_IN0 WSP(bf16_t, WS_WT_IN0)
#define WT_OUT0 WSP(bf16_t, WS_WT_OUT0)
#define WT_GATE0 WSP(bf16_t, WS_WT_GATE0)
#define WT_GATE1 WSP(bf16_t, WS_WT_GATE1)
#define WT_PROJ0 WSP(bf16_t, WS_WT_PROJ0)
#define WT_PROJ1 WSP(bf16_t, WS_WT_PROJ1)
#define WT_IN1 WSP(bf16_t, WS_WT_IN1)
#define WT_UQ WSP(bf16_t, WS_WT_UQ)
#define WT_UK WSP(bf16_t, WS_WT_UK)
#define WT_UV WSP(bf16_t, WS_WT_UV)
#define WT_OUT1 WSP(bf16_t, WS_WT_OUT1)
#define WSB WSP(bf16_t, WS_WSB)
#define GV WSP(float, WS_GV)
#define CS WSP(f32x2, WS_CS)
#define PART WSP(f32x2, WS_PART)
#define STATQ WSP(float, WS_STATQ)
#define STATKV WSP(float, WS_STATKV)
#define STATV WSP(f32x2, WS_STATV)
#define SSQC WSP(float, WS_SSQC)
#define MRBLK WSP(f32x2, WS_MRBLK)
#define XB WSP(bf16_t, WS_XB)
#define PB WSP(bf16_t, WS_PB)
#define PP WSP(bf16_t, WS_PP)
#define QB WSP(bf16_t, WS_PP)
#define H0 WSP(bf16_t, WS_HR)
#define H1 WSP(bf16_t, WS_HR)
#define UB WSP(bf16_t, WS_HR)
#define Y1B ((bf16_t*)a.out)
#define KB WSP(bf16_t, WS_KV)
#define VT WSP(bf16_t, WS_KV + 48 * MiB)

    PH(0) { PHASE_VARS const int tid = tid_from(wsg); const int gt = bid * 512 + tid, GT = G * 512;
        if (G >= 256 && bid < 256) {
            const int layer = bid >> 7, c = (bid & 127) * 8 + (tid & 7), ks = tid >> 3; const float* gate = ple_gate + (size_t)layer * DM * DM; const float* lg = post_ln_g + layer * DM; const float* lb = post_ln_b + layer * DM;
            float s1 = 0.f, s0 = 0.f;
#pragma unroll
            for (int k = ks * 16; k < ks * 16 + 16; ++k) { const float w = gate[(size_t)k * DM + c]; s1 += bf2f(f2bf(w * lg[k])); s0 += w * lb[k]; }
            float* red = (float*)lds; red[tid * 2] = s1; red[tid * 2 + 1] = s0;
            __syncthreads();
            if (tid < 8) { float t1 = 0.f, t0 = 0.f;
                for (int i = 0; i < 64; ++i) { t1 += red[(i * 8 + tid) * 2]; t0 += red[(i * 8 + tid) * 2 + 1]; }
                GV[layer * 2048 + c] = t1; GV[layer * 2048 + 1024 + c] = t0; }
            __syncthreads();
        } else if (G < 256 && bid < 32) {
            const int layer = bid >> 4, c = (bid & 15) * 64 + (tid & 63), kq = tid >> 6; const float* gate = ple_gate + (size_t)layer * DM * DM; const float* lg = post_ln_g + layer * DM; const float* lb = post_ln_b + layer * DM;
            float s1 = 0.f, s0 = 0.f;
            for (int k = kq * 128; k < kq * 128 + 128; ++k) { const float w = gate[(size_t)k * DM + c]; s1 += bf2f(f2bf(w * lg[k])); s0 += w * lb[k]; }
            float* red = (float*)lds; red[(kq * 64 + (tid & 63)) * 2] = s1; red[(kq * 64 + (tid & 63)) * 2 + 1] = s0;
            __syncthreads();
            if (tid < 64) { float t1 = 0.f, t0 = 0.f;
                for (int i = 0; i < 8; ++i) { t1 += red[(i * 64 + tid) * 2]; t0 += red[(i * 64 + tid) * 2 + 1]; }
                GV[layer * 2048 + c] = t1; GV[layer * 2048 + 1024 + c] = t0; }
            __syncthreads();
        }
        conv_w(ev_w_in, WT_IN0, 1024, EV_IN, EV_IN, 0, nullptr, nullptr, 0.125f * LOG2E, 512, gt, GT);
        conv_w(ev_w_out, WT_OUT0, 1024, 1024, 1024, 0, ev_a_norm, ev_b_norm, 1.f, 0, gt, GT);
        conv_w(ple_gate, WT_GATE0, 1024, 1024, 1024, 0, post_ln_g, nullptr, 1.f, 0, gt, GT);
        conv_w(ple_gate + (size_t)DM * DM, WT_GATE1, 1024, 1024, 1024, 0, post_ln_g + DM, nullptr, 1.f, 0, gt, GT);
        conv_w(ple_proj, WT_PROJ0, 256, 1024, 1024, 0, nullptr, nullptr, 1.f, 0, gt, GT);
        conv_w(ple_proj + 256 * DM, WT_PROJ1, 256, 1024, 1024, 0, nullptr, nullptr, 1.f, 0, gt, GT);
        conv_w(od_w_in, WT_IN1, 1024, OD_IN_SRC, OD_IN, 1, nullptr, nullptr, 1.f, 0, gt, GT);
        conv_w(od_w_uq, WT_UQ, 256, 768, 768, 2, od_q_norm, nullptr, 0.10206207261596577f * LOG2E, 768, gt, GT);
        conv_w(od_w_ukv, WT_UK, 128, 1024, 512, 3, od_kv_norm, nullptr, 1.f, 0, gt, GT);
        conv_w(od_w_ukv, WT_UV, 128, 1024, 512, 4, od_kv_norm, nullptr, 1.f, 0, gt, GT);
        conv_w(od_w_out, WT_OUT1, 1024, 1024, 1024, 0, od_c_norm, od_d_norm, 1.f, 0, gt, GT);
        conv_flat(od_w_s, WSB, (size_t)4 * 128 * 128 / 8, gt, GT);
        conv_flat(x_in, XB, (size_t)M * DM / 8, gt, GT);
        conv_flat(p_in, PB, (size_t)2 * M * 256 / 8, gt, GT);
        for (int i = gt; i < M * 16; i += GT) { const int row = i >> 4, j = i & 15; const float inv = exp2f(-(float)j * (13.287712379549449f / 16.f));
            double rev = (double)pos[row] * (double)inv * 0.15915494309189535; rev -= rint(rev); const float rf = (float)rev;
            CS[i] = (f32x2){__builtin_amdgcn_cosf(rf), __builtin_amdgcn_sinf(rf)}; }
    }
    if (a.ws == nullptr) grid.sync();
    SEAM();
    PH(1) { PHASE_VARS
        pg8::StaticOrder S; S.init(M, EV_IN, G, bid); pg8::Gemm g{XB, WT_IN0, M, EV_IN, 1024, 1024, 1024}; EpiStore E{H0, EV_IN, 1000};
        pg8::gemm_phase(wsg, lds3, g, S, E);
        pg8::StaticOrder S2; if (G == 256) S2.init(M, 1024, 128, bid - 128); else S2.init(M, 1024, G, bid);
        pg8::Gemm g2{PB, WT_PROJ0, M, 1024, 256, 256, 256}; EpiStore E2{PP, 1024, 1000};
        if (G != 256 || bid >= 128) pg8::gemm_phase(wsg, lds3, g2, S2, E2);
    }
    SEAM();
    PH(2) { PHASE_VARS for (int it = bid; it < 512; it += G) even_item(wsg, lds, H0, pos, ev_sink, ev_conv_w, XB, it >> 6, (it & 63) * 64); }
    SEAM();
    PH(3) { PHASE_VARS
        pg8::StaticOrder S; S.init(M, 1024, G, bid); pg8::Gemm g{XB, WT_OUT0, M, 1024, 1024, 1024, 1024}; EpiOut<false, false> E{x_in, UB, PART, nullptr};
        pg8::gemm_phase(wsg, lds3, g, S, E);
    }
    SEAM();
#define GATE_PHASE(WTG, LAYER, OUTF, XBOUT) do { \
        pg8::StaticOrder S; S.init(M, 1024, G, bid); \
        { int tq_ = tid_from(wsg); asm volatile("" : "+v"(tq_)); pg8::Unit u_; for (int i_ = tq_ >> 8; i_ < MR_UMAX && S.next(i_, u_); i_ += 2) { const int row_ = u_.pm * 256 + (tq_ & 255); const f32x4* pp_ = (const f32x4*)(PART + (size_t)row_ * 16); float s_ = 0.f, q_ = 0.f; \
              _Pragma("unroll") for (int j_ = 0; j_ < 8; ++j_) { const f32x4 v_ = pp_[j_]; s_ += v_[0] + v_[2]; q_ += v_[1] + v_[3]; } \
              const float mean_ = s_ * (1.f / 1024.f), var_ = q_ * (1.f / 1024.f) - mean_ * mean_; MRBLK[((size_t)bid * MR_UMAX + i_) * 256 + (tq_ & 255)] = (f32x2){mean_, rsqrtf(fmaxf(var_, 0.f) + EPS)}; } } \
        __threadfence_block(); __syncthreads(); \
        pg8::Gemm g{UB, WTG, M, 1024, 1024, 1024, 1024}; \
        EpiGate E{UB, MRBLK + (size_t)bid * MR_UMAX * 256, post_ln_g + (LAYER) * DM, post_ln_b + (LAYER) * DM, GV + (LAYER) * 2048, GV + (LAYER) * 2048 + 1024, PP, OUTF, XBOUT}; \
        pg8::gemm_phase(wsg, lds3, g, S, E); } while (0)
    PH(4) { PHASE_VARS GATE_PHASE(WT_GATE0, 0, (float*)nullptr, XB); }
    SEAM();
    PH(5) { PHASE_VARS
        pg8::StaticOrder S; S.init(M, OD_IN, G, bid); pg8::Gemm g{XB, WT_IN1, M, OD_IN, 1024, 1024, 1024}; EpiH1 E{H1, STATQ, STATKV, STATV, CS, KB};
        pg8::gemm_phase(wsg, lds3, g, S, E);
    }
    SEAM();
    PH(6) { PHASE_VARS
#ifndef P6MASK
#define P6MASK 15
#endif
        if constexpr (P6MASK & 1) { pg8::StaticOrder S; S.init(M, 768, G, bid); pg8::Gemm g{H1, WT_UQ, M, 768, 256, OD_IN, 256}; EpiQ E{STATQ, CS, QB}; pg8::gemm_phase(wsg, lds3, g, S, E); }
        if constexpr (P6MASK & 2) { pg8::StaticOrder S; S.init(M, 512, G, bid); pg8::Gemm g{H1 + 256, WT_UK, M, 512, 128, OD_IN, 128}; EpiK E{STATKV, KB}; pg8::gemm_phase(wsg, lds3, g, S, E); }
        if constexpr (P6MASK & 4) { pg8::StaticOrder S; S.init(512, M, G, bid); pg8::Gemm g{WT_UV, H1 + 256, 512, M, 128, 128, OD_IN}; EpiVT E{STATKV, VT}; pg8::gemm_phase(wsg, lds3, g, S, E); }
        if constexpr (P6MASK & 8) for (int it = bid; it < 256; it += G) gmlp_item(wsg, lds, H1, STATV, od_v_ln_g, od_v_ln_b, WSB, od_b_s, Y1B, it);
    }
    SEAM();
    PH(7) { PHASE_VARS for (int it = bid; it < 512; it += G) { const int xcd = it & 7, idx = it >> 3; mla_unit(wsg, lds, QB, KB, VT, H1, Y1B, SSQC, xcd * 8 + (idx >> 3), idx & 7); } }
    SEAM();
    PH(8) { PHASE_VARS
        pg8::StaticOrder S; S.init(M, 1024, G, bid); pg8::Gemm g{Y1B, WT_OUT1, M, 1024, 1024, 1024, 1024}; EpiOut<true, true> E{XB, UB, PART, SSQC};
        pg8::gemm_phase(wsg, lds3, g, S, E);
        pg8::StaticOrder S2; S2.init(M, 1024, G, bid); pg8::Gemm g2{PB + (size_t)M * 256, WT_PROJ1, M, 1024, 256, 256, 256}; EpiStore E2{PP, 1024, 1000};
        pg8::gemm_phase(wsg, lds3, g2, S2, E2);
    }
    SEAM();
    PH(9) { PHASE_VARS GATE_PHASE(WT_GATE1, 1, a.out, (bf16_t*)nullptr); }
}

extern "C" void kernel_launch(void* const* d_in, const int* in_sizes, int n_in, void* d_out, int out_size, void* d_ws, size_t ws_size, hipStream_t stream) {
    static int grid = 0;
    if (grid == 0) {
        if (n_in != 25 || out_size != M * DM || ws_size < WS_END) { fprintf(stderr, "kernel_launch: unexpected problem (n_in %d out %d ws %zu)\n", n_in, out_size, ws_size); grid = -1; return; }
        int dev = 0, cus = 0, per_cu = 0;
        (void)hipGetDevice(&dev);
        (void)hipDeviceGetAttribute(&cus, hipDeviceAttributeMultiprocessorCount, dev);
        (void)hipFuncSetAttribute((const void*)mega, hipFuncAttributeMaxDynamicSharedMemorySize, LDS_BYTES);
        (void)hipOccupancyMaxActiveBlocksPerMultiprocessor(&per_cu, (const void*)mega, 512, LDS_BYTES);
        if (per_cu < 1) { fprintf(stderr, "kernel_launch: occupancy query reports %d blocks per CU\n", per_cu); }
        grid = cus;
    }
    if (grid < 0) return;
    Args a{};
    for (int i = 0; i < 25; ++i) a.in[i] = d_in[i];
    a.out = (float*)d_out; a.ws = (unsigned char*)d_ws;
    (void)hipMemsetAsync((unsigned char*)d_ws + WS_BAR, 0, XCD_BAR_WORDS * 4, stream);
    void* args[] = {&a};
    hipError_t e = hipLaunchCooperativeKernel((const void*)mega, dim3(grid), dim3(512), args, LDS_BYTES, stream);
    if (e != hipSuccess) fprintf(stderr, "cooperative launch failed: %s (grid %d)\n", hipGetErrorString(e), grid);
}
```

```cpp
#include <hip/hip_runtime.h>
#include <hip/hip_cooperative_groups.h>
#include <cstdio>
#include <cstdint>
namespace cg = cooperative_groups;

#define LAS __attribute__((address_space(3)))
typedef unsigned short bf16_t;
typedef short bf16x8 __attribute__((ext_vector_type(8)));
typedef float f32x4 __attribute__((ext_vector_type(4)));
typedef float f32x2 __attribute__((ext_vector_type(2)));
typedef float f32x16 __attribute__((ext_vector_type(16)));
typedef unsigned u32x4 __attribute__((ext_vector_type(4)));
typedef unsigned u32x2 __attribute__((ext_vector_type(2)));

constexpr int BATCH = 8, SEQ = 4096, DM = 1024, M = BATCH * SEQ;
constexpr int EV_IN = 3328, OD_IN_SRC = 2464, OD_IN = 2560;
constexpr float EPS = 1e-6f, LOG2E = 1.4426950408889634f;
constexpr float DN_ALPHA = 1.4142135623730951f;
constexpr size_t MiB = 1u << 20;
constexpr size_t WS_WT_IN0 = 0, WS_WT_OUT0 = 7 * MiB, WS_WT_GATE0 = 9 * MiB, WS_WT_GATE1 = 11 * MiB, WS_WT_PROJ0 = 13 * MiB, WS_WT_PROJ1 = 13 * MiB + 512 * 1024,
                 WS_WT_IN1 = 14 * MiB, WS_WT_UQ = 19 * MiB, WS_WT_UK = 19 * MiB + 512 * 1024, WS_WT_UV = 19 * MiB + 768 * 1024, WS_WT_OUT1 = 20 * MiB,
                 WS_WSB = 22 * MiB, WS_GV = 22 * MiB + 512 * 1024, WS_CS = 23 * MiB, WS_PART = 27 * MiB, WS_STATQ = 31 * MiB, WS_STATKV = 31 * MiB + 512 * 1024,
                 WS_STATV = 32 * MiB, WS_SSQC = 34 * MiB, WS_MRBLK = 35 * MiB, WS_BAR = 39 * MiB,
                 WS_XB = 40 * MiB, WS_PB = 104 * MiB, WS_PP = 136 * MiB, WS_HR = 200 * MiB, WS_KV = 408 * MiB, WS_END = 488 * MiB;
constexpr int MR_UMAX = 8;

__device__ __forceinline__ unsigned cvt_pk_bf16(float lo, float hi) { unsigned r; asm volatile("v_cvt_pk_bf16_f32 %0, %1, %2" : "=v"(r) : "v"(lo), "v"(hi)); return r; }
__device__ __forceinline__ float bflo(unsigned w) { return __uint_as_float(w << 16); }
__device__ __forceinline__ float bfhi(unsigned w) { return __uint_as_float(w & 0xffff0000u); }
__device__ __forceinline__ float bf2f(bf16_t v) { return __uint_as_float((unsigned)v << 16); }
__device__ __forceinline__ bf16_t f2bf(float f) { return (bf16_t)(cvt_pk_bf16(f, 0.f) & 0xffffu); }
__device__ __forceinline__ float sigm(float x) { return __builtin_amdgcn_rcpf(1.f + __expf(-x)); }
__device__ __forceinline__ float siluf(float x) { return x * sigm(x); }
__device__ __forceinline__ float geluf(float x) { return x * sigm(1.5957691216057308f * (x + 0.044715f * x * x * x)); }
__device__ __forceinline__ u32x4 pack8(const f32x4 a, const f32x4 b) { u32x4 w; w.x = cvt_pk_bf16(a[0], a[1]); w.y = cvt_pk_bf16(a[2], a[3]); w.z = cvt_pk_bf16(b[0], b[1]); w.w = cvt_pk_bf16(b[2], b[3]); return w; }

template <int X> __device__ __forceinline__ float swz_xor(float v) { return __int_as_float(__builtin_amdgcn_ds_swizzle(__float_as_int(v), (X << 10) | 0x1f)); }
__device__ __forceinline__ float xor32_add(float v) { auto rr = __builtin_amdgcn_permlane32_swap(__float_as_uint(v), __float_as_uint(v), false, false); return __uint_as_float(rr[0]) + __uint_as_float(rr[1]); }
__device__ __forceinline__ float xor32_max(float v) { auto rr = __builtin_amdgcn_permlane32_swap(__float_as_uint(v), __float_as_uint(v), false, false); return fmaxf(__uint_as_float(rr[0]), __uint_as_float(rr[1])); }
__device__ __forceinline__ int lane_id_v() { int l; asm volatile("v_mbcnt_lo_u32_b32 %0, -1, 0\n\tv_mbcnt_hi_u32_b32 %0, -1, %0" : "=v"(l)); return l; }
__device__ __forceinline__ int tid_from(int wsg) { int l; asm volatile("v_mbcnt_lo_u32_b32 %0, -1, 0\n\tv_mbcnt_hi_u32_b32 %0, -1, %0" : "=v"(l)); return (wsg << 6) | l; }
__device__ __forceinline__ void swap32(unsigned& a, unsigned& b) { auto r = __builtin_amdgcn_permlane32_swap(a, b, false, false); a = r[0]; b = r[1]; }
namespace pg8 {
constexpr int BM = 256, BK = 64, HALF = 128, HTB = HALF * BK * 2, STAGE_BYTES = 8 * HTB, NXCD = 8, WGM = 8;
__host__ __device__ __forceinline__ int lds_byte(int r, int c) { const int st = (r >> 4) * 2 + (c >> 5), rr = r & 15, cc = c & 31, ob = rr * 64 + cc * 2; return st * 1024 + (ob ^ (((ob >> 9) & 1) << 5)); }
__host__ __device__ __forceinline__ void stage_rc(int b, int& R, int& C) { const int st = b / 1024, sb = b % 1024, swz = sb ^ (((sb >> 9) & 1) << 5); R = (st >> 1) * 16 + swz / 64; C = (st & 1) * 32 + (swz % 64) / 2; }
__host__ __device__ __forceinline__ int perm32(int rho) { const int n = rho >> 4, i = rho & 15; return 8 * (i >> 2) + 4 * n + (i & 3); }
struct Unit { int pm, pn, idx; };
struct Gemm { const bf16_t* A; const bf16_t* Bt; int M, N, K, lda, ldb; };
struct StaticOrder {
    int nM, nN, nwg, G, c;
    __device__ __forceinline__ void init(int M_, int N_, int G_, int c_) { nM = M_ / BM; nN = N_ / BM; nwg = nM * nN; G = G_; c = c_; }
    __device__ __forceinline__ bool next(int i, Unit& u) const {
        const long L = (long)i * G + c; if (L >= nwg) return false;
        int wgid = (int)L; { const int q = nwg / NXCD, r = nwg % NXCD, xcd = wgid % NXCD, off = wgid / NXCD; wgid = (xcd < r ? xcd * (q + 1) : r * (q + 1) + (xcd - r) * q) + off; }
        const int nig = WGM * nN, gid = wgid / nig, fm = gid * WGM, gsz = (nM - fm) < WGM ? (nM - fm) : WGM;
        u.pm = fm + ((wgid % nig) % gsz); u.pn = (wgid % nig) / gsz; u.idx = i; return true;
    }
};
template <class Epi, class Sched>
__device__ __forceinline__ void gemm_phase(int wsg, LAS unsigned char* lds, const Gemm g, const Sched& S, const Epi& E) {
    int tid_ = tid_from(wsg); asm volatile("" : "+v"(tid_));
    const int tid = tid_, wid = __builtin_amdgcn_readfirstlane(tid >> 6), lane = tid & 63, wr = wid >> 2, wc = wid & 3, fr = lane & 15, fq = lane >> 4;
    const int K = g.K, nt = K / BK;
    unsigned voffA[2], voffB[2];
#pragma unroll
    for (int i = 0; i < 2; ++i) { int R, C; stage_rc(tid * 16 + i * 8192, R, C); const int Rb = (R & ~31) + perm32(R & 31);
        voffA[i] = (unsigned)(R * g.lda + C) * 2u; voffB[i] = (unsigned)(Rb * g.ldb + C) * 2u; }
    const size_t kstep = (size_t)(BK * 2);
    const size_t hstepA = (size_t)HALF * g.lda * 2, hstepB = (size_t)HALF * g.ldb * 2;
    const size_t tstepA = 2 * hstepA, tstepB = 2 * hstepB;
    const unsigned ldsw = (unsigned)wid * 1024u;
    const int aoff = lds_byte(wr * 64 + fr, fq * 8), boff = lds_byte(wc * 32 + fr, fq * 8);
#define PG8_SA(b, h) (((b) * 2 + (h)) * HTB)
#define PG8_SB(b, h) ((4 + (b) * 2 + (h)) * HTB)
#define PG8_STAGE(bufoff, gbase, voff) do { _Pragma("unroll") for (int _i = 0; _i < 2; ++_i) \
        __builtin_amdgcn_global_load_lds((const unsigned*)((const char*)(gbase) + (voff)[_i]), (LAS unsigned*)(lds + (bufoff) + ldsw + _i * 8192), 16, 0, 0); } while (0)
#define PG8_LDA(dst, b, h) do { _Pragma("unroll") for (int m = 0; m < 4; ++m) _Pragma("unroll") for (int k = 0; k < 2; ++k) dst[m][k] = *(const LAS bf16x8*)(lds + PG8_SA(b, h) + aoff + m * 2048 + k * 1024); } while (0)
#define PG8_LDB(dst, b, h) do { _Pragma("unroll") for (int n = 0; n < 2; ++n) _Pragma("unroll") for (int k = 0; k < 2; ++k) dst[n][k] = *(const LAS bf16x8*)(lds + PG8_SB(b, h) + boff + n * 2048 + k * 1024); } while (0)
#define PG8_MMA(ai, bj, At, Bt) do { __builtin_amdgcn_s_setprio(1); _Pragma("unroll") for (int m = 0; m < 4; ++m) _Pragma("unroll") for (int n = 0; n < 2; ++n) _Pragma("unroll") for (int k = 0; k < 2; ++k) \
        acc[ai][bj][m][n] = __builtin_amdgcn_mfma_f32_16x16x32_bf16(Bt[n][k], At[m][k], acc[ai][bj][m][n], 0, 0, 0); __builtin_amdgcn_s_setprio(0); } while (0)
#define PG8_WAIT_V(n) asm volatile("s_waitcnt vmcnt(" #n ")" ::: "memory")
#define PG8_WAIT_L(n) asm volatile("s_waitcnt lgkmcnt(" #n ")" ::: "memory")
#define PG8_BAR __builtin_amdgcn_s_barrier()
#define PG8_SCHED __builtin_amdgcn_sched_barrier(0)
    Unit cur, nxt; int ui = 0;
    if (!S.next(0, cur)) return;
    f32x4 acc[2][2][4][2];
#pragma unroll
    for (int a = 0; a < 2; ++a)
#pragma unroll
        for (int b = 0; b < 2; ++b)
#pragma unroll
            for (int m = 0; m < 4; ++m)
#pragma unroll
                for (int n = 0; n < 2; ++n) acc[a][b][m][n] = (f32x4){0.f, 0.f, 0.f, 0.f};
    bf16x8 At[4][2], B0[2][2], B1[2][2];
    const char* cA = (const char*)g.A + (size_t)cur.pm * tstepA; const char* cB = (const char*)g.Bt + (size_t)cur.pn * tstepB;
    PG8_STAGE(PG8_SB(0, 0), cB, voffB); PG8_STAGE(PG8_SB(0, 1), cB + hstepB, voffB); PG8_STAGE(PG8_SA(0, 0), cA, voffA); PG8_STAGE(PG8_SA(0, 1), cA + hstepA, voffA);
    if (wr == 1) PG8_BAR;
    PG8_WAIT_V(2); PG8_BAR;
    PG8_STAGE(PG8_SB(1, 0), cB + kstep, voffB); PG8_STAGE(PG8_SA(1, 0), cA + kstep, voffA); PG8_STAGE(PG8_SB(1, 1), cB + hstepB + kstep, voffB);
    PG8_WAIT_V(6); PG8_BAR;
    for (;;) {
        const bool has_next = S.next(ui + 1, nxt);
        const char* nA = has_next ? (const char*)g.A + (size_t)nxt.pm * tstepA : cA; const char* nB = has_next ? (const char*)g.Bt + (size_t)nxt.pn * tstepB : cB;
        for (int t = 0; t < nt; t += 2) {
            const bool last = (t == nt - 2);
            const char* a1 = cA + (size_t)(t + 1) * kstep;
            const char* a2 = last ? nA : cA + (size_t)(t + 2) * kstep; const char* b2 = last ? nB : cB + (size_t)(t + 2) * kstep;
            const char* a3 = a2 + kstep; const char* b3 = b2 + kstep;
            if constexpr (Epi::MID) { if (t == (nt >> 1)) E.mid(acc, cur, wr, lane_id_v() & 15); }
            PG8_LDB(B0, 0, 0); PG8_LDB(B1, 0, 1); PG8_SCHED; PG8_LDA(At, 0, 0); PG8_STAGE(PG8_SA(1, 1), a1 + hstepA, voffA);
            PG8_WAIT_V(8); PG8_WAIT_L(0); PG8_BAR; PG8_MMA(0, 0, At, B0); PG8_MMA(0, 1, At, B1); PG8_BAR; PG8_SCHED;
            PG8_LDA(At, 0, 1); PG8_STAGE(PG8_SB(0, 0), b2, voffB); PG8_STAGE(PG8_SB(0, 1), b2 + hstepB, voffB); PG8_STAGE(PG8_SA(0, 0), a2, voffA);
            PG8_WAIT_V(8); PG8_WAIT_L(0); PG8_BAR; PG8_MMA(1, 0, At, B0); PG8_MMA(1, 1, At, B1); PG8_BAR; PG8_SCHED;
            PG8_LDB(B0, 1, 0); PG8_LDB(B1, 1, 1); PG8_SCHED; PG8_LDA(At, 1, 0); PG8_STAGE(PG8_SA(0, 1), a2 + hstepA, voffA);
            PG8_WAIT_V(8); PG8_WAIT_L(0); PG8_BAR; PG8_MMA(0, 0, At, B0); PG8_MMA(0, 1, At, B1); PG8_BAR; PG8_SCHED;
            PG8_LDA(At, 1, 1); PG8_STAGE(PG8_SB(1, 0), b3, voffB); PG8_STAGE(PG8_SB(1, 1), b3 + hstepB, voffB); PG8_STAGE(PG8_SA(1, 0), a3, voffA);
            PG8_WAIT_V(8); PG8_WAIT_L(0); PG8_BAR; PG8_MMA(1, 0, At, B0); PG8_MMA(1, 1, At, B1); PG8_BAR; PG8_SCHED;
        }
        if (wr == 0) PG8_BAR;
        { const int l_e = lane_id_v(); E(acc, cur, wr, wc, l_e & 15, l_e >> 4); }
        if (!has_next) break;
#pragma unroll
        for (int a = 0; a < 2; ++a)
#pragma unroll
            for (int b = 0; b < 2; ++b)
#pragma unroll
                for (int m = 0; m < 4; ++m)
#pragma unroll
                    for (int n = 0; n < 2; ++n) acc[a][b][m][n] = (f32x4){0.f, 0.f, 0.f, 0.f};
        cur = nxt; cA = nA; cB = nB; ++ui;
        if (wr == 1) PG8_BAR;
    }
    PG8_WAIT_V(0);
    PG8_BAR;
#undef PG8_SA
#undef PG8_SB
#undef PG8_STAGE
#undef PG8_LDA
#undef PG8_LDB
#undef PG8_MMA
#undef PG8_WAIT_V
#undef PG8_WAIT_L
#undef PG8_BAR
#undef PG8_SCHED
}
}
using pg8::Unit;
typedef f32x4 AccT[2][2][4][2];
#define EPI_ROW(u, ai, m) ((u).pm * 256 + (ai) * 128 + wr * 64 + (m) * 16 + fr)
#define EPI_LCOL(bj) ((bj) * 128 + wc * 32 + 8 * fq)

struct EpiStore {
    static constexpr bool MID = false;
    bf16_t* O; int ldc; int silu_pn;
    __device__ __forceinline__ void operator()(const AccT& acc, const Unit& u, int wr, int wc, int fr, int fq) const {
        const bool act = u.pn >= silu_pn;
#pragma unroll
        for (int ai = 0; ai < 2; ++ai)
#pragma unroll
            for (int m = 0; m < 4; ++m) { bf16_t* rowp = O + (size_t)EPI_ROW(u, ai, m) * ldc + u.pn * 256;
#pragma unroll
                for (int bj = 0; bj < 2; ++bj) { f32x4 v0 = acc[ai][bj][m][0], v1 = acc[ai][bj][m][1];
                    if (act) {
#pragma unroll
                        for (int e = 0; e < 4; ++e) { v0[e] = siluf(v0[e]); v1[e] = siluf(v1[e]); } }
                    *(u32x4*)(rowp + EPI_LCOL(bj)) = pack8(v0, v1); }
                asm volatile("" ::: "memory"); }
    }
};
template <bool MIDSCALE, bool RESBF> struct EpiOut {
    static constexpr bool MID = MIDSCALE;
    const void* res; bf16_t* Ub; f32x2* part; const float* ssqC;
    __device__ __forceinline__ void mid(AccT& acc, const Unit& u, int wr, int fr) const {
#pragma unroll
        for (int ai = 0; ai < 2; ++ai)
#pragma unroll
            for (int m = 0; m < 4; ++m) { const int row = EPI_ROW(u, ai, m); const f32x4 a = *(const f32x4*)(ssqC + (size_t)row * 8), b = *(const f32x4*)(ssqC + (size_t)row * 8 + 4);
                const float s = ((a[0] + a[1]) + (a[2] + a[3])) + ((b[0] + b[1]) + (b[2] + b[3])); const float rc = rsqrtf(s * (1.f / 512.f) + EPS);
#pragma unroll
                for (int bj = 0; bj < 2; ++bj)
#pragma unroll
                    for (int n = 0; n < 2; ++n) acc[ai][bj][m][n] *= rc; }
    }
    __device__ __forceinline__ void operator()(const AccT& acc, const Unit& u, int wr, int wc, int fr, int fq) const {
#pragma unroll
        for (int ai = 0; ai < 2; ++ai)
#pragma unroll
            for (int m = 0; m < 4; ++m) { const int row = EPI_ROW(u, ai, m); const size_t off = (size_t)row * DM + u.pn * 256; float s = 0.f, q = 0.f;
#pragma unroll
                for (int bj = 0; bj < 2; ++bj) { const size_t o = off + EPI_LCOL(bj); f32x4 r0, r1;
                    if constexpr (RESBF) { const u32x4 rw = *(const u32x4*)((const bf16_t*)res + o); r0 = (f32x4){bflo(rw.x), bfhi(rw.x), bflo(rw.y), bfhi(rw.y)}; r1 = (f32x4){bflo(rw.z), bfhi(rw.z), bflo(rw.w), bfhi(rw.w)}; }
                    else { r0 = *(const f32x4*)((const float*)res + o); r1 = *(const f32x4*)((const float*)res + o + 4); }
                    const f32x4 u0 = r0 * DN_ALPHA + acc[ai][bj][m][0], u1 = r1 * DN_ALPHA + acc[ai][bj][m][1];
                    *(u32x4*)(Ub + o) = pack8(u0, u1);
                    s += ((u0[0] + u0[1]) + (u0[2] + u0[3])) + ((u1[0] + u1[1]) + (u1[2] + u1[3]));
                    q += ((u0[0] * u0[0] + u0[1] * u0[1]) + (u0[2] * u0[2] + u0[3] * u0[3])) + ((u1[0] * u1[0] + u1[1] * u1[1]) + (u1[2] * u1[2] + u1[3] * u1[3])); }
                s += swz_xor<16>(s); s = xor32_add(s); q += swz_xor<16>(q); q = xor32_add(q);
                if (fq == 0) part[(size_t)row * 16 + u.pn * 4 + wc] = (f32x2){s, q};
                asm volatile("" ::: "memory"); }
    }
};
struct EpiGate {
    static constexpr bool MID = false;
    const bf16_t* Ub; const f32x2* mr; const float* lng; const float* lnb; const float* G1; const float* G0; const bf16_t* pp; float* out; bf16_t* xb;
    __device__ __forceinline__ void operator()(const AccT& acc, const Unit& u, int wr, int wc, int fr, int fq) const {
#pragma unroll
        for (int bj = 0; bj < 2; ++bj) { const int col = u.pn * 256 + EPI_LCOL(bj);
            f32x4 g[2], b[2], g1[2], g0[2];
#pragma unroll
            for (int n = 0; n < 2; ++n) { g[n] = *(const f32x4*)(lng + col + 4 * n); b[n] = *(const f32x4*)(lnb + col + 4 * n); g1[n] = *(const f32x4*)(G1 + col + 4 * n); g0[n] = *(const f32x4*)(G0 + col + 4 * n); }
#pragma unroll
            for (int ai = 0; ai < 2; ++ai)
#pragma unroll
                for (int m = 0; m < 4; ++m) { const int rl = ai * 128 + wr * 64 + m * 16 + fr; const f32x2 st = mr[u.idx * 256 + rl]; const size_t o = (size_t)(u.pm * 256 + rl) * DM + col;
                    const u32x4 pw = *(const u32x4*)(pp + o), uw = *(const u32x4*)(Ub + o); f32x4 ov[2];
                    const float ppv[8] = {bflo(pw.x), bfhi(pw.x), bflo(pw.y), bfhi(pw.y), bflo(pw.z), bfhi(pw.z), bflo(pw.w), bfhi(pw.w)};
                    const float uv[8] = {bflo(uw.x), bfhi(uw.x), bflo(uw.y), bfhi(uw.y), bflo(uw.z), bfhi(uw.z), bflo(uw.w), bfhi(uw.w)};
#pragma unroll
                    for (int n = 0; n < 2; ++n) {
#pragma unroll
                        for (int e = 0; e < 4; ++e) { const float h = (uv[4 * n + e] - st.x) * st.y * g[n][e] + b[n][e]; const float t = st.y * (acc[ai][bj][m][n][e] - st.x * g1[n][e]) + g0[n][e];
                            ov[n][e] = h + sigm(t) * ppv[4 * n + e]; } }
                    if (out) { __builtin_nontemporal_store(ov[0], (f32x4*)(out + o)); __builtin_nontemporal_store(ov[1], (f32x4*)(out + o + 4)); }
                    if (xb) *(u32x4*)(xb + o) = pack8(ov[0], ov[1]);
                    asm volatile("" ::: "memory"); } }
    }
};
struct EpiH1 {
    static constexpr bool MID = false;
    bf16_t* H1; float* statQ; float* statKV; f32x2* statV; const f32x2* cs; bf16_t* Kb;
    __device__ __forceinline__ void operator()(const AccT& acc, const Unit& u, int wr, int wc, int fr, int fq) const {
        const int pn = u.pn;
#pragma unroll
        for (int ai = 0; ai < 2; ++ai)
#pragma unroll
            for (int m = 0; m < 4; ++m) { const int row = EPI_ROW(u, ai, m); bf16_t* rowp = H1 + (size_t)row * OD_IN + pn * 256;
                if (pn == 0) { float q = 0.f;
#pragma unroll
                    for (int bj = 0; bj < 2; ++bj) { const f32x4 v0 = acc[ai][bj][m][0], v1 = acc[ai][bj][m][1]; *(u32x4*)(rowp + EPI_LCOL(bj)) = pack8(v0, v1);
                        q += ((v0[0] * v0[0] + v0[1] * v0[1]) + (v0[2] * v0[2] + v0[3] * v0[3])) + ((v1[0] * v1[0] + v1[1] * v1[1]) + (v1[2] * v1[2] + v1[3] * v1[3])); }
                    q += swz_xor<16>(q); q = xor32_add(q); if (fq == 0) statQ[(size_t)row * 4 + wc] = q;
                } else if (pn == 1) {
                    { const f32x4 v0 = acc[ai][0][m][0], v1 = acc[ai][0][m][1]; *(u32x4*)(rowp + EPI_LCOL(0)) = pack8(v0, v1);
                      float q = ((v0[0] * v0[0] + v0[1] * v0[1]) + (v0[2] * v0[2] + v0[3] * v0[3])) + ((v1[0] * v1[0] + v1[1] * v1[1]) + (v1[2] * v1[2] + v1[3] * v1[3]));
                      q += swz_xor<16>(q); q = xor32_add(q); if (fq == 0) statKV[(size_t)row * 4 + wc] = q; }
                    if (wc == 0) { const f32x4 v0 = acc[ai][1][m][0], v1 = acc[ai][1][m][1]; const float x[8] = {v0[0], v0[1], v0[2], v0[3], v1[0], v1[1], v1[2], v1[3]};
                        const f32x4 c01 = *(const f32x4*)(cs + (size_t)row * 16 + 4 * fq), c23 = *(const f32x4*)(cs + (size_t)row * 16 + 4 * fq + 2);
                        const float cc[4] = {c01[0], c01[2], c23[0], c23[2]}, ss[4] = {c01[1], c01[3], c23[1], c23[3]}; float o[8];
#pragma unroll
                        for (int e = 0; e < 4; ++e) { o[2 * e] = x[2 * e] * cc[e] - x[2 * e + 1] * ss[e]; o[2 * e + 1] = x[2 * e] * ss[e] + x[2 * e + 1] * cc[e]; }
                        u32x4 w; w.x = cvt_pk_bf16(o[0], o[1]); w.y = cvt_pk_bf16(o[2], o[3]); w.z = cvt_pk_bf16(o[4], o[5]); w.w = cvt_pk_bf16(o[6], o[7]);
                        const int b = row >> 12, s = row & 4095;
#pragma unroll
                        for (int h = 0; h < 8; ++h) *(u32x4*)(Kb + ((size_t)(b * 8 + h) * SEQ + s) * 96 + 64 + 8 * fq) = w; }
                } else if (pn < 6) { float s = 0.f, q = 0.f;
#pragma unroll
                    for (int bj = 0; bj < 2; ++bj) { f32x4 v0 = acc[ai][bj][m][0], v1 = acc[ai][bj][m][1];
#pragma unroll
                        for (int e = 0; e < 4; ++e) { v0[e] = geluf(v0[e]); v1[e] = geluf(v1[e]); }
                        *(u32x4*)(rowp + EPI_LCOL(bj)) = pack8(v0, v1);
                        s += ((v0[0] + v0[1]) + (v0[2] + v0[3])) + ((v1[0] + v1[1]) + (v1[2] + v1[3]));
                        q += ((v0[0] * v0[0] + v0[1] * v0[1]) + (v0[2] * v0[2] + v0[3] * v0[3])) + ((v1[0] * v1[0] + v1[1] * v1[1]) + (v1[2] * v1[2] + v1[3] * v1[3])); }
                    if (pn >= 4) { s += swz_xor<16>(s); s = xor32_add(s); q += swz_xor<16>(q); q = xor32_add(q);
                        if (fq == 0) statV[(size_t)row * 8 + (pn - 4) * 4 + wc] = (f32x2){s, q}; }
                } else {
#pragma unroll
                    for (int bj = 0; bj < 2; ++bj) *(u32x4*)(rowp + EPI_LCOL(bj)) = pack8(acc[ai][bj][m][0], acc[ai][bj][m][1]); }
                asm volatile("" ::: "memory"); }
    }
};
struct EpiQ {
    static constexpr bool MID = false;
    const float* statQ; const f32x2* cs; bf16_t* Qb;
    __device__ __forceinline__ void operator()(const AccT& acc, const Unit& u, int wr, int wc, int fr, int fq) const {
#pragma unroll
        for (int ai = 0; ai < 2; ++ai)
#pragma unroll
            for (int m = 0; m < 4; ++m) { const int row = EPI_ROW(u, ai, m); const f32x4 sq = *(const f32x4*)(statQ + (size_t)row * 4);
                const float rq = rsqrtf(((sq[0] + sq[1]) + (sq[2] + sq[3])) * (1.f / 256.f) + EPS); const int b = row >> 12, s = row & 4095;
#pragma unroll
                for (int bj = 0; bj < 2; ++bj) { const int col = u.pn * 256 + EPI_LCOL(bj), h = col / 96, j = col - h * 96;
                    const f32x4 v0 = acc[ai][bj][m][0] * rq, v1 = acc[ai][bj][m][1] * rq; u32x4 w;
                    if (j >= 64) { const int i0 = (j - 64) >> 1; const float x[8] = {v0[0], v0[1], v0[2], v0[3], v1[0], v1[1], v1[2], v1[3]};
                        const f32x4 c01 = *(const f32x4*)(cs + (size_t)row * 16 + i0), c23 = *(const f32x4*)(cs + (size_t)row * 16 + i0 + 2);
                        const float cc[4] = {c01[0], c01[2], c23[0], c23[2]}, ss[4] = {c01[1], c01[3], c23[1], c23[3]}; float o[8];
#pragma unroll
                        for (int e = 0; e < 4; ++e) { o[2 * e] = x[2 * e] * cc[e] - x[2 * e + 1] * ss[e]; o[2 * e + 1] = x[2 * e] * ss[e] + x[2 * e + 1] * cc[e]; }
                        w.x = cvt_pk_bf16(o[0], o[1]); w.y = cvt_pk_bf16(o[2], o[3]); w.z = cvt_pk_bf16(o[4], o[5]); w.w = cvt_pk_bf16(o[6], o[7]);
                    } else w = pack8(v0, v1);
                    *(u32x4*)(Qb + ((size_t)(b * 8 + h) * SEQ + s) * 96 + j) = w; }
                asm volatile("" ::: "memory"); }
    }
};
struct EpiK {
    static constexpr bool MID = false;
    const float* statKV; bf16_t* Kb;
    __device__ __forceinline__ void operator()(const AccT& acc, const Unit& u, int wr, int wc, int fr, int fq) const {
#pragma unroll
        for (int ai = 0; ai < 2; ++ai)
#pragma unroll
            for (int m = 0; m < 4; ++m) { const int row = EPI_ROW(u, ai, m); const f32x4 sq = *(const f32x4*)(statKV + (size_t)row * 4);
                const float rk = rsqrtf(((sq[0] + sq[1]) + (sq[2] + sq[3])) * (1.f / 128.f) + EPS); const int b = row >> 12, s = row & 4095;
#pragma unroll
                for (int bj = 0; bj < 2; ++bj) { const int col = u.pn * 256 + EPI_LCOL(bj), h = col >> 6, j = col & 63;
                    *(u32x4*)(Kb + ((size_t)(b * 8 + h) * SEQ + s) * 96 + j) = pack8(acc[ai][bj][m][0] * rk, acc[ai][bj][m][1] * rk); }
                asm volatile("" ::: "memory"); }
    }
};
struct EpiVT {
    static constexpr bool MID = false;
    const float* statKV; bf16_t* Vt;
    __device__ __forceinline__ void operator()(const AccT& acc, const Unit& u, int wr, int wc, int fr, int fq) const {
#pragma unroll
        for (int bj = 0; bj < 2; ++bj) { const int tok = u.pn * 256 + EPI_LCOL(bj), b = tok >> 12, s = tok & 4095; float rk[8];
#pragma unroll
            for (int e = 0; e < 8; ++e) { const f32x4 sq = *(const f32x4*)(statKV + (size_t)(tok + e) * 4); rk[e] = rsqrtf(((sq[0] + sq[1]) + (sq[2] + sq[3])) * (1.f / 128.f) + EPS); }
#pragma unroll
            for (int ai = 0; ai < 2; ++ai)
#pragma unroll
                for (int m = 0; m < 4; ++m) { const int hd = EPI_ROW(u, ai, m); f32x4 v0 = acc[ai][bj][m][0], v1 = acc[ai][bj][m][1];
#pragma unroll
                    for (int e = 0; e < 4; ++e) { v0[e] *= rk[e]; v1[e] *= rk[4 + e]; }
                    *(u32x4*)(Vt + ((size_t)b * 512 + hd) * SEQ + s) = pack8(v0, v1);
                    asm volatile("" ::: "memory"); } }
    }
};

__device__ __forceinline__ int colmap(int map, int n) {
    switch (map) {
    case 1: { if (n < 384) return n; if (n < 416) { const int j = n - 384, i = j >> 1; return 384 + ((j & 1) ? i + 16 : i); } if (n < 512) return -1; if (n < 1024) return 416 + (n - 512); if (n < 1536) return 928 + (n - 1024); return 1440 + (n - 1536); }
    case 2: { const int h = n / 96, j = n - h * 96; if (j < 64) return n; const int jj = j - 64, i = jj >> 1; return h * 96 + 64 + ((jj & 1) ? i + 16 : i); }
    case 3: return (n >> 6) * 128 + (n & 63);
    case 4: return (n >> 6) * 128 + 64 + (n & 63);
    default: return n;
    }
}
__device__ __forceinline__ void conv_w(const float* W, bf16_t* WT, int K, int Nsrc, int Ndst, int map, const float* rs, const float* rs2, float cscale, int cs_upto, int gt, int GT) {
    const int nitem = Ndst * (K >> 3);
    const int nb8 = Ndst >> 3;
    for (int it = gt; it < nitem; it += GT) { const int rest = it >> 6, n = (rest % nb8) * 8 + ((it >> 3) & 7), k0 = ((rest / nb8) * 8 + (it & 7)) * 8; const int src = colmap(map, n); const float cs = (n < cs_upto) ? cscale : 1.f; const int srcc = src < 0 ? 0 : src; const float csz = src < 0 ? 0.f : cs; float v[8];
#pragma unroll
        for (int e = 0; e < 8; ++e) { const int k = k0 + e; const float w = W[(size_t)k * Nsrc + srcc]; v[e] = w * csz; }
        if (rs) { const float* rp = (rs2 && k0 >= 512) ? (rs2 + (k0 - 512)) : (rs + k0); const f32x4 ra = *(const f32x4*)rp, rb4 = *(const f32x4*)(rp + 4);
#pragma unroll
            for (int e = 0; e < 4; ++e) { v[e] *= ra[e]; v[4 + e] *= rb4[e]; } }
        u32x4 o; o.x = cvt_pk_bf16(v[0], v[1]); o.y = cvt_pk_bf16(v[2], v[3]); o.z = cvt_pk_bf16(v[4], v[5]); o.w = cvt_pk_bf16(v[6], v[7]);
        *(u32x4*)(WT + (size_t)n * K + k0) = o; }
}
__device__ __forceinline__ void conv_flat(const float* src, bf16_t* dst, size_t n8, int gt, int GT) {
    size_t i = gt;
    for (; i + 3 * (size_t)GT < n8; i += 4 * (size_t)GT) { f32x4 a[4], b[4];
#pragma unroll
        for (int j = 0; j < 4; ++j) { a[j] = __builtin_nontemporal_load((const f32x4*)(src + (i + j * (size_t)GT) * 8)); b[j] = __builtin_nontemporal_load((const f32x4*)(src + (i + j * (size_t)GT) * 8 + 4)); }
#pragma unroll
        for (int j = 0; j < 4; ++j) *(u32x4*)(dst + (i + j * (size_t)GT) * 8) = pack8(a[j], b[j]); }
    for (; i < n8; i += GT) { const f32x4 a = *(const f32x4*)(src + i * 8), b = *(const f32x4*)(src + i * 8 + 4); *(u32x4*)(dst + i * 8) = pack8(a, b); }
}

struct Args { const void* in[25]; float* out; unsigned char* ws; };

__device__ __forceinline__ int kappa(int r) { return (r & ~12) | ((r & 4) << 1) | ((r & 8) >> 1); }
constexpr int EK_ROW = 72, EK_BUF = 64 * EK_ROW * 2, EV_STAGE = 4 * EK_BUF + 256;
__device__ __forceinline__ void even_item(int wsg, unsigned char* lds, const bf16_t* H0, const int* pos, const float* sink, const float* convw, bf16_t* Y0, int b, int q0) {
    int tid_ = tid_from(wsg); asm volatile("" : "+v"(tid_));
    const int tid = tid_, lane = tid & 63, wid = tid >> 6, r32 = lane & 31, hi = lane >> 5;
    const int h = wid, kvh = h >> 2;
    const size_t tb = (size_t)b * SEQ;
    bf16x8 qf[2][4]; float posq[2];
#pragma unroll
    for (int qb = 0; qb < 2; ++qb) { const size_t t = tb + q0 + 32 * qb + r32; posq[qb] = (float)pos[t];
#pragma unroll
        for (int ks = 0; ks < 4; ++ks) qf[qb][ks] = *(const bf16x8*)(H0 + t * EV_IN + h * 64 + 16 * ks + 8 * hi); }
    const float slope2 = exp2f(-(float)(h + 1)) * LOG2E, sink2 = sink[h] * LOG2E;
    f32x16 O[2][2]; float mrun[2], lrun[2];
#pragma unroll
    for (int qb = 0; qb < 2; ++qb) { mrun[qb] = sink2; lrun[qb] = (hi == 0) ? 1.f : 0.f; O[qb][0] = (f32x16){}; O[qb][1] = (f32x16){}; }
    u32x4 gk[2], gv[2]; float gp = 0.f;
#define EV_ISSUE(j_) do { const int kbase_ = q0 - 128 + 64 * (j_); \
        _Pragma("unroll") for (int i = 0; i < 2; ++i) { const int c = tid + i * 512; \
            { const int key = (c >> 3) & 63, ch = c & 7, kg = min(max(kbase_ + key, 0), SEQ - 1); gk[i] = *(const u32x4*)(H0 + (tb + kg) * EV_IN + 512 + i * 64 + ch * 8); } \
            { const int key = c & 63, ch = (c >> 6) & 7, kg = min(max(kbase_ + key, 0), SEQ - 1); gv[i] = *(const u32x4*)(H0 + (tb + kg) * EV_IN + 640 + i * 64 + ch * 8); } } \
        { const int kg = min(max(kbase_ + (tid & 63), 0), SEQ - 1); gp = (float)pos[tb + kg]; } } while (0)
#define EV_COMMIT(p_) do { unsigned char* base_ = lds + (p_) * EV_STAGE; \
        _Pragma("unroll") for (int i = 0; i < 2; ++i) { const int c = tid + i * 512; \
            { const int key = (c >> 3) & 63, ch = c & 7; *(u32x4*)(base_ + i * EK_BUF + (key * EK_ROW + ch * 8) * 2) = gk[i]; } \
            { const int key = c & 63, ch = (c >> 6) & 7; const u32x4 v = gv[i]; bf16_t* vt = (bf16_t*)(base_ + 2 * EK_BUF + i * EK_BUF) + (ch * 8) * EK_ROW + key; \
              vt[0 * EK_ROW] = (bf16_t)(v.x & 0xffffu); vt[1 * EK_ROW] = (bf16_t)(v.x >> 16); vt[2 * EK_ROW] = (bf16_t)(v.y & 0xffffu); vt[3 * EK_ROW] = (bf16_t)(v.y >> 16); \
              vt[4 * EK_ROW] = (bf16_t)(v.z & 0xffffu); vt[5 * EK_ROW] = (bf16_t)(v.z >> 16); vt[6 * EK_ROW] = (bf16_t)(v.w & 0xffffu); vt[7 * EK_ROW] = (bf16_t)(v.w >> 16); } } \
        ((float*)(base_ + 4 * EK_BUF))[tid & 63] = gp; } while (0)
    __syncthreads();
    EV_ISSUE(0); EV_COMMIT(0);
    __syncthreads();
#pragma unroll 1
    for (int j = 0; j < 5; ++j) {
        const int kbase = q0 - 128 + 64 * j; const int pbuf = j & 1;
        if (j + 1 < 5) EV_ISSUE(j + 1);
        const unsigned char* KLp = lds + pbuf * EV_STAGE; const unsigned char* VTp = KLp + 2 * EK_BUF; const float* posK = (const float*)(KLp + 4 * EK_BUF);
        const unsigned char* kb = KLp + kvh * EK_BUF; const unsigned char* vb = VTp + kvh * EK_BUF;
        f32x16 S[2][2];
#pragma unroll
        for (int rb = 0; rb < 2; ++rb) { bf16x8 kf[4];
#pragma unroll
            for (int ks = 0; ks < 4; ++ks) kf[ks] = *(const bf16x8*)(kb + ((kappa(r32) + 32 * rb) * EK_ROW + 16 * ks + 8 * hi) * 2);
#pragma unroll
            for (int qb = 0; qb < 2; ++qb) { f32x16 a = (f32x16){};
#pragma unroll
                for (int ks = 0; ks < 4; ++ks) a = __builtin_amdgcn_mfma_f32_32x32x16_bf16(kf[ks], qf[qb][ks], a, 0, 0, 0);
                S[qb][rb] = a; } }
#pragma unroll
        for (int qb = 0; qb < 2; ++qb) { const int qg = q0 + 32 * qb + r32; float mx = -1e30f;
            const int lo = max(-kbase, qg - 128 - kbase) - 8 * hi; const unsigned span = (unsigned)(min(SEQ - 1 - kbase, qg + 128 - kbase) - 8 * hi - lo);
            const float* pk_ = posK + 8 * hi;
#pragma unroll
            for (int rb = 0; rb < 2; ++rb)
#pragma unroll
                for (int hf = 0; hf < 2; ++hf) {
                    const f32x4 pa = *(const f32x4*)(pk_ + 32 * rb + 16 * hf), pb = *(const f32x4*)(pk_ + 32 * rb + 16 * hf + 4);
                    const float pkv[8] = {pa[0], pa[1], pa[2], pa[3], pb[0], pb[1], pb[2], pb[3]};
#pragma unroll
                    for (int i = 0; i < 8; ++i) { const int r = 8 * hf + i, c = 32 * rb + i + 16 * hf;
                        const float bias = slope2 * fabsf(posq[qb] - pkv[i]); const float sv0 = S[qb][rb][r] - bias;
                        const bool valid = (unsigned)(c - lo) <= span;
                        const float sv = valid ? sv0 : -1e30f; S[qb][rb][r] = sv; mx = fmaxf(mx, sv); }
                    __builtin_amdgcn_sched_barrier(0); }
            mx = xor32_max(mx);
            const float mnew = fmaxf(mrun[qb], mx), alpha = __builtin_amdgcn_exp2f(mrun[qb] - mnew); mrun[qb] = mnew; float ps = 0.f;
#pragma unroll
            for (int rb = 0; rb < 2; ++rb)
#pragma unroll
                for (int r = 0; r < 16; ++r) { const float p = __builtin_amdgcn_exp2f(S[qb][rb][r] - mnew); S[qb][rb][r] = p; ps += p; }
            lrun[qb] = lrun[qb] * alpha + ps;
#pragma unroll
            for (int db = 0; db < 2; ++db) O[qb][db] *= alpha; }
#pragma unroll
        for (int mm = 0; mm < 4; ++mm) { bf16x8 pf[2];
#pragma unroll
            for (int qb = 0; qb < 2; ++qb) { const f32x16& s = S[qb][mm >> 1]; const int o = 8 * (mm & 1); u32x4 w;
                w.x = cvt_pk_bf16(s[o + 0], s[o + 1]); w.y = cvt_pk_bf16(s[o + 2], s[o + 3]); w.z = cvt_pk_bf16(s[o + 4], s[o + 5]); w.w = cvt_pk_bf16(s[o + 6], s[o + 7]); pf[qb] = __builtin_bit_cast(bf16x8, w); }
#pragma unroll
            for (int db = 0; db < 2; ++db) { const bf16x8 vf = *(const bf16x8*)(vb + ((32 * db + r32) * EK_ROW + 16 * mm + 8 * hi) * 2);
#pragma unroll
                for (int qb = 0; qb < 2; ++qb) O[qb][db] = __builtin_amdgcn_mfma_f32_32x32x16_bf16(vf, pf[qb], O[qb][db], 0, 0, 0); } }
        if (j + 1 < 5) EV_COMMIT(pbuf ^ 1);
        __syncthreads();
    }
#undef EV_ISSUE
#undef EV_COMMIT
    float* ssq = (float*)lds;
#pragma unroll
    for (int qb = 0; qb < 2; ++qb) { float l = lrun[qb]; l = xor32_add(l); const float il = 1.f / l; float q = 0.f;
#pragma unroll
        for (int db = 0; db < 2; ++db) { O[qb][db] *= il;
#pragma unroll
            for (int r = 0; r < 16; ++r) q += O[qb][db][r] * O[qb][db][r]; }
        q = xor32_add(q); if (hi == 0) ssq[h * 64 + 32 * qb + r32] = q; }
    __syncthreads();
#pragma unroll
    for (int qb = 0; qb < 2; ++qb) { float s = 0.f;
#pragma unroll
        for (int hh = 0; hh < 8; ++hh) s += ssq[hh * 64 + 32 * qb + r32];
        const float ra = rsqrtf(s * (1.f / 512.f) + EPS); const size_t t = tb + q0 + 32 * qb + r32;
#pragma unroll
        for (int kp = 0; kp < 4; ++kp) {
            const int db = kp >> 1, ga = (2 * kp) & 3, gb = ga + 1, c16 = 16 * kp + 8 * hi;
            u32x4 zq = *(const u32x4*)(H0 + t * EV_IN + 2304 + h * 64 + c16);
            unsigned z0 = zq.x, z1 = zq.y, z2 = zq.z, z3 = zq.w; swap32(z0, z2); swap32(z1, z3); zq = (u32x4){z0, z1, z2, z3};
            unsigned a0 = cvt_pk_bf16(O[qb][db][4 * ga + 0] * ra * siluf(bflo(zq.x)), O[qb][db][4 * ga + 1] * ra * siluf(bfhi(zq.x))), a1 = cvt_pk_bf16(O[qb][db][4 * ga + 2] * ra * siluf(bflo(zq.y)), O[qb][db][4 * ga + 3] * ra * siluf(bfhi(zq.y)));
            unsigned b0 = cvt_pk_bf16(O[qb][db][4 * gb + 0] * ra * siluf(bflo(zq.z)), O[qb][db][4 * gb + 1] * ra * siluf(bfhi(zq.z))), b1 = cvt_pk_bf16(O[qb][db][4 * gb + 2] * ra * siluf(bflo(zq.w)), O[qb][db][4 * gb + 3] * ra * siluf(bfhi(zq.w)));
            swap32(a0, b0); swap32(a1, b1);
            *(u32x4*)(Y0 + t * DM + h * 64 + c16) = (u32x4){a0, a1, b0, b1}; } }
    { const int c0 = lane * 8; float cw[3][8];
#pragma unroll
        for (int jj = 0; jj < 3; ++jj) { const f32x4 a = *(const f32x4*)(convw + jj * 512 + c0), bq = *(const f32x4*)(convw + jj * 512 + c0 + 4);
#pragma unroll
            for (int e = 0; e < 4; ++e) { cw[jj][e] = a[e]; cw[jj][4 + e] = bq[e]; } }
        const int t0 = q0 + wid * 8;
#define EV_Z(dst, j_) do { const float vm_ = ((tg - 1 + (j_)) >= 0 && (tg - 1 + (j_)) < SEQ) ? 1.f : 0.f; const u32x4 cg_ = CG[j_], xi_ = XI[j_]; \
            dst[0] = bflo(cg_.x) * bflo(xi_.x) * vm_; dst[1] = bfhi(cg_.x) * bfhi(xi_.x) * vm_; dst[2] = bflo(cg_.y) * bflo(xi_.y) * vm_; dst[3] = bfhi(cg_.y) * bfhi(xi_.y) * vm_; \
            dst[4] = bflo(cg_.z) * bflo(xi_.z) * vm_; dst[5] = bfhi(cg_.z) * bfhi(xi_.z) * vm_; dst[6] = bflo(cg_.w) * bflo(xi_.w) * vm_; dst[7] = bfhi(cg_.w) * bfhi(xi_.w) * vm_; } while (0)
#pragma unroll 1
        for (int hg = 0; hg < 2; ++hg) { const int tg = t0 + 4 * hg; u32x4 CG[6], XI[6], BG[4], ZW[4];
#pragma unroll
            for (int j = 0; j < 6; ++j) { const int tc = min(max(tg - 1 + j, 0), SEQ - 1); CG[j] = *(const u32x4*)(H0 + (tb + tc) * EV_IN + 1280 + c0); XI[j] = *(const u32x4*)(H0 + (tb + tc) * EV_IN + 1792 + c0); }
#pragma unroll
            for (int i = 0; i < 4; ++i) { BG[i] = *(const u32x4*)(H0 + (tb + tg + i) * EV_IN + 768 + c0); ZW[i] = *(const u32x4*)(H0 + (tb + tg + i) * EV_IN + 2304 + 512 + c0); }
            float zp[8], zc[8], zn[8];
            EV_Z(zp, 0); EV_Z(zc, 1);
#pragma unroll
            for (int i = 0; i < 4; ++i) { const int t = tg + i; EV_Z(zn, i + 2);
                const u32x4 bgw = BG[i], zw = ZW[i];
                const float bg[8] = {bflo(bgw.x), bfhi(bgw.x), bflo(bgw.y), bfhi(bgw.y), bflo(bgw.z), bfhi(bgw.z), bflo(bgw.w), bfhi(bgw.w)};
                const float zz[8] = {siluf(bflo(zw.x)), siluf(bfhi(zw.x)), siluf(bflo(zw.y)), siluf(bfhi(zw.y)), siluf(bflo(zw.z)), siluf(bfhi(zw.z)), siluf(bflo(zw.w)), siluf(bfhi(zw.w))};
                float y[8], q = 0.f;
#pragma unroll
                for (int e = 0; e < 8; ++e) { y[e] = bg[e] * (cw[0][e] * zp[e] + cw[1][e] * zc[e] + cw[2][e] * zn[e]); q += y[e] * y[e]; }
                q += swz_xor<1>(q); q += swz_xor<2>(q); q += swz_xor<4>(q); q += swz_xor<8>(q); q += swz_xor<16>(q); q = xor32_add(q);
                const float rb = rsqrtf(q * (1.f / 512.f) + EPS); u32x4 w;
                w.x = cvt_pk_bf16(y[0] * rb * zz[0], y[1] * rb * zz[1]); w.y = cvt_pk_bf16(y[2] * rb * zz[2], y[3] * rb * zz[3]);
                w.z = cvt_pk_bf16(y[4] * rb * zz[4], y[5] * rb * zz[5]); w.w = cvt_pk_bf16(y[6] * rb * zz[6], y[7] * rb * zz[7]);
                *(u32x4*)(Y0 + (tb + t) * DM + 512 + c0) = w;
#pragma unroll
                for (int e = 0; e < 8; ++e) { zp[e] = zc[e]; zc[e] = zn[e]; }
                __builtin_amdgcn_sched_barrier(0); } }
#undef EV_Z
    }
}

constexpr int GV_ROW = 136, GV_BUF = 128 * GV_ROW * 2;
__device__ __forceinline__ void gmlp_item(int wsg, unsigned char* lds, const bf16_t* H1, const f32x2* statV, const float* lng, const float* lnb, const bf16_t* WSb, const float* bs, bf16_t* Y1, int chunk) {
    int tid_ = tid_from(wsg); asm volatile("" : "+v"(tid_));
    const int tid = tid_, lane = tid & 63, wid = tid >> 6, fr = lane & 15, fq = lane >> 4;
    f32x2* mr = (f32x2*)(lds + 2 * GV_BUF);
    const size_t row0 = (size_t)chunk * 128;
    __syncthreads();
    if (tid < 128) { const f32x2* p = statV + (row0 + tid) * 8; float s = 0.f, q = 0.f;
#pragma unroll
        for (int i = 0; i < 8; ++i) { const f32x2 v = p[i]; s += v.x; q += v.y; }
        const float mean = s * (1.f / 512.f), var = q * (1.f / 512.f) - mean * mean; mr[tid] = (f32x2){mean, rsqrtf(fmaxf(var, 0.f) + EPS)}; }
    const int st_s = (tid >> 2) & 127, st_cl = tid & 3;
    u32x4 gst[4];
#define GM_ISSUE(g_) do { _Pragma("unroll") for (int i = 0; i < 4; ++i) gst[i] = *(const u32x4*)(H1 + (row0 + st_s) * OD_IN + 1024 + (g_) * 128 + (st_cl + 4 * i) * 8); } while (0)
#define GM_COMMIT(g_, buf_) do { bf16_t* VnT_ = (bf16_t*)(lds + (buf_) * GV_BUF); const f32x2 st = mr[st_s]; \
        _Pragma("unroll") for (int i = 0; i < 4; ++i) { const int ch = st_cl + 4 * i, cb = (g_) * 128 + ch * 8; const u32x4 v = gst[i]; \
            const f32x4 ga = *(const f32x4*)(lng + cb), gb = *(const f32x4*)(lng + cb + 4), ba = *(const f32x4*)(lnb + cb), bb = *(const f32x4*)(lnb + cb + 4); \
            const float x[8] = {bflo(v.x), bfhi(v.x), bflo(v.y), bfhi(v.y), bflo(v.z), bfhi(v.z), bflo(v.w), bfhi(v.w)}; \
            const float gg[8] = {ga[0], ga[1], ga[2], ga[3], gb[0], gb[1], gb[2], gb[3]}, bbv[8] = {ba[0], ba[1], ba[2], ba[3], bb[0], bb[1], bb[2], bb[3]}; \
            _Pragma("unroll") for (int e = 0; e < 8; ++e) VnT_[(ch * 8 + e) * GV_ROW + st_s] = f2bf((x[e] - st.x) * st.y * gg[e] + bbv[e]); } } while (0)
    unsigned ydp[4][8][2]; float q = 0.f;
    const size_t trow = row0 + 16 * wid + fr;
    GM_ISSUE(0);
    __syncthreads();
    GM_COMMIT(0, 0);
    __syncthreads();
#pragma unroll
    for (int g = 0; g < 4; ++g) {
        if (g < 3) GM_ISSUE(g + 1);
        const bf16_t* VnT = (const bf16_t*)(lds + (g & 1) * GV_BUF);
        bf16x8 wf[4];
#pragma unroll
        for (int ks = 0; ks < 4; ++ks) wf[ks] = *(const bf16x8*)(WSb + ((size_t)g * 128 + 16 * wid + fr) * 128 + 32 * ks + 8 * fq);
        const float bsv = bs[g * 128 + 16 * wid + fr];
#pragma unroll
        for (int nb = 0; nb < 8; ++nb) { f32x4 a = (f32x4){0.f, 0.f, 0.f, 0.f};
#pragma unroll
            for (int ks = 0; ks < 4; ++ks) { const bf16x8 vf = *(const bf16x8*)(VnT + (16 * nb + fr) * GV_ROW + 32 * ks + 8 * fq); a = __builtin_amdgcn_mfma_f32_16x16x32_bf16(vf, wf[ks], a, 0, 0, 0); }
            const int d = g * 128 + 16 * nb + 4 * fq; const u32x2 uw = *(const u32x2*)(H1 + trow * OD_IN + 512 + d);
            const float y0 = bflo(uw.x) * (a[0] + bsv), y1 = bfhi(uw.x) * (a[1] + bsv), y2 = bflo(uw.y) * (a[2] + bsv), y3 = bfhi(uw.y) * (a[3] + bsv);
            q += (y0 * y0 + y1 * y1) + (y2 * y2 + y3 * y3); ydp[g][nb][0] = cvt_pk_bf16(y0, y1); ydp[g][nb][1] = cvt_pk_bf16(y2, y3); }
        if (g < 3) GM_COMMIT(g + 1, (g + 1) & 1);
        __syncthreads();
        __builtin_amdgcn_sched_barrier(0);
    }
#undef GM_ISSUE
#undef GM_COMMIT
    q += swz_xor<16>(q); q = xor32_add(q);
    const float rd = rsqrtf(q * (1.f / 512.f) + EPS);
#pragma unroll
    for (int g = 0; g < 4; ++g)
#pragma unroll
        for (int nb = 0; nb < 8; ++nb) { const int d = g * 128 + 16 * nb + 4 * fq; const u32x2 zw = *(const u32x2*)(H1 + trow * OD_IN + 1536 + 512 + d); u32x2 w;
            w.x = cvt_pk_bf16(bflo(ydp[g][nb][0]) * rd * siluf(bflo(zw.x)), bfhi(ydp[g][nb][0]) * rd * siluf(bfhi(zw.x))); w.y = cvt_pk_bf16(bflo(ydp[g][nb][1]) * rd * siluf(bflo(zw.y)), bfhi(ydp[g][nb][1]) * rd * siluf(bfhi(zw.y)));
            *(u32x2*)(Y1 + trow * DM + 512 + d) = w; }
}

constexpr int MK_ROW = 104, MK_BUF = 64 * MK_ROW * 2, MV_ROW = 72, MV_BUF = 64 * MV_ROW * 2;
__device__ __forceinline__ void mla_unit(int wsg, unsigned char* lds, const bf16_t* Qb, const bf16_t* Kb, const bf16_t* Vt, const bf16_t* H1, bf16_t* Y1, float* ssqC, int bh, int qblk) {
    int tid_ = tid_from(wsg); asm volatile("" : "+v"(tid_));
    const int tid = tid_, lane = tid & 63, wid = tid >> 6, r32 = lane & 31, hi = lane >> 5;
    const int b = bh >> 3, h = bh & 7;
    const bf16_t* Kg = Kb + (size_t)bh * SEQ * 96; const bf16_t* Vg = Vt + (size_t)bh * 64 * SEQ;
    const int qrow0 = qblk * 512 + wid * 64;
    bf16x8 qf[2][6];
#pragma unroll
    for (int qb = 0; qb < 2; ++qb)
#pragma unroll
        for (int ks = 0; ks < 6; ++ks) qf[qb][ks] = *(const bf16x8*)(Qb + ((size_t)bh * SEQ + qrow0 + 32 * qb + r32) * 96 + 16 * ks + 8 * hi);
    f32x16 O[2][2]; float mrun[2], lrun[2];
#pragma unroll
    for (int qb = 0; qb < 2; ++qb) { mrun[qb] = -1e30f; lrun[qb] = 0.f; O[qb][0] = (f32x16){}; O[qb][1] = (f32x16){}; }
    const int kc0 = tid, kc1 = tid + 512; const int vc = (tid >= 256) ? tid - 256 : tid + 256;
    const int k0_key = kc0 / 12, k0_ch = kc0 - k0_key * 12, k1_key = kc1 / 12, k1_ch = kc1 - k1_key * 12;
    const unsigned k0_l = (k0_key * MK_ROW + k0_ch * 8) * 2, k1_l = (k1_key * MK_ROW + k1_ch * 8) * 2, v_l = ((vc >> 3) * MV_ROW + (vc & 7) * 8) * 2;
    const bf16_t* vsrc = Vg + (size_t)(vc >> 3) * SEQ + (vc & 7) * 8;
    u32x4 g0, g1, g2 = (u32x4){0u, 0u, 0u, 0u};
#define MLA_ISSUE(t) do { g0 = *(const u32x4*)(Kg + (size_t)(t) * 64 * 96 + kc0 * 8); if (tid < 256) { g1 = *(const u32x4*)(Kg + (size_t)(t) * 64 * 96 + kc1 * 8); g2 = *(const u32x4*)(vsrc + (t) * 64); } else { g1 = *(const u32x4*)(vsrc + (t) * 64); } } while (0)
#define MLA_COMMIT(p) do { unsigned char* kb_ = lds + (p) * MK_BUF; unsigned char* vb_ = lds + 2 * MK_BUF + (p) * MV_BUF; *(u32x4*)(kb_ + k0_l) = g0; \
        if (tid < 256) { *(u32x4*)(kb_ + k1_l) = g1; *(u32x4*)(vb_ + v_l) = g2; } else { *(u32x4*)(vb_ + v_l) = g1; } } while (0)
    __syncthreads();
    MLA_ISSUE(0); MLA_COMMIT(0);
    __syncthreads();
    const int krow = kappa(r32);
    for (int t = 0; t < 64; ++t) {
        const int p = t & 1;
        if (t + 1 < 64) MLA_ISSUE(t + 1);
        const unsigned char* kb = lds + p * MK_BUF; const unsigned char* vb = lds + 2 * MK_BUF + p * MV_BUF;
        f32x16 S[2][2];
#pragma unroll
        for (int rb = 0; rb < 2; ++rb) { bf16x8 kf[6];
#pragma unroll
            for (int ks = 0; ks < 6; ++ks) kf[ks] = *(const bf16x8*)(kb + ((krow + 32 * rb) * MK_ROW + 16 * ks + 8 * hi) * 2);
#pragma unroll
            for (int qb = 0; qb < 2; ++qb) { f32x16 a = (f32x16){};
#pragma unroll
                for (int ks = 0; ks < 6; ++ks) a = __builtin_amdgcn_mfma_f32_32x32x16_bf16(kf[ks], qf[qb][ks], a, 0, 0, 0);
                S[qb][rb] = a; } }
#pragma unroll
        for (int qb = 0; qb < 2; ++qb) { float mx = -1e30f;
#pragma unroll
            for (int rb = 0; rb < 2; ++rb)
#pragma unroll
                for (int r = 0; r < 16; ++r) mx = fmaxf(mx, S[qb][rb][r]);
            if (__builtin_expect(__builtin_amdgcn_ballot_w64(mx - mrun[qb] > 8.0f) != 0ull, 0)) { mx = xor32_max(mx);
                const float mnew_ = fmaxf(mrun[qb], mx), alpha = __builtin_amdgcn_exp2f(mrun[qb] - mnew_); mrun[qb] = mnew_; lrun[qb] *= alpha;
#pragma unroll
                for (int db = 0; db < 2; ++db) O[qb][db] *= alpha; }
            const float mnew = mrun[qb]; float ps = 0.f;
#pragma unroll
            for (int rb = 0; rb < 2; ++rb)
#pragma unroll
                for (int r = 0; r < 16; ++r) { const float pe = __builtin_amdgcn_exp2f(S[qb][rb][r] - mnew); S[qb][rb][r] = pe; ps += pe; }
            lrun[qb] += ps; }
#pragma unroll
        for (int mm = 0; mm < 4; ++mm) { bf16x8 pf[2];
#pragma unroll
            for (int qb = 0; qb < 2; ++qb) { const f32x16& s = S[qb][mm >> 1]; const int o = 8 * (mm & 1); u32x4 w;
                w.x = cvt_pk_bf16(s[o + 0], s[o + 1]); w.y = cvt_pk_bf16(s[o + 2], s[o + 3]); w.z = cvt_pk_bf16(s[o + 4], s[o + 5]); w.w = cvt_pk_bf16(s[o + 6], s[o + 7]); pf[qb] = __builtin_bit_cast(bf16x8, w); }
#pragma unroll
            for (int db = 0; db < 2; ++db) { const bf16x8 vf = *(const bf16x8*)(vb + ((32 * db + r32) * MV_ROW + 16 * mm + 8 * hi) * 2);
#pragma unroll
                for (int qb = 0; qb < 2; ++qb) O[qb][db] = __builtin_amdgcn_mfma_f32_32x32x16_bf16(vf, pf[qb], O[qb][db], 0, 0, 0); } }
        if (t + 1 < 64) MLA_COMMIT(p ^ 1);
        __syncthreads();
    }
#undef MLA_ISSUE
#undef MLA_COMMIT
#pragma unroll
    for (int qb = 0; qb < 2; ++qb) { float l = lrun[qb]; l = xor32_add(l); const float il = 1.f / l; float q = 0.f;
        const size_t t = (size_t)b * SEQ + qrow0 + 32 * qb + r32;
#pragma unroll
        for (int db = 0; db < 2; ++db) { O[qb][db] *= il;
#pragma unroll
            for (int r = 0; r < 16; ++r) q += O[qb][db][r] * O[qb][db][r]; }
        q = xor32_add(q); if (hi == 0) ssqC[t * 8 + h] = q;
#pragma unroll
        for (int kp = 0; kp < 4; ++kp) {
            const int db = kp >> 1, ga = (2 * kp) & 3, gb = ga + 1, c16 = 16 * kp + 8 * hi;
            u32x4 zq = *(const u32x4*)(H1 + t * OD_IN + 1536 + h * 64 + c16);
            unsigned z0 = zq.x, z1 = zq.y, z2 = zq.z, z3 = zq.w; swap32(z0, z2); swap32(z1, z3); zq = (u32x4){z0, z1, z2, z3};
            unsigned a0 = cvt_pk_bf16(O[qb][db][4 * ga + 0] * siluf(bflo(zq.x)), O[qb][db][4 * ga + 1] * siluf(bfhi(zq.x))), a1 = cvt_pk_bf16(O[qb][db][4 * ga + 2] * siluf(bflo(zq.y)), O[qb][db][4 * ga + 3] * siluf(bfhi(zq.y)));
            unsigned b0 = cvt_pk_bf16(O[qb][db][4 * gb + 0] * siluf(bflo(zq.z)), O[qb][db][4 * gb + 1] * siluf(bfhi(zq.z))), b1 = cvt_pk_bf16(O[qb][db][4 * gb + 2] * siluf(bflo(zq.w)), O[qb][db][4 * gb + 3] * siluf(bfhi(zq.w)));
            swap32(a0, b0); swap32(a1, b1);
            *(u32x4*)(Y1 + t * DM + h * 64 + c16) = (u32x4){a0, a1, b0, b1}; } }
}

#define XB_TMO      128
#define XB_XCNT(j)  (256  + 64 * (j))
#define XB_XSUB(j)  (1280 + 64 * (j))
#define XB_XGEN(j)  (2304 + 64 * (j))
#define XB_TOP      3328
#define XB_TOPGEN   3392
#define XCD_BAR_WORDS 3456
#define XB_SPIN_CAP (1u << 18)
__device__ __forceinline__ unsigned xb_ld(unsigned* p)              { return __hip_atomic_load(p, __ATOMIC_RELAXED, __HIP_MEMORY_SCOPE_AGENT); }
__device__ __forceinline__ unsigned xb_add(unsigned* p, unsigned v) { return __hip_atomic_fetch_add(p, v, __ATOMIC_RELAXED, __HIP_MEMORY_SCOPE_AGENT); }
__device__ __forceinline__ unsigned xb_xcc_id() { return (unsigned)__builtin_amdgcn_s_getreg((3 << 11) | 20) & 0xFu; }
#define XB_SPIN(cond, bar) do { unsigned _sp = 0; while (cond) { __builtin_amdgcn_s_sleep(1); \
    if ((++_sp & 255u) == 0u) { if (xb_ld(&(bar)[XB_TMO])) break; if (_sp > XB_SPIN_CAP) { atomicAdd(&(bar)[XB_TMO], 1u); break; } } } } while (0)
__device__ __forceinline__ void xcd_barrier_complete(unsigned* bar, unsigned x, unsigned& nloc, unsigned& nx) {
    const unsigned G = gridDim.x * gridDim.y * gridDim.z;
    unsigned sum, cnt, mine, sp = 0u;
    for (;;) {
        sum = 0u; cnt = 0u; mine = 0u;
#pragma unroll
        for (unsigned j = 0; j < 16; ++j) { const unsigned c = xb_ld(&bar[XB_XCNT(j)]); sum += c; cnt += (c > 0u) ? 1u : 0u; mine = (j == x) ? c : mine; }
        if (sum == G) break;
        __builtin_amdgcn_s_sleep(1);
        if ((++sp & 255u) == 0u) { if (xb_ld(&bar[XB_TMO])) break; if (sp > XB_SPIN_CAP) { atomicAdd(&bar[XB_TMO], 1u); break; } }
    }
    nloc = mine > 0u ? mine : 1u; nx = cnt > 0u ? cnt : 1u;
}
__device__ __forceinline__ void xcd_barrier(unsigned* bar, volatile LAS unsigned* st, int wsg) {
    asm volatile("s_waitcnt vmcnt(0)" ::: "memory");
    __syncthreads();
    if (tid_from(wsg) == 0) {
        __builtin_amdgcn_s_waitcnt(0);
        const unsigned x = xb_xcc_id();
        unsigned nloc = st[0], nx = st[1];
        if (nloc == 0u) { xcd_barrier_complete(bar, x, nloc, nx); st[0] = nloc; st[1] = nx; }
        const unsigned old = xb_add(&bar[XB_XSUB(x)], 1u);
        const unsigned gen = old / nloc;
        if (old + 1u == (gen + 1u) * nloc) {
            __builtin_amdgcn_fence(__ATOMIC_RELEASE, "agent");
            asm volatile("s_waitcnt vmcnt(0)" ::: "memory");
            const unsigned og = xb_add(&bar[XB_TOP], 1u);
            const unsigned tg = og / nx;
            if (og + 1u == (tg + 1u) * nx) xb_add(&bar[XB_TOPGEN], 1u);
            else XB_SPIN(xb_ld(&bar[XB_TOPGEN]) == tg, bar);
            __builtin_amdgcn_fence(__ATOMIC_ACQUIRE, "agent");
            xb_add(&bar[XB_XGEN(x)], 1u);
            asm volatile("s_waitcnt vmcnt(0)" ::: "memory");
        } else {
            XB_SPIN(xb_ld(&bar[XB_XGEN(x)]) == gen, bar);
            __builtin_amdgcn_fence(__ATOMIC_ACQUIRE, "agent");
            asm volatile("s_waitcnt vmcnt(0)" ::: "memory");
        }
    }
    __syncthreads();
}

constexpr int LDS_BYTES = 147456;
#ifndef PHMASK
#define PHMASK 0x3ff
#endif
#ifndef DUPMASK
#define DUPMASK 0x000
#endif
#define PH(k) for (int rep_ = 0; rep_ < (((DUPMASK >> (k)) & 1) ? 2 : 1); ++rep_) if constexpr ((PHMASK >> (k)) & 1)
__global__ void __launch_bounds__(512, 2) mega(Args a) {
    extern __shared__ __attribute__((aligned(16))) unsigned char lds_raw[];
    cg::grid_group grid = cg::this_grid();
    LAS unsigned char* lds3 = (LAS unsigned char*)lds_raw;
    unsigned char* lds = lds_raw;
    const int wsg = __builtin_amdgcn_readfirstlane(threadIdx.x >> 6);
    volatile LAS unsigned* xb_st = (volatile LAS unsigned*)(lds3 + (LDS_BYTES - 16));
    if (threadIdx.x < 4) xb_st[threadIdx.x] = 0u;
    __syncthreads();
    if (threadIdx.x == 0) (void)xb_add((unsigned*)(a.ws + WS_BAR) + XB_XCNT(xb_xcc_id()), 1u);
#define SEAM() xcd_barrier((unsigned*)(a.ws + WS_BAR), xb_st, wsg)
#define PHASE_VARS int bid = blockIdx.x, G = gridDim.x; asm volatile("" : "+s"(bid), "+s"(G));
#define INF(i) ((const float*)a.in[i])
#define x_in (INF(0))
#define p_in (INF(1))
#define pos ((const int*)a.in[2])
#define ev_w_in INF(3)
#define ev_conv_w INF(4)
#define ev_sink INF(5)
#define ev_a_norm INF(6)
#define ev_b_norm INF(7)
#define ev_w_out INF(8)
#define od_w_in INF(9)
#define od_q_norm INF(10)
#define od_w_uq INF(11)
#define od_kv_norm INF(12)
#define od_w_ukv INF(13)
#define od_v_ln_g INF(14)
#define od_v_ln_b INF(15)
#define od_w_s INF(16)
#define od_b_s INF(17)
#define od_c_norm INF(18)
#define od_d_norm INF(19)
#define od_w_out INF(20)
#define post_ln_g INF(21)
#define post_ln_b INF(22)
#define ple_proj INF(23)
#define ple_gate INF(24)
#define WSP(T, off) ((T*)(a.ws + (off)))
#define WT_IN0 WSP(bf16_t, WS_WT_IN0)
#define WT_OUT0 WSP(bf16_t, WS_WT_OUT0)
#define WT_GATE0 WSP(bf16_t, WS_WT_GATE0)
#define WT_GATE1 WSP(bf16_t, WS_WT_GATE1)
#define WT_PROJ0 WSP(bf16_t, WS_WT_PROJ0)
#define WT_PROJ1 WSP(bf16_t, WS_WT_PROJ1)
#define WT_IN1 WSP(bf16_t, WS_WT_IN1)
#define WT_UQ WSP(bf16_t, WS_WT_UQ)
#define WT_UK WSP(bf16_t, WS_WT_UK)
#define WT_UV WSP(bf16_t, WS_WT_UV)
#define WT_OUT1 WSP(bf16_t, WS_WT_OUT1)
#define WSB WSP(bf16_t, WS_WSB)
#define GV WSP(float, WS_GV)
#define CS WSP(f32x2, WS_CS)
#define PART WSP(f32x2, WS_PART)
#define STATQ WSP(float, WS_STATQ)
#define STATKV WSP(float, WS_STATKV)
#define STATV WSP(f32x2, WS_STATV)
#define SSQC WSP(float, WS_SSQC)
#define MRBLK WSP(f32x2, WS_MRBLK)
#define XB WSP(bf16_t, WS_XB)
#define PB WSP(bf16_t, WS_PB)
#define PP WSP(bf16_t, WS_PP)
#define QB WSP(bf16_t, WS_PP)
#define H0 WSP(bf16_t, WS_HR)
#define H1 WSP(bf16_t, WS_HR)
#define UB WSP(bf16_t, WS_HR)
#define Y1B ((bf16_t*)a.out)
#define KB WSP(bf16_t, WS_KV)
#define VT WSP(bf16_t, WS_KV + 48 * MiB)

    PH(0) { PHASE_VARS const int tid = tid_from(wsg); const int gt = bid * 512 + tid, GT = G * 512;
        if (G >= 256 && bid < 256) {
            const int layer = bid >> 7, c = (bid & 127) * 8 + (tid & 7), ks = tid >> 3; const float* gate = ple_gate + (size_t)layer * DM * DM; const float* lg = post_ln_g + layer * DM; const float* lb = post_ln_b + layer * DM;
            float s1 = 0.f, s0 = 0.f;
#pragma unroll
            for (int k = ks * 16; k < ks * 16 + 16; ++k) { const float w = gate[(size_t)k * DM + c]; s1 += bf2f(f2bf(w * lg[k])); s0 += w * lb[k]; }
            float* red = (float*)lds; red[tid * 2] = s1; red[tid * 2 + 1] = s0;
            __syncthreads();
            if (tid < 8) { float t1 = 0.f, t0 = 0.f;
                for (int i = 0; i < 64; ++i) { t1 += red[(i * 8 + tid) * 2]; t0 += red[(i * 8 + tid) * 2 + 1]; }
                GV[layer * 2048 + c] = t1; GV[layer * 2048 + 1024 + c] = t0; }
            __syncthreads();
        } else if (G < 256 && bid < 32) {
            const int layer = bid >> 4, c = (bid & 15) * 64 + (tid & 63), kq = tid >> 6; const float* gate = ple_gate + (size_t)layer * DM * DM; const float* lg = post_ln_g + layer * DM; const float* lb = post_ln_b + layer * DM;
            float s1 = 0.f, s0 = 0.f;
            for (int k = kq * 128; k < kq * 128 + 128; ++k) { const float w = gate[(size_t)k * DM + c]; s1 += bf2f(f2bf(w * lg[k])); s0 += w * lb[k]; }
            float* red = (float*)lds; red[(kq * 64 + (tid & 63)) * 2] = s1; red[(kq * 64 + (tid & 63)) * 2 + 1] = s0;
            __syncthreads();
            if (tid < 64) { float t1 = 0.f, t0 = 0.f;
                for (int i = 0; i < 8; ++i) { t1 += red[(i * 64 + tid) * 2]; t0 += red[(i * 64 + tid) * 2 + 1]; }
                GV[layer * 2048 + c] = t1; GV[layer * 2048 + 1024 + c] = t0; }
            __syncthreads();
        }
        conv_w(ev_w_in, WT_IN0, 1024, EV_IN, EV_IN, 0, nullptr, nullptr, 0.125f * LOG2E, 512, gt, GT);
        conv_w(ev_w_out, WT_OUT0, 1024, 1024, 1024, 0, ev_a_norm, ev_b_norm, 1.f, 0, gt, GT);
        conv_w(ple_gate, WT_GATE0, 1024, 1024, 1024, 0, post_ln_g, nullptr, 1.f, 0, gt, GT);
        conv_w(ple_gate + (size_t)DM * DM, WT_GATE1, 1024, 1024, 1024, 0, post_ln_g + DM, nullptr, 1.f, 0, gt, GT);
        conv_w(ple_proj, WT_PROJ0, 256, 1024, 1024, 0, nullptr, nullptr, 1.f, 0, gt, GT);
        conv_w(ple_proj + 256 * DM, WT_PROJ1, 256, 1024, 1024, 0, nullptr, nullptr, 1.f, 0, gt, GT);
        conv_w(od_w_in, WT_IN1, 1024, OD_IN_SRC, OD_IN, 1, nullptr, nullptr, 1.f, 0, gt, GT);
        conv_w(od_w_uq, WT_UQ, 256, 768, 768, 2, od_q_norm, nullptr, 0.10206207261596577f * LOG2E, 768, gt, GT);
        conv_w(od_w_ukv, WT_UK, 128, 1024, 512, 3, od_kv_norm, nullptr, 1.f, 0, gt, GT);
        conv_w(od_w_ukv, WT_UV, 128, 1024, 512, 4, od_kv_norm, nullptr, 1.f, 0, gt, GT);
        conv_w(od_w_out, WT_OUT1, 1024, 1024, 1024, 0, od_c_norm, od_d_norm, 1.f, 0, gt, GT);
        conv_flat(od_w_s, WSB, (size_t)4 * 128 * 128 / 8, gt, GT);
        conv_flat(x_in, XB, (size_t)M * DM / 8, gt, GT);
        conv_flat(p_in, PB, (size_t)2 * M * 256 / 8, gt, GT);
        for (int i = gt; i < M * 16; i += GT) { const int row = i >> 4, j = i & 15; const float inv = exp2f(-(float)j * (13.287712379549449f / 16.f));
            double rev = (double)pos[row] * (double)inv * 0.15915494309189535; rev -= rint(rev); const float rf = (float)rev;
            CS[i] = (f32x2){__builtin_amdgcn_cosf(rf), __builtin_amdgcn_sinf(rf)}; }
    }
    if (a.ws == nullptr) grid.sync();
    SEAM();
    PH(1) { PHASE_VARS
        pg8::StaticOrder S; S.init(M, EV_IN, G, bid); pg8::Gemm g{XB, WT_IN0, M, EV_IN, 1024, 1024, 1024}; EpiStore E{H0, EV_IN, 1000};
        pg8::gemm_phase(wsg, lds3, g, S, E);
        pg8::StaticOrder S2; if (G == 256) S2.init(M, 1024, 128, bid - 128); else S2.init(M, 1024, G, bid);
        pg8::Gemm g2{PB, WT_PROJ0, M, 1024, 256, 256, 256}; EpiStore E2{PP, 1024, 1000};
        if (G != 256 || bid >= 128) pg8::gemm_phase(wsg, lds3, g2, S2, E2);
    }
    SEAM();
    PH(2) { PHASE_VARS for (int it = bid; it < 512; it += G) even_item(wsg, lds, H0, pos, ev_sink, ev_conv_w, XB, it >> 6, (it & 63) * 64); }
    SEAM();
    PH(3) { PHASE_VARS
        pg8::StaticOrder S; S.init(M, 1024, G, bid); pg8::Gemm g{XB, WT_OUT0, M, 1024, 1024, 1024, 1024}; EpiOut<false, false> E{x_in, UB, PART, nullptr};
        pg8::gemm_phase(wsg, lds3, g, S, E);
    }
    SEAM();
#define GATE_PHASE(WTG, LAYER, OUTF, XBOUT) do { \
        pg8::StaticOrder S; S.init(M, 1024, G, bid); \
        { int tq_ = tid_from(wsg); asm volatile("" : "+v"(tq_)); pg8::Unit u_; for (int i_ = tq_ >> 8; i_ < MR_UMAX && S.next(i_, u_); i_ += 2) { const int row_ = u_.pm * 256 + (tq_ & 255); const f32x4* pp_ = (const f32x4*)(PART + (size_t)row_ * 16); float s_ = 0.f, q_ = 0.f; \
              _Pragma("unroll") for (int j_ = 0; j_ < 8; ++j_) { const f32x4 v_ = pp_[j_]; s_ += v_[0] + v_[2]; q_ += v_[1] + v_[3]; } \
              const float mean_ = s_ * (1.f / 1024.f), var_ = q_ * (1.f / 1024.f) - mean_ * mean_; MRBLK[((size_t)bid * MR_UMAX + i_) * 256 + (tq_ & 255)] = (f32x2){mean_, rsqrtf(fmaxf(var_, 0.f) + EPS)}; } } \
        __threadfence_block(); __syncthreads(); \
        pg8::Gemm g{UB, WTG, M, 1024, 1024, 1024, 1024}; \
        EpiGate E{UB, MRBLK + (size_t)bid * MR_UMAX * 256, post_ln_g + (LAYER) * DM, post_ln_b + (LAYER) * DM, GV + (LAYER) * 2048, GV + (LAYER) * 2048 + 1024, PP, OUTF, XBOUT}; \
        pg8::gemm_phase(wsg, lds3, g, S, E); } while (0)
    PH(4) { PHASE_VARS GATE_PHASE(WT_GATE0, 0, (float*)nullptr, XB); }
    SEAM();
    PH(5) { PHASE_VARS
        pg8::StaticOrder S; S.init(M, OD_IN, G, bid); pg8::Gemm g{XB, WT_IN1, M, OD_IN, 1024, 1024, 1024}; EpiH1 E{H1, STATQ, STATKV, STATV, CS, KB};
        pg8::gemm_phase(wsg, lds3, g, S, E);
    }
    SEAM();
    PH(6) { PHASE_VARS
#ifndef P6MASK
#define P6MASK 15
#endif
        if constexpr (P6MASK & 1) { pg8::StaticOrder S; S.init(M, 768, G, bid); pg8::Gemm g{H1, WT_UQ, M, 768, 256, OD_IN, 256}; EpiQ E{STATQ, CS, QB}; pg8::gemm_phase(wsg, lds3, g, S, E); }
        if constexpr (P6MASK & 2) { pg8::StaticOrder S; S.init(M, 512, G, bid); pg8::Gemm g{H1 + 256, WT_UK, M, 512, 128, OD_IN, 128}; EpiK E{STATKV, KB}; pg8::gemm_phase(wsg, lds3, g, S, E); }
        if constexpr (P6MASK & 4) { pg8::StaticOrder S; S.init(512, M, G, bid); pg8::Gemm g{WT_UV, H1 + 256, 512, M, 128, 128, OD_IN}; EpiVT E{STATKV, VT}; pg8::gemm_phase(wsg, lds3, g, S, E); }
        if constexpr (P6MASK & 8) for (int it = bid; it < 256; it += G) gmlp_item(wsg, lds, H1, STATV, od_v_ln_g, od_v_ln_b, WSB, od_b_s, Y1B, it);
    }
    SEAM();
    PH(7) { PHASE_VARS for (int it = bid; it < 512; it += G) { const int xcd = it & 7, idx = it >> 3; mla_unit(wsg, lds, QB, KB, VT, H1, Y1B, SSQC, xcd * 8 + (idx >> 3), idx & 7); } }
    SEAM();
    PH(8) { PHASE_VARS
        pg8::StaticOrder S; S.init(M, 1024, G, bid); pg8::Gemm g{Y1B, WT_OUT1, M, 1024, 1024, 1024, 1024}; EpiOut<true, true> E{XB, UB, PART, SSQC};
        pg8::gemm_phase(wsg, lds3, g, S, E);
        pg8::StaticOrder S2; S2.init(M, 1024, G, bid); pg8::Gemm g2{PB + (size_t)M * 256, WT_PROJ1, M, 1024, 256, 256, 256}; EpiStore E2{PP, 1024, 1000};
        pg8::gemm_phase(wsg, lds3, g2, S2, E2);
    }
    SEAM();
    PH(9) { PHASE_VARS GATE_PHASE(WT_GATE1, 1, a.out, (bf16_t*)nullptr); }
}

extern "C" void kernel_launch(void* const* d_in, const int* in_sizes, int n_in, void* d_out, int out_size, void* d_ws, size_t ws_size, hipStream_t stream) {
    static int grid = 0;
    if (grid == 0) {
        if (n_in != 25 || out_size != M * DM || ws_size < WS_END) { fprintf(stderr, "kernel_launch: unexpected problem (n_in %d out %d ws %zu)\n", n_in, out_size, ws_size); grid = -1; return; }
        int dev = 0, cus = 0, per_cu = 0;
        (void)hipGetDevice(&dev);
        (void)hipDeviceGetAttribute(&cus, hipDeviceAttributeMultiprocessorCount, dev);
        (void)hipFuncSetAttribute((const void*)mega, hipFuncAttributeMaxDynamicSharedMemorySize, LDS_BYTES);
        (void)hipOccupancyMaxActiveBlocksPerMultiprocessor(&per_cu, (const void*)mega, 512, LDS_BYTES);
        if (per_cu < 1) { fprintf(stderr, "kernel_launch: occupancy query reports %d blocks per CU\n", per_cu); }
        grid = cus;
    }
    if (grid < 0) return;
    Args a{};
    for (int i = 0; i < 25; ++i) a.in[i] = d_in[i];
    a.out = (float*)d_out; a.ws = (unsigned char*)d_ws;
    (void)hipMemsetAsync((unsigned char*)d_ws + WS_BAR, 0, XCD_BAR_WORDS * 4, stream);
    void* args[] = {&a};
    hipError_t e = hipLaunchCooperativeKernel((const void*)mega, dim3(grid), dim3(512), args, LDS_BYTES, stream);
    if (e != hipSuccess) fprintf(stderr, "cooperative launch failed: %s (grid %d)\n", hipGetErrorString(e), grid);
}
```

```cpp
#include <hip/hip_runtime.h>
#include <hip/hip_cooperative_groups.h>
#include <cstdio>
#include <cstdint>
namespace cg = cooperative_groups;

#define LAS __attribute__((address_space(3)))
typedef unsigned short bf16_t;
typedef short bf16x8 __attribute__((ext_vector_type(8)));
typedef float f32x4 __attribute__((ext_vector_type(4)));
typedef float f32x2 __attribute__((ext_vector_type(2)));
typedef float f32x16 __attribute__((ext_vector_type(16)));
typedef unsigned u32x4 __attribute__((ext_vector_type(4)));
typedef unsigned u32x2 __attribute__((ext_vector_type(2)));

constexpr int BATCH = 8, SEQ = 4096, DM = 1024, M = BATCH * SEQ;
constexpr int EV_IN = 3328, OD_IN_SRC = 2464, OD_IN = 2560;
constexpr float EPS = 1e-6f, LOG2E = 1.4426950408889634f;
constexpr float DN_ALPHA = 1.4142135623730951f;
constexpr size_t MiB = 1u << 20;
constexpr size_t WS_WT_IN0 = 0, WS_WT_OUT0 = 7 * MiB, WS_WT_GATE0 = 9 * MiB, WS_WT_GATE1 = 11 * MiB, WS_WT_PROJ0 = 13 * MiB, WS_WT_PROJ1 = 13 * MiB + 512 * 1024,
                 WS_WT_IN1 = 14 * MiB, WS_WT_UQ = 19 * MiB, WS_WT_UK = 19 * MiB + 512 * 1024, WS_WT_UV = 19 * MiB + 768 * 1024, WS_WT_OUT1 = 20 * MiB,
                 WS_WSB = 22 * MiB, WS_GV = 22 * MiB + 512 * 1024, WS_CS = 23 * MiB, WS_PART = 27 * MiB, WS_STATQ = 31 * MiB, WS_STATKV = 31 * MiB + 512 * 1024,
                 WS_STATV = 32 * MiB, WS_SSQC = 34 * MiB, WS_MRBLK = 35 * MiB, WS_BAR = 39 * MiB,
                 WS_XB = 40 * MiB, WS_PB = 104 * MiB, WS_PP = 136 * MiB, WS_HR = 200 * MiB, WS_KV = 408 * MiB, WS_END = 488 * MiB;
constexpr int MR_UMAX = 8;

__device__ __forceinline__ unsigned cvt_pk_bf16(float lo, float hi) { unsigned r; asm volatile("v_cvt_pk_bf16_f32 %0, %1, %2" : "=v"(r) : "v"(lo), "v"(hi)); return r; }
__device__ __forceinline__ float bflo(unsigned w) { return __uint_as_float(w << 16); }
__device__ __forceinline__ float bfhi(unsigned w) { return __uint_as_float(w & 0xffff0000u); }
__device__ __forceinline__ float bf2f(bf16_t v) { return __uint_as_float((unsigned)v << 16); }
__device__ __forceinline__ bf16_t f2bf(float f) { return (bf16_t)(cvt_pk_bf16(f, 0.f) & 0xffffu); }
__device__ __forceinline__ float sigm(float x) { return __builtin_amdgcn_rcpf(1.f + __expf(-x)); }
__device__ __forceinline__ float siluf(float x) { return x * sigm(x); }
__device__ __forceinline__ float geluf(float x) { return x * sigm(1.5957691216057308f * (x + 0.044715f * x * x * x)); }
__device__ __forceinline__ u32x4 pack8(const f32x4 a, const f32x4 b) { u32x4 w; w.x = cvt_pk_bf16(a[0], a[1]); w.y = cvt_pk_bf16(a[2], a[3]); w.z = cvt_pk_bf16(b[0], b[1]); w.w = cvt_pk_bf16(b[2], b[3]); return w; }

template <int X> __device__ __forceinline__ float swz_xor(float v) { return __int_as_float(__builtin_amdgcn_ds_swizzle(__float_as_int(v), (X << 10) | 0x1f)); }
__device__ __forceinline__ float xor32_add(float v) { auto rr = __builtin_amdgcn_permlane32_swap(__float_as_uint(v), __float_as_uint(v), false, false); return __uint_as_float(rr[0]) + __uint_as_float(rr[1]); }
__device__ __forceinline__ float xor32_max(float v) { auto rr = __builtin_amdgcn_permlane32_swap(__float_as_uint(v), __float_as_uint(v), false, false); return fmaxf(__uint_as_float(rr[0]), __uint_as_float(rr[1])); }
__device__ __forceinline__ int lane_id_v() { int l; asm volatile("v_mbcnt_lo_u32_b32 %0, -1, 0\n\tv_mbcnt_hi_u32_b32 %0, -1, %0" : "=v"(l)); return l; }
__device__ __forceinline__ int tid_from(int wsg) { int l; asm volatile("v_mbcnt_lo_u32_b32 %0, -1, 0\n\tv_mbcnt_hi_u32_b32 %0, -1, %0" : "=v"(l)); return (wsg << 6) | l; }
__device__ __forceinline__ void swap32(unsigned& a, unsigned& b) { auto r = __builtin_amdgcn_permlane32_swap(a, b, false, false); a = r[0]; b = r[1]; }
namespace pg8 {
constexpr int BM = 256, BK = 64, HALF = 128, HTB = HALF * BK * 2, STAGE_BYTES = 8 * HTB, NXCD = 8, WGM = 8;
__host__ __device__ __forceinline__ int lds_byte(int r, int c) { const int st = (r >> 4) * 2 + (c >> 5), rr = r & 15, cc = c & 31, ob = rr * 64 + cc * 2; return st * 1024 + (ob ^ (((ob >> 9) & 1) << 5)); }
__host__ __device__ __forceinline__ void stage_rc(int b, int& R, int& C) { const int st = b / 1024, sb = b % 1024, swz = sb ^ (((sb >> 9) & 1) << 5); R = (st >> 1) * 16 + swz / 64; C = (st & 1) * 32 + (swz % 64) / 2; }
__host__ __device__ __forceinline__ int perm32(int rho) { const int n = rho >> 4, i = rho & 15; return 8 * (i >> 2) + 4 * n + (i & 3); }
struct Unit { int pm, pn, idx; };
struct Gemm { const bf16_t* A; const bf16_t* Bt; int M, N, K, lda, ldb; };
struct StaticOrder {
    int nM, nN, nwg, G, c;
    __device__ __forceinline__ void init(int M_, int N_, int G_, int c_) { nM = M_ / BM; nN = N_ / BM; nwg = nM * nN; G = G_; c = c_; }
    __device__ __forceinline__ bool next(int i, Unit& u) const {
        const long L = (long)i * G + c; if (L >= nwg) return false;
        int wgid = (int)L; { const int q = nwg / NXCD, r = nwg % NXCD, xcd = wgid % NXCD, off = wgid / NXCD; wgid = (xcd < r ? xcd * (q + 1) : r * (q + 1) + (xcd - r) * q) + off; }
        const int nig = WGM * nN, gid = wgid / nig, fm = gid * WGM, gsz = (nM - fm) < WGM ? (nM - fm) : WGM;
        u.pm = fm + ((wgid % nig) % gsz); u.pn = (wgid % nig) / gsz; u.idx = i; return true;
    }
};
template <class Epi, class Sched>
__device__ __forceinline__ void gemm_phase(int wsg, LAS unsigned char* lds, const Gemm g, const Sched& S, const Epi& E) {
    int tid_ = tid_from(wsg); asm volatile("" : "+v"(tid_));
    const int tid = tid_, wid = __builtin_amdgcn_readfirstlane(tid >> 6), lane = tid & 63, wr = wid >> 2, wc = wid & 3, fr = lane & 15, fq = lane >> 4;
    const int K = g.K, nt = K / BK;
    unsigned voffA[2], voffB[2];
#pragma unroll
    for (int i = 0; i < 2; ++i) { int R, C; stage_rc(tid * 16 + i * 8192, R, C); const int Rb = (R & ~31) + perm32(R & 31);
        voffA[i] = (unsigned)(R * g.lda + C) * 2u; voffB[i] = (unsigned)(Rb * g.ldb + C) * 2u; }
    const size_t kstep = (size_t)(BK * 2);
    const size_t hstepA = (size_t)HALF * g.lda * 2, hstepB = (size_t)HALF * g.ldb * 2;
    const size_t tstepA = 2 * hstepA, tstepB = 2 * hstepB;
    const unsigned ldsw = (unsigned)wid * 1024u;
    const int aoff = lds_byte(wr * 64 + fr, fq * 8), boff = lds_byte(wc * 32 + fr, fq * 8);
#define PG8_SA(b, h) (((b) * 2 + (h)) * HTB)
#define PG8_SB(b, h) ((4 + (b) * 2 + (h)) * HTB)
#define PG8_STAGE(bufoff, gbase, voff) do { _Pragma("unroll") for (int _i = 0; _i < 2; ++_i) \
        __builtin_amdgcn_global_load_lds((const unsigned*)((const char*)(gbase) + (voff)[_i]), (LAS unsigned*)(lds + (bufoff) + ldsw + _i * 8192), 16, 0, 0); } while (0)
#define PG8_LDA(dst, b, h) do { _Pragma("unroll") for (int m = 0; m < 4; ++m) _Pragma("unroll") for (int k = 0; k < 2; ++k) dst[m][k] = *(const LAS bf16x8*)(lds + PG8_SA(b, h) + aoff + m * 2048 + k * 1024); } while (0)
#define PG8_LDB(dst, b, h) do { _Pragma("unroll") for (int n = 0; n < 2; ++n) _Pragma("unroll") for (int k = 0; k < 2; ++k) dst[n][k] = *(const LAS bf16x8*)(lds + PG8_SB(b, h) + boff + n * 2048 + k * 1024); } while (0)
#define PG8_MMA(ai, bj, At, Bt) do { __builtin_amdgcn_s_setprio(1); _Pragma("unroll") for (int m = 0; m < 4; ++m) _Pragma("unroll") for (int n = 0; n < 2; ++n) _Pragma("unroll") for (int k = 0; k < 2; ++k) \
        acc[ai][bj][m][n] = __builtin_amdgcn_mfma_f32_16x16x32_bf16(Bt[n][k], At[m][k], acc[ai][bj][m][n], 0, 0, 0); __builtin_amdgcn_s_setprio(0); } while (0)
#define PG8_WAIT_V(n) asm volatile("s_waitcnt vmcnt(" #n ")" ::: "memory")
#define PG8_WAIT_L(n) asm volatile("s_waitcnt lgkmcnt(" #n ")" ::: "memory")
#define PG8_BAR __builtin_amdgcn_s_barrier()
#define PG8_SCHED __builtin_amdgcn_sched_barrier(0)
    Unit cur, nxt; int ui = 0;
    if (!S.next(0, cur)) return;
    f32x4 acc[2][2][4][2];
#pragma unroll
    for (int a = 0; a < 2; ++a)
#pragma unroll
        for (int b = 0; b < 2; ++b)
#pragma unroll
            for (int m = 0; m < 4; ++m)
#pragma unroll
                for (int n = 0; n < 2; ++n) acc[a][b][m][n] = (f32x4){0.f, 0.f, 0.f, 0.f};
    bf16x8 At[4][2], B0[2][2], B1[2][2];
    const char* cA = (const char*)g.A + (size_t)cur.pm * tstepA; const char* cB = (const char*)g.Bt + (size_t)cur.pn * tstepB;
    PG8_STAGE(PG8_SB(0, 0), cB, voffB); PG8_STAGE(PG8_SB(0, 1), cB + hstepB, voffB); PG8_STAGE(PG8_SA(0, 0), cA, voffA); PG8_STAGE(PG8_SA(0, 1), cA + hstepA, voffA);
    if (wr == 1) PG8_BAR;
    PG8_WAIT_V(2); PG8_BAR;
    PG8_STAGE(PG8_SB(1, 0), cB + kstep, voffB); PG8_STAGE(PG8_SA(1, 0), cA + kstep, voffA); PG8_STAGE(PG8_SB(1, 1), cB + hstepB + kstep, voffB);
    PG8_WAIT_V(6); PG8_BAR;
    for (;;) {
        const bool has_next = S.next(ui + 1, nxt);
        const char* nA = has_next ? (const char*)g.A + (size_t)nxt.pm * tstepA : cA; const char* nB = has_next ? (const char*)g.Bt + (size_t)nxt.pn * tstepB : cB;
        for (int t = 0; t < nt; t += 2) {
            const bool last = (t == nt - 2);
            const char* a1 = cA + (size_t)(t + 1) * kstep;
            const char* a2 = last ? nA : cA + (size_t)(t + 2) * kstep; const char* b2 = last ? nB : cB + (size_t)(t + 2) * kstep;
            const char* a3 = a2 + kstep; const char* b3 = b2 + kstep;
            if constexpr (Epi::MID) { if (t == (nt >> 1)) E.mid(acc, cur, wr, lane_id_v() & 15); }
            PG8_LDB(B0, 0, 0); PG8_LDB(B1, 0, 1); PG8_SCHED; PG8_LDA(At, 0, 0); PG8_STAGE(PG8_SA(1, 1), a1 + hstepA, voffA);
            PG8_WAIT_V(8); PG8_WAIT_L(0); PG8_BAR; PG8_MMA(0, 0, At, B0); PG8_MMA(0, 1, At, B1); PG8_BAR; PG8_SCHED;
            PG8_LDA(At, 0, 1); PG8_STAGE(PG8_SB(0, 0), b2, voffB); PG8_STAGE(PG8_SB(0, 1), b2 + hstepB, voffB); PG8_STAGE(PG8_SA(0, 0), a2, voffA);
            PG8_WAIT_V(8); PG8_WAIT_L(0); PG8_BAR; PG8_MMA(1, 0, At, B0); PG8_MMA(1, 1, At, B1); PG8_BAR; PG8_SCHED;
            PG8_LDB(B0, 1, 0); PG8_LDB(B1, 1, 1); PG8_SCHED; PG8_LDA(At, 1, 0); PG8_STAGE(PG8_SA(0, 1), a2 + hstepA, voffA);
            PG8_WAIT_V(8); PG8_WAIT_L(0); PG8_BAR; PG8_MMA(0, 0, At, B0); PG8_MMA(0, 1, At, B1); PG8_BAR; PG8_SCHED;
            PG8_LDA(At, 1, 1); PG8_STAGE(PG8_SB(1, 0), b3, voffB); PG8_STAGE(PG8_SB(1, 1), b3 + hstepB, voffB); PG8_STAGE(PG8_SA(1, 0), a3, voffA);
            PG8_WAIT_V(8); PG8_WAIT_L(0); PG8_BAR; PG8_MMA(1, 0, At, B0); PG8_MMA(1, 1, At, B1); PG8_BAR; PG8_SCHED;
        }
        if (wr == 0) PG8_BAR;
        { const int l_e = lane_id_v(); E(acc, cur, wr, wc, l_e & 15, l_e >> 4); }
        if (!has_next) break;
#pragma unroll
        for (int a = 0; a < 2; ++a)
#pragma unroll
            for (int b = 0; b < 2; ++b)
#pragma unroll
                for (int m = 0; m < 4; ++m)
#pragma unroll
                    for (int n = 0; n < 2; ++n) acc[a][b][m][n] = (f32x4){0.f, 0.f, 0.f, 0.f};
        cur = nxt; cA = nA; cB = nB; ++ui;
        if (wr == 1) PG8_BAR;
    }
    PG8_WAIT_V(0);
    PG8_BAR;
#undef PG8_SA
#undef PG8_SB
#undef PG8_STAGE
#undef PG8_LDA
#undef PG8_LDB
#undef PG8_MMA
#undef PG8_WAIT_V
#undef PG8_WAIT_L
#undef PG8_BAR
#undef PG8_SCHED
}
}
using pg8::Unit;
typedef f32x4 AccT[2][2][4][2];
#define EPI_ROW(u, ai, m) ((u).pm * 256 + (ai) * 128 + wr * 64 + (m) * 16 + fr)
#define EPI_LCOL(bj) ((bj) * 128 + wc * 32 + 8 * fq)

struct EpiStore {
    static constexpr bool MID = false;
    bf16_t* O; int ldc; int silu_pn;
    __device__ __forceinline__ void operator()(const AccT& acc, const Unit& u, int wr, int wc, int fr, int fq) const {
        const bool act = u.pn >= silu_pn;
#pragma unroll
        for (int ai = 0; ai < 2; ++ai)
#pragma unroll
            for (int m = 0; m < 4; ++m) { bf16_t* rowp = O + (size_t)EPI_ROW(u, ai, m) * ldc + u.pn * 256;
#pragma unroll
                for (int bj = 0; bj < 2; ++bj) { f32x4 v0 = acc[ai][bj][m][0], v1 = acc[ai][bj][m][1];
                    if (act) {
#pragma unroll
                        for (int e = 0; e < 4; ++e) { v0[e] = siluf(v0[e]); v1[e] = siluf(v1[e]); } }
                    *(u32x4*)(rowp + EPI_LCOL(bj)) = pack8(v0, v1); }
                asm volatile("" ::: "memory"); }
    }
};
template <bool MIDSCALE, bool RESBF> struct EpiOut {
    static constexpr bool MID = MIDSCALE;
    const void* res; bf16_t* Ub; f32x2* part; const float* ssqC;
    __device__ __forceinline__ void mid(AccT& acc, const Unit& u, int wr, int fr) const {
#pragma unroll
        for (int ai = 0; ai < 2; ++ai)
#pragma unroll
            for (int m = 0; m < 4; ++m) { const int row = EPI_ROW(u, ai, m); const f32x4 a = *(const f32x4*)(ssqC + (size_t)row * 8), b = *(const f32x4*)(ssqC + (size_t)row * 8 + 4);
                const float s = ((a[0] + a[1]) + (a[2] + a[3])) + ((b[0] + b[1]) + (b[2] + b[3])); const float rc = rsqrtf(s * (1.f / 512.f) + EPS);
#pragma unroll
                for (int bj = 0; bj < 2; ++bj)
#pragma unroll
                    for (int n = 0; n < 2; ++n) acc[ai][bj][m][n] *= rc; }
    }
    __device__ __forceinline__ void operator()(const AccT& acc, const Unit& u, int wr, int wc, int fr, int fq) const {
#pragma unroll
        for (int ai = 0; ai < 2; ++ai)
#pragma unroll
            for (int m = 0; m < 4; ++m) { const int row = EPI_ROW(u, ai, m); const size_t off = (size_t)row * DM + u.pn * 256; float s = 0.f, q = 0.f;
#pragma unroll
                for (int bj = 0; bj < 2; ++bj) { const size_t o = off + EPI_LCOL(bj); f32x4 r0, r1;
                    if constexpr (RESBF) { const u32x4 rw = *(const u32x4*)((const bf16_t*)res + o); r0 = (f32x4){bflo(rw.x), bfhi(rw.x), bflo(rw.y), bfhi(rw.y)}; r1 = (f32x4){bflo(rw.z), bfhi(rw.z), bflo(rw.w), bfhi(rw.w)}; }
                    else { r0 = *(const f32x4*)((const float*)res + o); r1 = *(const f32x4*)((const float*)res + o + 4); }
                    const f32x4 u0 = r0 * DN_ALPHA + acc[ai][bj][m][0], u1 = r1 * DN_ALPHA + acc[ai][bj][m][1];
                    *(u32x4*)(Ub + o) = pack8(u0, u1);
                    s += ((u0[0] + u0[1]) + (u0[2] + u0[3])) + ((u1[0] + u1[1]) + (u1[2] + u1[3]));
                    q += ((u0[0] * u0[0] + u0[1] * u0[1]) + (u0[2] * u0[2] + u0[3] * u0[3])) + ((u1[0] * u1[0] + u1[1] * u1[1]) + (u1[2] * u1[2] + u1[3] * u1[3])); }
                s += swz_xor<16>(s); s = xor32_add(s); q += swz_xor<16>(q); q = xor32_add(q);
                if (fq == 0) part[(size_t)row * 16 + u.pn * 4 + wc] = (f32x2){s, q};
                asm volatile("" ::: "memory"); }
    }
};
struct EpiGate {
    static constexpr bool MID = false;
    const bf16_t* Ub; const f32x2* mr; const float* lng; const float* lnb; const float* G1; const float* G0; const bf16_t* pp; float* out; bf16_t* xb;
    __device__ __forceinline__ void operator()(const AccT& acc, const Unit& u, int wr, int wc, int fr, int fq) const {
#pragma unroll
        for (int bj = 0; bj < 2; ++bj) { const int col = u.pn * 256 + EPI_LCOL(bj);
            f32x4 g[2], b[2], g1[2], g0[2];
#pragma unroll
            for (int n = 0; n < 2; ++n) { g[n] = *(const f32x4*)(lng + col + 4 * n); b[n] = *(const f32x4*)(lnb + col + 4 * n); g1[n] = *(const f32x4*)(G1 + col + 4 * n); g0[n] = *(const f32x4*)(G0 + col + 4 * n); }
#pragma unroll
            for (int ai = 0; ai < 2; ++ai)
#pragma unroll
                for (int m = 0; m < 4; ++m) { const int rl = ai * 128 + wr * 64 + m * 16 + fr; const f32x2 st = mr[u.idx * 256 + rl]; const size_t o = (size_t)(u.pm * 256 + rl) * DM + col;
                    const u32x4 pw = *(const u32x4*)(pp + o), uw = *(const u32x4*)(Ub + o); f32x4 ov[2];
                    const float ppv[8] = {bflo(pw.x), bfhi(pw.x), bflo(pw.y), bfhi(pw.y), bflo(pw.z), bfhi(pw.z), bflo(pw.w), bfhi(pw.w)};
                    const float uv[8] = {bflo(uw.x), bfhi(uw.x), bflo(uw.y), bfhi(uw.y), bflo(uw.z), bfhi(uw.z), bflo(uw.w), bfhi(uw.w)};
#pragma unroll
                    for (int n = 0; n < 2; ++n) {
#pragma unroll
                        for (int e = 0; e < 4; ++e) { const float h = (uv[4 * n + e] - st.x) * st.y * g[n][e] + b[n][e]; const float t = st.y * (acc[ai][bj][m][n][e] - st.x * g1[n][e]) + g0[n][e];
                            ov[n][e] = h + sigm(t) * ppv[4 * n + e]; } }
                    if (out) { __builtin_nontemporal_store(ov[0], (f32x4*)(out + o)); __builtin_nontemporal_store(ov[1], (f32x4*)(out + o + 4)); }
                    if (xb) *(u32x4*)(xb + o) = pack8(ov[0], ov[1]);
                    asm volatile("" ::: "memory"); } }
    }
};
struct EpiH1 {
    static constexpr bool MID = false;
    bf16_t* H1; float* statQ; float* statKV; f32x2* statV; const f32x2* cs; bf16_t* Kb;
    __device__ __forceinline__ void operator()(const AccT& acc, const Unit& u, int wr, int wc, int fr, int fq) const {
        const int pn = u.pn;
#pragma unroll
        for (int ai = 0; ai < 2; ++ai)
#pragma unroll
            for (int m = 0; m < 4; ++m) { const int row = EPI_ROW(u, ai, m); bf16_t* rowp = H1 + (size_t)row * OD_IN + pn * 256;
                if (pn == 0) { float q = 0.f;
#pragma unroll
                    for (int bj = 0; bj < 2; ++bj) { const f32x4 v0 = acc[ai][bj][m][0], v1 = acc[ai][bj][m][1]; *(u32x4*)(rowp + EPI_LCOL(bj)) = pack8(v0, v1);
                        q += ((v0[0] * v0[0] + v0[1] * v0[1]) + (v0[2] * v0[2] + v0[3] * v0[3])) + ((v1[0] * v1[0] + v1[1] * v1[1]) + (v1[2] * v1[2] + v1[3] * v1[3])); }
                    q += swz_xor<16>(q); q = xor32_add(q); if (fq == 0) statQ[(size_t)row * 4 + wc] = q;
                } else if (pn == 1) {
                    { const f32x4 v0 = acc[ai][0][m][0], v1 = acc[ai][0][m][1]; *(u32x4*)(rowp + EPI_LCOL(0)) = pack8(v0, v1);
                      float q = ((v0[0] * v0[0] + v0[1] * v0[1]) + (v0[2] * v0[2] + v0[3] * v0[3])) + ((v1[0] * v1[0] + v1[1] * v1[1]) + (v1[2] * v1[2] + v1[3] * v1[3]));
                      q += swz_xor<16>(q); q = xor32_add(q); if (fq == 0) statKV[(size_t)row * 4 + wc] = q; }
                    if (wc == 0) { const f32x4 v0 = acc[ai][1][m][0], v1 = acc[ai][1][m][1]; const float x[8] = {v0[0], v0[1], v0[2], v0[3], v1[0], v1[1], v1[2], v1[3]};
                        const f32x4 c01 = *(const f32x4*)(cs + (size_t)row * 16 + 4 * fq), c23 = *(const f32x4*)(cs + (size_t)row * 16 + 4 * fq + 2);
                        const float cc[4] = {c01[0], c01[2], c23[0], c23[2]}, ss[4] = {c01[1], c01[3], c23[1], c23[3]}; float o[8];
#pragma unroll
                        for (int e = 0; e < 4; ++e) { o[2 * e] = x[2 * e] * cc[e] - x[2 * e + 1] * ss[e]; o[2 * e + 1] = x[2 * e] * ss[e] + x[2 * e + 1] * cc[e]; }
                        u32x4 w; w.x = cvt_pk_bf16(o[0], o[1]); w.y = cvt_pk_bf16(o[2], o[3]); w.z = cvt_pk_bf16(o[4], o[5]); w.w = cvt_pk_bf16(o[6], o[7]);
                        const int b = row >> 12, s = row & 4095;
#pragma unroll
                        for (int h = 0; h < 8; ++h) *(u32x4*)(Kb + ((size_t)(b * 8 + h) * SEQ + s) * 96 + 64 + 8 * fq) = w; }
                } else if (pn < 6) { float s = 0.f, q = 0.f;
#pragma unroll
                    for (int bj = 0; bj < 2; ++bj) { f32x4 v0 = acc[ai][bj][m][0], v1 = acc[ai][bj][m][1];
#pragma unroll
                        for (int e = 0; e < 4; ++e) { v0[e] = geluf(v0[e]); v1[e] = geluf(v1[e]); }
                        *(u32x4*)(rowp + EPI_LCOL(bj)) = pack8(v0, v1);
                        s += ((v0[0] + v0[1]) + (v0[2] + v0[3])) + ((v1[0] + v1[1]) + (v1[2] + v1[3]));
                        q += ((v0[0] * v0[0] + v0[1] * v0[1]) + (v0[2] * v0[2] + v0[3] * v0[3])) + ((v1[0] * v1[0] + v1[1] * v1[1]) + (v1[2] * v1[2] + v1[3] * v1[3])); }
                    if (pn >= 4) { s += swz_xor<16>(s); s = xor32_add(s); q += swz_xor<16>(q); q = xor32_add(q);
                        if (fq == 0) statV[(size_t)row * 8 + (pn - 4) * 4 + wc] = (f32x2){s, q}; }
                } else {
#pragma unroll
                    for (int bj = 0; bj < 2; ++bj) *(u32x4*)(rowp + EPI_LCOL(bj)) = pack8(acc[ai][bj][m][0], acc[ai][bj][m][1]); }
                asm volatile("" ::: "memory"); }
    }
};
struct EpiQ {
    static constexpr bool MID = false;
    const float* statQ; const f32x2* cs; bf16_t* Qb;
    __device__ __forceinline__ void operator()(const AccT& acc, const Unit& u, int wr, int wc, int fr, int fq) const {
#pragma unroll
        for (int ai = 0; ai < 2; ++ai)
#pragma unroll
            for (int m = 0; m < 4; ++m) { const int row = EPI_ROW(u, ai, m); const f32x4 sq = *(const f32x4*)(statQ + (size_t)row * 4);
                const float rq = rsqrtf(((sq[0] + sq[1]) + (sq[2] + sq[3])) * (1.f / 256.f) + EPS); const int b = row >> 12, s = row & 4095;
#pragma unroll
                for (int bj = 0; bj < 2; ++bj) { const int col = u.pn * 256 + EPI_LCOL(bj), h = col / 96, j = col - h * 96;
                    const f32x4 v0 = acc[ai][bj][m][0] * rq, v1 = acc[ai][bj][m][1] * rq; u32x4 w;
                    if (j >= 64) { const int i0 = (j - 64) >> 1; const float x[8] = {v0[0], v0[1], v0[2], v0[3], v1[0], v1[1], v1[2], v1[3]};
                        const f32x4 c01 = *(const f32x4*)(cs + (size_t)row * 16 + i0), c23 = *(const f32x4*)(cs + (size_t)row * 16 + i0 + 2);
                        const float cc[4] = {c01[0], c01[2], c23[0], c23[2]}, ss[4] = {c01[1], c01[3], c23[1], c23[3]}; float o[8];
#pragma unroll
                        for (int e = 0; e < 4; ++e) { o[2 * e] = x[2 * e] * cc[e] - x[2 * e + 1] * ss[e]; o[2 * e + 1] = x[2 * e] * ss[e] + x[2 * e + 1] * cc[e]; }
                        w.x = cvt_pk_bf16(o[0], o[1]); w.y = cvt_pk_bf16(o[2], o[3]); w.z = cvt_pk_bf16(o[4], o[5]); w.w = cvt_pk_bf16(o[6], o[7]);
                    } else w = pack8(v0, v1);
                    *(u32x4*)(Qb + ((size_t)(b * 8 + h) * SEQ + s) * 96 + j) = w; }
                asm volatile("" ::: "memory"); }
    }
};
struct EpiK {
    static constexpr bool MID = false;
    const float* statKV; bf16_t* Kb;
    __device__ __forceinline__ void operator()(const AccT& acc, const Unit& u, int wr, int wc, int fr, int fq) const {
#pragma unroll
        for (int ai = 0; ai < 2; ++ai)
#pragma unroll
            for (int m = 0; m < 4; ++m) { const int row = EPI_ROW(u, ai, m); const f32x4 sq = *(const f32x4*)(statKV + (size_t)row * 4);
                const float rk = rsqrtf(((sq[0] + sq[1]) + (sq[2] + sq[3])) * (1.f / 128.f) + EPS); const int b = row >> 12, s = row & 4095;
#pragma unroll
                for (int bj = 0; bj < 2; ++bj) { const int col = u.pn * 256 + EPI_LCOL(bj), h = col >> 6, j = col & 63;
                    *(u32x4*)(Kb + ((size_t)(b * 8 + h) * SEQ + s) * 96 + j) = pack8(acc[ai][bj][m][0] * rk, acc[ai][bj][m][1] * rk); }
                asm volatile("" ::: "memory"); }
    }
};
struct EpiVT {
    static constexpr bool MID = false;
    const float* statKV; bf16_t* Vt;
    __device__ __forceinline__ void operator()(const AccT& acc, const Unit& u, int wr, int wc, int fr, int fq) const {
#pragma unroll
        for (int bj = 0; bj < 2; ++bj) { const int tok = u.pn * 256 + EPI_LCOL(bj), b = tok >> 12, s = tok & 4095; float rk[8];
#pragma unroll
            for (int e = 0; e < 8; ++e) { const f32x4 sq = *(const f32x4*)(statKV + (size_t)(tok + e) * 4); rk[e] = rsqrtf(((sq[0] + sq[1]) + (sq[2] + sq[3])) * (1.f / 128.f) + EPS); }
#pragma unroll
            for (int ai = 0; ai < 2; ++ai)
#pragma unroll
                for (int m = 0; m < 4; ++m) { const int hd = EPI_ROW(u, ai, m); f32x4 v0 = acc[ai][bj][m][0], v1 = acc[ai][bj][m][1];
#pragma unroll
                    for (int e = 0; e < 4; ++e) { v0[e] *= rk[e]; v1[e] *= rk[4 + e]; }
                    *(u32x4*)(Vt + ((size_t)b * 512 + hd) * SEQ + s) = pack8(v0, v1);
                    asm volatile("" ::: "memory"); } }
    }
};

__device__ __forceinline__ int colmap(int map, int n) {
    switch (map) {
    case 1: { if (n < 384) return n; if (n < 416) { const int j = n - 384, i = j >> 1; return 384 + ((j & 1) ? i + 16 : i); } if (n < 512) return -1; if (n < 1024) return 416 + (n - 512); if (n < 1536) return 928 + (n - 1024); return 1440 + (n - 1536); }
    case 2: { const int h = n / 96, j = n - h * 96; if (j < 64) return n; const int jj = j - 64, i = jj >> 1; return h * 96 + 64 + ((jj & 1) ? i + 16 : i); }
    case 3: return (n >> 6) * 128 + (n & 63);
    case 4: return (n >> 6) * 128 + 64 + (n & 63);
    default: return n;
    }
}
__device__ __forceinline__ void conv_w(const float* W, bf16_t* WT, int K, int Nsrc, int Ndst, int map, const float* rs, const float* rs2, float cscale, int cs_upto, int gt, int GT) {
    const int nitem = Ndst * (K >> 3);
    const int nb8 = Ndst >> 3;
    for (int it = gt; it < nitem; it += GT) { const int rest = it >> 6, n = (rest % nb8) * 8 + ((it >> 3) & 7), k0 = ((rest / nb8) * 8 + (it & 7)) * 8; const int src = colmap(map, n); const float cs = (n < cs_upto) ? cscale : 1.f; const int srcc = src < 0 ? 0 : src; const float csz = src < 0 ? 0.f : cs; float v[8];
#pragma unroll
        for (int e = 0; e < 8; ++e) { const int k = k0 + e; const float w = W[(size_t)k * Nsrc + srcc]; v[e] = w * csz; }
        if (rs) { const float* rp = (rs2 && k0 >= 512) ? (rs2 + (k0 - 512)) : (rs + k0); const f32x4 ra = *(const f32x4*)rp, rb4 = *(const f32x4*)(rp + 4);
#pragma unroll
            for (int e = 0; e < 4; ++e) { v[e] *= ra[e]; v[4 + e] *= rb4[e]; } }
        u32x4 o; o.x = cvt_pk_bf16(v[0], v[1]); o.y = cvt_pk_bf16(v[2], v[3]); o.z = cvt_pk_bf16(v[4], v[5]); o.w = cvt_pk_bf16(v[6], v[7]);
        *(u32x4*)(WT + (size_t)n * K + k0) = o; }
}
__device__ __forceinline__ void conv_flat(const float* src, bf16_t* dst, size_t n8, int gt, int GT) {
    size_t i = gt;
    for (; i + 3 * (size_t)GT < n8; i += 4 * (size_t)GT) { f32x4 a[4], b[4];
#pragma unroll
        for (int j = 0; j < 4; ++j) { a[j] = __builtin_nontemporal_load((const f32x4*)(src + (i + j * (size_t)GT) * 8)); b[j] = __builtin_nontemporal_load((const f32x4*)(src + (i + j * (size_t)GT) * 8 + 4)); }
#pragma unroll
        for (int j = 0; j < 4; ++j) *(u32x4*)(dst + (i + j * (size_t)GT) * 8) = pack8(a[j], b[j]); }
    for (; i < n8; i += GT) { const f32x4 a = *(const f32x4*)(src + i * 8), b = *(const f32x4*)(src + i * 8 + 4); *(u32x4*)(dst + i * 8) = pack8(a, b); }
}

struct Args { const void* in[25]; float* out; unsigned char* ws; };

__device__ __forceinline__ int kappa(int r) { return (r & ~12) | ((r & 4) << 1) | ((r & 8) >> 1); }
constexpr int EK_ROW = 72, EK_BUF = 64 * EK_ROW * 2, EV_STAGE = 4 * EK_BUF + 256;
__device__ __forceinline__ void even_item(int wsg, unsigned char* lds, const bf16_t* H0, const int* pos, const float* sink, const float* convw, bf16_t* Y0, int b, int q0) {
    int tid_ = tid_from(wsg); asm volatile("" : "+v"(tid_));
    const int tid = tid_, lane = tid & 63, wid = tid >> 6, r32 = lane & 31, hi = lane >> 5;
    const int h = wid, kvh = h >> 2;
    const size_t tb = (size_t)b * SEQ;
    bf16x8 qf[2][4]; float posq[2];
#pragma unroll
    for (int qb = 0; qb < 2; ++qb) { const size_t t = tb + q0 + 32 * qb + r32; posq[qb] = (float)pos[t];
#pragma unroll
        for (int ks = 0; ks < 4; ++ks) qf[qb][ks] = *(const bf16x8*)(H0 + t * EV_IN + h * 64 + 16 * ks + 8 * hi); }
    const float slope2 = exp2f(-(float)(h + 1)) * LOG2E, sink2 = sink[h] * LOG2E;
    f32x16 O[2][2]; float mrun[2], lrun[2];
#pragma unroll
    for (int qb = 0; qb < 2; ++qb) { mrun[qb] = sink2; lrun[qb] = (hi == 0) ? 1.f : 0.f; O[qb][0] = (f32x16){}; O[qb][1] = (f32x16){}; }
    u32x4 gk[2], gv[2]; float gp = 0.f;
#define EV_ISSUE(j_) do { const int kbase_ = q0 - 128 + 64 * (j_); \
        _Pragma("unroll") for (int i = 0; i < 2; ++i) { const int c = tid + i * 512; \
            { const int key = (c >> 3) & 63, ch = c & 7, kg = min(max(kbase_ + key, 0), SEQ - 1); gk[i] = *(const u32x4*)(H0 + (tb + kg) * EV_IN + 512 + i * 64 + ch * 8); } \
            { const int key = c & 63, ch = (c >> 6) & 7, kg = min(max(kbase_ + key, 0), SEQ - 1); gv[i] = *(const u32x4*)(H0 + (tb + kg) * EV_IN + 640 + i * 64 + ch * 8); } } \
        { const int kg = min(max(kbase_ + (tid & 63), 0), SEQ - 1); gp = (float)pos[tb + kg]; } } while (0)
#define EV_COMMIT(p_) do { unsigned char* base_ = lds + (p_) * EV_STAGE; \
        _Pragma("unroll") for (int i = 0; i < 2; ++i) { const int c = tid + i * 512; \
            { const int key = (c >> 3) & 63, ch = c & 7; *(u32x4*)(base_ + i * EK_BUF + (key * EK_ROW + ch * 8) * 2) = gk[i]; } \
            { const int key = c & 63, ch = (c >> 6) & 7; const u32x4 v = gv[i]; bf16_t* vt = (bf16_t*)(base_ + 2 * EK_BUF + i * EK_BUF) + (ch * 8) * EK_ROW + key; \
              vt[0 * EK_ROW] = (bf16_t)(v.x & 0xffffu); vt[1 * EK_ROW] = (bf16_t)(v.x >> 16); vt[2 * EK_ROW] = (bf16_t)(v.y & 0xffffu); vt[3 * EK_ROW] = (bf16_t)(v.y >> 16); \
              vt[4 * EK_ROW] = (bf16_t)(v.z & 0xffffu); vt[5 * EK_ROW] = (bf16_t)(v.z >> 16); vt[6 * EK_ROW] = (bf16_t)(v.w & 0xffffu); vt[7 * EK_ROW] = (bf16_t)(v.w >> 16); } } \
        ((float*)(base_ + 4 * EK_BUF))[tid & 63] = gp; } while (0)
    __syncthreads();
    EV_ISSUE(0); EV_COMMIT(0);
    __syncthreads();
#pragma unroll 1
    for (int j = 0; j < 5; ++j) {
        const int kbase = q0 - 128 + 64 * j; const int pbuf = j & 1;
        if (j + 1 < 5) EV_ISSUE(j + 1);
        const unsigned char* KLp = lds + pbuf * EV_STAGE; const unsigned char* VTp = KLp + 2 * EK_BUF; const float* posK = (const float*)(KLp + 4 * EK_BUF);
        const unsigned char* kb = KLp + kvh * EK_BUF; const unsigned char* vb = VTp + kvh * EK_BUF;
        f32x16 S[2][2];
#pragma unroll
        for (int rb = 0; rb < 2; ++rb) { bf16x8 kf[4];
#pragma unroll
            for (int ks = 0; ks < 4; ++ks) kf[ks] = *(const bf16x8*)(kb + ((kappa(r32) + 32 * rb) * EK_ROW + 16 * ks + 8 * hi) * 2);
#pragma unroll
            for (int qb = 0; qb < 2; ++qb) { f32x16 a = (f32x16){};
#pragma unroll
                for (int ks = 0; ks < 4; ++ks) a = __builtin_amdgcn_mfma_f32_32x32x16_bf16(kf[ks], qf[qb][ks], a, 0, 0, 0);
                S[qb][rb] = a; } }
#pragma unroll
        for (int qb = 0; qb < 2; ++qb) { const int qg = q0 + 32 * qb + r32; float mx = -1e30f;
            const int lo = max(-kbase, qg - 128 - kbase) - 8 * hi; const unsigned span = (unsigned)(min(SEQ - 1 - kbase, qg + 128 - kbase) - 8 * hi - lo);
            const float* pk_ = posK + 8 * hi;
#pragma unroll
            for (int rb = 0; rb < 2; ++rb)
#pragma unroll
                for (int hf = 0; hf < 2; ++hf) {
                    const f32x4 pa = *(const f32x4*)(pk_ + 32 * rb + 16 * hf), pb = *(const f32x4*)(pk_ + 32 * rb + 16 * hf + 4);
                    const float pkv[8] = {pa[0], pa[1], pa[2], pa[3], pb[0], pb[1], pb[2], pb[3]};
#pragma unroll
                    for (int i = 0; i < 8; ++i) { const int r = 8 * hf + i, c = 32 * rb + i + 16 * hf;
                        const float bias = slope2 * fabsf(posq[qb] - pkv[i]); const float sv0 = S[qb][rb][r] - bias;
                        const bool valid = (unsigned)(c - lo) <= span;
                        const float sv = valid ? sv0 : -1e30f; S[qb][rb][r] = sv; mx = fmaxf(mx, sv); }
                    __builtin_amdgcn_sched_barrier(0); }
            mx = xor32_max(mx);
            if (__builtin_expect(__builtin_amdgcn_ballot_w64(mx - mrun[qb] > 8.0f) != 0ull, 0)) { const float mnew_ = fmaxf(mrun[qb], mx), alpha = __builtin_amdgcn_exp2f(mrun[qb] - mnew_); mrun[qb] = mnew_; lrun[qb] *= alpha;
#pragma unroll
                for (int db = 0; db < 2; ++db) O[qb][db] *= alpha; }
            const float mnew = mrun[qb]; float ps = 0.f;
#pragma unroll
            for (int rb = 0; rb < 2; ++rb)
#pragma unroll
                for (int r = 0; r < 16; ++r) { const float p = __builtin_amdgcn_exp2f(S[qb][rb][r] - mnew); S[qb][rb][r] = p; ps += p; }
            lrun[qb] += ps; }
#pragma unroll
        for (int mm = 0; mm < 4; ++mm) { bf16x8 pf[2];
#pragma unroll
            for (int qb = 0; qb < 2; ++qb) { const f32x16& s = S[qb][mm >> 1]; const int o = 8 * (mm & 1); u32x4 w;
                w.x = cvt_pk_bf16(s[o + 0], s[o + 1]); w.y = cvt_pk_bf16(s[o + 2], s[o + 3]); w.z = cvt_pk_bf16(s[o + 4], s[o + 5]); w.w = cvt_pk_bf16(s[o + 6], s[o + 7]); pf[qb] = __builtin_bit_cast(bf16x8, w); }
#pragma unroll
            for (int db = 0; db < 2; ++db) { const bf16x8 vf = *(const bf16x8*)(vb + ((32 * db + r32) * EK_ROW + 16 * mm + 8 * hi) * 2);
#pragma unroll
                for (int qb = 0; qb < 2; ++qb) O[qb][db] = __builtin_amdgcn_mfma_f32_32x32x16_bf16(vf, pf[qb], O[qb][db], 0, 0, 0); } }
        if (j + 1 < 5) EV_COMMIT(pbuf ^ 1);
        __syncthreads();
    }
#undef EV_ISSUE
#undef EV_COMMIT
    float* ssq = (float*)lds;
#pragma unroll
    for (int qb = 0; qb < 2; ++qb) { float l = lrun[qb]; l = xor32_add(l); const float il = 1.f / l; float q = 0.f;
#pragma unroll
        for (int db = 0; db < 2; ++db) { O[qb][db] *= il;
#pragma unroll
            for (int r = 0; r < 16; ++r) q += O[qb][db][r] * O[qb][db][r]; }
        q = xor32_add(q); if (hi == 0) ssq[h * 64 + 32 * qb + r32] = q; }
    __syncthreads();
#pragma unroll
    for (int qb = 0; qb < 2; ++qb) { float s = 0.f;
#pragma unroll
        for (int hh = 0; hh < 8; ++hh) s += ssq[hh * 64 + 32 * qb + r32];
        const float ra = rsqrtf(s * (1.f / 512.f) + EPS); const size_t t = tb + q0 + 32 * qb + r32;
#pragma unroll
        for (int kp = 0; kp < 4; ++kp) {
            const int db = kp >> 1, ga = (2 * kp) & 3, gb = ga + 1, c16 = 16 * kp + 8 * hi;
            u32x4 zq = *(const u32x4*)(H0 + t * EV_IN + 2304 + h * 64 + c16);
            unsigned z0 = zq.x, z1 = zq.y, z2 = zq.z, z3 = zq.w; swap32(z0, z2); swap32(z1, z3); zq = (u32x4){z0, z1, z2, z3};
            unsigned a0 = cvt_pk_bf16(O[qb][db][4 * ga + 0] * ra * siluf(bflo(zq.x)), O[qb][db][4 * ga + 1] * ra * siluf(bfhi(zq.x))), a1 = cvt_pk_bf16(O[qb][db][4 * ga + 2] * ra * siluf(bflo(zq.y)), O[qb][db][4 * ga + 3] * ra * siluf(bfhi(zq.y)));
            unsigned b0 = cvt_pk_bf16(O[qb][db][4 * gb + 0] * ra * siluf(bflo(zq.z)), O[qb][db][4 * gb + 1] * ra * siluf(bfhi(zq.z))), b1 = cvt_pk_bf16(O[qb][db][4 * gb + 2] * ra * siluf(bflo(zq.w)), O[qb][db][4 * gb + 3] * ra * siluf(bfhi(zq.w)));
            swap32(a0, b0); swap32(a1, b1);
            *(u32x4*)(Y0 + t * DM + h * 64 + c16) = (u32x4){a0, a1, b0, b1}; } }
    { const int c0 = lane * 8; float cw[3][8];
#pragma unroll
        for (int jj = 0; jj < 3; ++jj) { const f32x4 a = *(const f32x4*)(convw + jj * 512 + c0), bq = *(const f32x4*)(convw + jj * 512 + c0 + 4);
#pragma unroll
            for (int e = 0; e < 4; ++e) { cw[jj][e] = a[e]; cw[jj][4 + e] = bq[e]; } }
        const int t0 = q0 + wid * 8;
#define EV_Z(dst, j_) do { const float vm_ = ((tg - 1 + (j_)) >= 0 && (tg - 1 + (j_)) < SEQ) ? 1.f : 0.f; const u32x4 cg_ = CG[j_], xi_ = XI[j_]; \
            dst[0] = bflo(cg_.x) * bflo(xi_.x) * vm_; dst[1] = bfhi(cg_.x) * bfhi(xi_.x) * vm_; dst[2] = bflo(cg_.y) * bflo(xi_.y) * vm_; dst[3] = bfhi(cg_.y) * bfhi(xi_.y) * vm_; \
            dst[4] = bflo(cg_.z) * bflo(xi_.z) * vm_; dst[5] = bfhi(cg_.z) * bfhi(xi_.z) * vm_; dst[6] = bflo(cg_.w) * bflo(xi_.w) * vm_; dst[7] = bfhi(cg_.w) * bfhi(xi_.w) * vm_; } while (0)
#pragma unroll 1
        for (int hg = 0; hg < 2; ++hg) { const int tg = t0 + 4 * hg; u32x4 CG[6], XI[6], BG[4], ZW[4];
#pragma unroll
            for (int j = 0; j < 6; ++j) { const int tc = min(max(tg - 1 + j, 0), SEQ - 1); CG[j] = *(const u32x4*)(H0 + (tb + tc) * EV_IN + 1280 + c0); XI[j] = *(const u32x4*)(H0 + (tb + tc) * EV_IN + 1792 + c0); }
#pragma unroll
            for (int i = 0; i < 4; ++i) { BG[i] = *(const u32x4*)(H0 + (tb + tg + i) * EV_IN + 768 + c0); ZW[i] = *(const u32x4*)(H0 + (tb + tg + i) * EV_IN + 2304 + 512 + c0); }
            float zp[8], zc[8], zn[8];
            EV_Z(zp, 0); EV_Z(zc, 1);
#pragma unroll
            for (int i = 0; i < 4; ++i) { const int t = tg + i; EV_Z(zn, i + 2);
                const u32x4 bgw = BG[i], zw = ZW[i];
                const float bg[8] = {bflo(bgw.x), bfhi(bgw.x), bflo(bgw.y), bfhi(bgw.y), bflo(bgw.z), bfhi(bgw.z), bflo(bgw.w), bfhi(bgw.w)};
                const float zz[8] = {siluf(bflo(zw.x)), siluf(bfhi(zw.x)), siluf(bflo(zw.y)), siluf(bfhi(zw.y)), siluf(bflo(zw.z)), siluf(bfhi(zw.z)), siluf(bflo(zw.w)), siluf(bfhi(zw.w))};
                float y[8], q = 0.f;
#pragma unroll
                for (int e = 0; e < 8; ++e) { y[e] = bg[e] * (cw[0][e] * zp[e] + cw[1][e] * zc[e] + cw[2][e] * zn[e]); q += y[e] * y[e]; }
                q += swz_xor<1>(q); q += swz_xor<2>(q); q += swz_xor<4>(q); q += swz_xor<8>(q); q += swz_xor<16>(q); q = xor32_add(q);
                const float rb = rsqrtf(q * (1.f / 512.f) + EPS); u32x4 w;
                w.x = cvt_pk_bf16(y[0] * rb * zz[0], y[1] * rb * zz[1]); w.y = cvt_pk_bf16(y[2] * rb * zz[2], y[3] * rb * zz[3]);
                w.z = cvt_pk_bf16(y[4] * rb * zz[4], y[5] * rb * zz[5]); w.w = cvt_pk_bf16(y[6] * rb * zz[6], y[7] * rb * zz[7]);
                *(u32x4*)(Y0 + (tb + t) * DM + 512 + c0) = w;
#pragma unroll
                for (int e = 0; e < 8; ++e) { zp[e] = zc[e]; zc[e] = zn[e]; }
                __builtin_amdgcn_sched_barrier(0); } }
#undef EV_Z
    }
}

constexpr int GV_ROW = 136, GV_BUF = 128 * GV_ROW * 2;
__device__ __forceinline__ void gmlp_item(int wsg, unsigned char* lds, const bf16_t* H1, const f32x2* statV, const float* lng, const float* lnb, const bf16_t* WSb, const float* bs, bf16_t* Y1, int chunk) {
    int tid_ = tid_from(wsg); asm volatile("" : "+v"(tid_));
    const int tid = tid_, lane = tid & 63, wid = tid >> 6, fr = lane & 15, fq = lane >> 4;
    f32x2* mr = (f32x2*)(lds + 2 * GV_BUF);
    const size_t row0 = (size_t)chunk * 128;
    __syncthreads();
    if (tid < 128) { const f32x2* p = statV + (row0 + tid) * 8; float s = 0.f, q = 0.f;
#pragma unroll
        for (int i = 0; i < 8; ++i) { const f32x2 v = p[i]; s += v.x; q += v.y; }
        const float mean = s * (1.f / 512.f), var = q * (1.f / 512.f) - mean * mean; mr[tid] = (f32x2){mean, rsqrtf(fmaxf(var, 0.f) + EPS)}; }
    const int st_s = (tid >> 2) & 127, st_cl = tid & 3;
    u32x4 gst[4];
#define GM_ISSUE(g_) do { _Pragma("unroll") for (int i = 0; i < 4; ++i) gst[i] = *(const u32x4*)(H1 + (row0 + st_s) * OD_IN + 1024 + (g_) * 128 + (st_cl + 4 * i) * 8); } while (0)
#define GM_COMMIT(g_, buf_) do { bf16_t* VnT_ = (bf16_t*)(lds + (buf_) * GV_BUF); const f32x2 st = mr[st_s]; \
        _Pragma("unroll") for (int i = 0; i < 4; ++i) { const int ch = st_cl + 4 * i, cb = (g_) * 128 + ch * 8; const u32x4 v = gst[i]; \
            const f32x4 ga = *(const f32x4*)(lng + cb), gb = *(const f32x4*)(lng + cb + 4), ba = *(const f32x4*)(lnb + cb), bb = *(const f32x4*)(lnb + cb + 4); \
            const float x[8] = {bflo(v.x), bfhi(v.x), bflo(v.y), bfhi(v.y), bflo(v.z), bfhi(v.z), bflo(v.w), bfhi(v.w)}; \
            const float gg[8] = {ga[0], ga[1], ga[2], ga[3], gb[0], gb[1], gb[2], gb[3]}, bbv[8] = {ba[0], ba[1], ba[2], ba[3], bb[0], bb[1], bb[2], bb[3]}; \
            _Pragma("unroll") for (int e = 0; e < 8; ++e) VnT_[(ch * 8 + e) * GV_ROW + st_s] = f2bf((x[e] - st.x) * st.y * gg[e] + bbv[e]); } } while (0)
    unsigned ydp[4][8][2]; float q = 0.f;
    const size_t trow = row0 + 16 * wid + fr;
    GM_ISSUE(0);
    __syncthreads();
    GM_COMMIT(0, 0);
    __syncthreads();
#pragma unroll
    for (int g = 0; g < 4; ++g) {
        if (g < 3) GM_ISSUE(g + 1);
        const bf16_t* VnT = (const bf16_t*)(lds + (g & 1) * GV_BUF);
        bf16x8 wf[4];
#pragma unroll
        for (int ks = 0; ks < 4; ++ks) wf[ks] = *(const bf16x8*)(WSb + ((size_t)g * 128 + 16 * wid + fr) * 128 + 32 * ks + 8 * fq);
        const float bsv = bs[g * 128 + 16 * wid + fr];
#pragma unroll
        for (int nb = 0; nb < 8; ++nb) { f32x4 a = (f32x4){0.f, 0.f, 0.f, 0.f};
#pragma unroll
            for (int ks = 0; ks < 4; ++ks) { const bf16x8 vf = *(const bf16x8*)(VnT + (16 * nb + fr) * GV_ROW + 32 * ks + 8 * fq); a = __builtin_amdgcn_mfma_f32_16x16x32_bf16(vf, wf[ks], a, 0, 0, 0); }
            const int d = g * 128 + 16 * nb + 4 * fq; const u32x2 uw = *(const u32x2*)(H1 + trow * OD_IN + 512 + d);
            const float y0 = bflo(uw.x) * (a[0] + bsv), y1 = bfhi(uw.x) * (a[1] + bsv), y2 = bflo(uw.y) * (a[2] + bsv), y3 = bfhi(uw.y) * (a[3] + bsv);
            q += (y0 * y0 + y1 * y1) + (y2 * y2 + y3 * y3); ydp[g][nb][0] = cvt_pk_bf16(y0, y1); ydp[g][nb][1] = cvt_pk_bf16(y2, y3); }
        if (g < 3) GM_COMMIT(g + 1, (g + 1) & 1);
        __syncthreads();
        __builtin_amdgcn_sched_barrier(0);
    }
#undef GM_ISSUE
#undef GM_COMMIT
    q += swz_xor<16>(q); q = xor32_add(q);
    const float rd = rsqrtf(q * (1.f / 512.f) + EPS);
#pragma unroll
    for (int g = 0; g < 4; ++g)
#pragma unroll
        for (int nb = 0; nb < 8; ++nb) { const int d = g * 128 + 16 * nb + 4 * fq; const u32x2 zw = *(const u32x2*)(H1 + trow * OD_IN + 1536 + 512 + d); u32x2 w;
            w.x = cvt_pk_bf16(bflo(ydp[g][nb][0]) * rd * siluf(bflo(zw.x)), bfhi(ydp[g][nb][0]) * rd * siluf(bfhi(zw.x))); w.y = cvt_pk_bf16(bflo(ydp[g][nb][1]) * rd * siluf(bflo(zw.y)), bfhi(ydp[g][nb][1]) * rd * siluf(bfhi(zw.y)));
            *(u32x2*)(Y1 + trow * DM + 512 + d) = w; }
}

constexpr int MK_ROW = 104, MK_BUF = 64 * MK_ROW * 2, MV_ROW = 72, MV_BUF = 64 * MV_ROW * 2;
__device__ __forceinline__ void mla_unit(int wsg, unsigned char* lds, const bf16_t* Qb, const bf16_t* Kb, const bf16_t* Vt, const bf16_t* H1, bf16_t* Y1, float* ssqC, int bh, int qblk) {
    int tid_ = tid_from(wsg); asm volatile("" : "+v"(tid_));
    const int tid = tid_, lane = tid & 63, wid = tid >> 6, r32 = lane & 31, hi = lane >> 5;
    const int b = bh >> 3, h = bh & 7;
    const bf16_t* Kg = Kb + (size_t)bh * SEQ * 96; const bf16_t* Vg = Vt + (size_t)bh * 64 * SEQ;
    const int qrow0 = qblk * 512 + wid * 64;
    bf16x8 qf[2][6];
#pragma unroll
    for (int qb = 0; qb < 2; ++qb)
#pragma unroll
        for (int ks = 0; ks < 6; ++ks) qf[qb][ks] = *(const bf16x8*)(Qb + ((size_t)bh * SEQ + qrow0 + 32 * qb + r32) * 96 + 16 * ks + 8 * hi);
    f32x16 O[2][2]; float mrun[2], lrun[2];
#pragma unroll
    for (int qb = 0; qb < 2; ++qb) { mrun[qb] = -1e30f; lrun[qb] = 0.f; O[qb][0] = (f32x16){}; O[qb][1] = (f32x16){}; }
    const int kc0 = tid, kc1 = tid + 512; const int vc = (tid >= 256) ? tid - 256 : tid + 256;
    const int k0_key = kc0 / 12, k0_ch = kc0 - k0_key * 12, k1_key = kc1 / 12, k1_ch = kc1 - k1_key * 12;
    const unsigned k0_l = (k0_key * MK_ROW + k0_ch * 8) * 2, k1_l = (k1_key * MK_ROW + k1_ch * 8) * 2, v_l = ((vc >> 3) * MV_ROW + (vc & 7) * 8) * 2;
    const bf16_t* vsrc = Vg + (size_t)(vc >> 3) * SEQ + (vc & 7) * 8;
    u32x4 g0, g1, g2 = (u32x4){0u, 0u, 0u, 0u};
#define MLA_ISSUE(t) do { g0 = *(const u32x4*)(Kg + (size_t)(t) * 64 * 96 + kc0 * 8); if (tid < 256) { g1 = *(const u32x4*)(Kg + (size_t)(t) * 64 * 96 + kc1 * 8); g2 = *(const u32x4*)(vsrc + (t) * 64); } else { g1 = *(const u32x4*)(vsrc + (t) * 64); } } while (0)
#define MLA_COMMIT(p) do { unsigned char* kb_ = lds + (p) * MK_BUF; unsigned char* vb_ = lds + 2 * MK_BUF + (p) * MV_BUF; *(u32x4*)(kb_ + k0_l) = g0; \
        if (tid < 256) { *(u32x4*)(kb_ + k1_l) = g1; *(u32x4*)(vb_ + v_l) = g2; } else { *(u32x4*)(vb_ + v_l) = g1; } } while (0)
    __syncthreads();
    MLA_ISSUE(0); MLA_COMMIT(0);
    __syncthreads();
    const int krow = kappa(r32);
    for (int t = 0; t < 64; ++t) {
        const int p = t & 1;
        if (t + 1 < 64) MLA_ISSUE(t + 1);
        const unsigned char* kb = lds + p * MK_BUF; const unsigned char* vb = lds + 2 * MK_BUF + p * MV_BUF;
        f32x16 S[2][2];
#pragma unroll
        for (int rb = 0; rb < 2; ++rb) { bf16x8 kf[6];
#pragma unroll
            for (int ks = 0; ks < 6; ++ks) kf[ks] = *(const bf16x8*)(kb + ((krow + 32 * rb) * MK_ROW + 16 * ks + 8 * hi) * 2);
#pragma unroll
            for (int qb = 0; qb < 2; ++qb) { f32x16 a = (f32x16){};
#pragma unroll
                for (int ks = 0; ks < 6; ++ks) a = __builtin_amdgcn_mfma_f32_32x32x16_bf16(kf[ks], qf[qb][ks], a, 0, 0, 0);
                S[qb][rb] = a; } }
#pragma unroll
        for (int qb = 0; qb < 2; ++qb) { float mx = -1e30f;
#pragma unroll
            for (int rb = 0; rb < 2; ++rb)
#pragma unroll
                for (int r = 0; r < 16; ++r) mx = fmaxf(mx, S[qb][rb][r]);
            if (__builtin_expect(__builtin_amdgcn_ballot_w64(mx - mrun[qb] > 8.0f) != 0ull, 0)) { mx = xor32_max(mx);
                const float mnew_ = fmaxf(mrun[qb], mx), alpha = __builtin_amdgcn_exp2f(mrun[qb] - mnew_); mrun[qb] = mnew_; lrun[qb] *= alpha;
#pragma unroll
                for (int db = 0; db < 2; ++db) O[qb][db] *= alpha; }
            const float mnew = mrun[qb]; float ps = 0.f;
#pragma unroll
            for (int rb = 0; rb < 2; ++rb)
#pragma unroll
                for (int r = 0; r < 16; ++r) { const float pe = __builtin_amdgcn_exp2f(S[qb][rb][r] - mnew); S[qb][rb][r] = pe; ps += pe; }
            lrun[qb] += ps; }
#pragma unroll
        for (int mm = 0; mm < 4; ++mm) { bf16x8 pf[2];
#pragma unroll
            for (int qb = 0; qb < 2; ++qb) { const f32x16& s = S[qb][mm >> 1]; const int o = 8 * (mm & 1); u32x4 w;
                w.x = cvt_pk_bf16(s[o + 0], s[o + 1]); w.y = cvt_pk_bf16(s[o + 2], s[o + 3]); w.z = cvt_pk_bf16(s[o + 4], s[o + 5]); w.w = cvt_pk_bf16(s[o + 6], s[o + 7]); pf[qb] = __builtin_bit_cast(bf16x8, w); }
#pragma unroll
            for (int db = 0; db < 2; ++db) { const bf16x8 vf = *(const bf16x8*)(vb + ((32 * db + r32) * MV_ROW + 16 * mm + 8 * hi) * 2);
#pragma unroll
                for (int qb = 0; qb < 2; ++qb) O[qb][db] = __builtin_amdgcn_mfma_f32_32x32x16_bf16(vf, pf[qb], O[qb][db], 0, 0, 0); } }
        if (t + 1 < 64) MLA_COMMIT(p ^ 1);
        __syncthreads();
    }
#undef MLA_ISSUE
#undef MLA_COMMIT
#pragma unroll
    for (int qb = 0; qb < 2; ++qb) { float l = lrun[qb]; l = xor32_add(l); const float il = 1.f / l; float q = 0.f;
        const size_t t = (size_t)b * SEQ + qrow0 + 32 * qb + r32;
#pragma unroll
        for (int db = 0; db < 2; ++db) { O[qb][db] *= il;
#pragma unroll
            for (int r = 0; r < 16; ++r) q += O[qb][db][r] * O[qb][db][r]; }
        q = xor32_add(q); if (hi == 0) ssqC[t * 8 + h] = q;
#pragma unroll
        for (int kp = 0; kp < 4; ++kp) {
            const int db = kp >> 1, ga = (2 * kp) & 3, gb = ga + 1, c16 = 16 * kp + 8 * hi;
            u32x4 zq = *(const u32x4*)(H1 + t * OD_IN + 1536 + h * 64 + c16);
            unsigned z0 = zq.x, z1 = zq.y, z2 = zq.z, z3 = zq.w; swap32(z0, z2); swap32(z1, z3); zq = (u32x4){z0, z1, z2, z3};
            unsigned a0 = cvt_pk_bf16(O[qb][db][4 * ga + 0] * siluf(bflo(zq.x)), O[qb][db][4 * ga + 1] * siluf(bfhi(zq.x))), a1 = cvt_pk_bf16(O[qb][db][4 * ga + 2] * siluf(bflo(zq.y)), O[qb][db][4 * ga + 3] * siluf(bfhi(zq.y)));
            unsigned b0 = cvt_pk_bf16(O[qb][db][4 * gb + 0] * siluf(bflo(zq.z)), O[qb][db][4 * gb + 1] * siluf(bfhi(zq.z))), b1 = cvt_pk_bf16(O[qb][db][4 * gb + 2] * siluf(bflo(zq.w)), O[qb][db][4 * gb + 3] * siluf(bfhi(zq.w)));
            swap32(a0, b0); swap32(a1, b1);
            *(u32x4*)(Y1 + t * DM + h * 64 + c16) = (u32x4){a0, a1, b0, b1}; } }
}

#define XB_TMO      128
#define XB_XCNT(j)  (256  + 64 * (j))
#define XB_XSUB(j)  (1280 + 64 * (j))
#define XB_XGEN(j)  (2304 + 64 * (j))
#define XB_TOP      3328
#define XB_TOPGEN   3392
#define XCD_BAR_WORDS 3456
#define XB_SPIN_CAP (1u << 18)
__device__ __forceinline__ unsigned xb_ld(unsigned* p)              { return __hip_atomic_load(p, __ATOMIC_RELAXED, __HIP_MEMORY_SCOPE_AGENT); }
__device__ __forceinline__ unsigned xb_add(unsigned* p, unsigned v) { return __hip_atomic_fetch_add(p, v, __ATOMIC_RELAXED, __HIP_MEMORY_SCOPE_AGENT); }
__device__ __forceinline__ unsigned xb_xcc_id() { return (unsigned)__builtin_amdgcn_s_getreg((3 << 11) | 20) & 0xFu; }
#define XB_SPIN(cond, bar) do { unsigned _sp = 0; while (cond) { __builtin_amdgcn_s_sleep(1); \
    if ((++_sp & 255u) == 0u) { if (xb_ld(&(bar)[XB_TMO])) break; if (_sp > XB_SPIN_CAP) { atomicAdd(&(bar)[XB_TMO], 1u); break; } } } } while (0)
__device__ __forceinline__ void xcd_barrier_complete(unsigned* bar, unsigned x, unsigned& nloc, unsigned& nx) {
    const unsigned G = gridDim.x * gridDim.y * gridDim.z;
    unsigned sum, cnt, mine, sp = 0u;
    for (;;) {
        sum = 0u; cnt = 0u; mine = 0u;
#pragma unroll
        for (unsigned j = 0; j < 16; ++j) { const unsigned c = xb_ld(&bar[XB_XCNT(j)]); sum += c; cnt += (c > 0u) ? 1u : 0u; mine = (j == x) ? c : mine; }
        if (sum == G) break;
        __builtin_amdgcn_s_sleep(1);
        if ((++sp & 255u) == 0u) { if (xb_ld(&bar[XB_TMO])) break; if (sp > XB_SPIN_CAP) { atomicAdd(&bar[XB_TMO], 1u); break; } }
    }
    nloc = mine > 0u ? mine : 1u; nx = cnt > 0u ? cnt : 1u;
}
__device__ __forceinline__ void xcd_barrier(unsigned* bar, volatile LAS unsigned* st, int wsg) {
    asm volatile("s_waitcnt vmcnt(0)" ::: "memory");
    __syncthreads();
    if (tid_from(wsg) == 0) {
        __builtin_amdgcn_s_waitcnt(0);
        const unsigned x = xb_xcc_id();
        unsigned nloc = st[0], nx = st[1];
        if (nloc == 0u) { xcd_barrier_complete(bar, x, nloc, nx); st[0] = nloc; st[1] = nx; }
        const unsigned old = xb_add(&bar[XB_XSUB(x)], 1u);
        const unsigned gen = old / nloc;
        if (old + 1u == (gen + 1u) * nloc) {
            __builtin_amdgcn_fence(__ATOMIC_RELEASE, "agent");
            asm volatile("s_waitcnt vmcnt(0)" ::: "memory");
            const unsigned og = xb_add(&bar[XB_TOP], 1u);
            const unsigned tg = og / nx;
            if (og + 1u == (tg + 1u) * nx) xb_add(&bar[XB_TOPGEN], 1u);
            else XB_SPIN(xb_ld(&bar[XB_TOPGEN]) == tg, bar);
            __builtin_amdgcn_fence(__ATOMIC_ACQUIRE, "agent");
            xb_add(&bar[XB_XGEN(x)], 1u);
            asm volatile("s_waitcnt vmcnt(0)" ::: "memory");
        } else {
            XB_SPIN(xb_ld(&bar[XB_XGEN(x)]) == gen, bar);
            __builtin_amdgcn_fence(__ATOMIC_ACQUIRE, "agent");
            asm volatile("s_waitcnt vmcnt(0)" ::: "memory");
        }
    }
    __syncthreads();
}

constexpr int LDS_BYTES = 147456;
#ifndef PHMASK
#define PHMASK 0x3ff
#endif
#ifndef DUPMASK
#define DUPMASK 0x000
#endif
#define PH(k) for (int rep_ = 0; rep_ < (((DUPMASK >> (k)) & 1) ? 2 : 1); ++rep_) if constexpr ((PHMASK >> (k)) & 1)
__global__ void __launch_bounds__(512, 2) mega(Args a) {
    extern __shared__ __attribute__((aligned(16))) unsigned char lds_raw[];
    cg::grid_group grid = cg::this_grid();
    LAS unsigned char* lds3 = (LAS unsigned char*)lds_raw;
    unsigned char* lds = lds_raw;
    const int wsg = __builtin_amdgcn_readfirstlane(threadIdx.x >> 6);
    volatile LAS unsigned* xb_st = (volatile LAS unsigned*)(lds3 + (LDS_BYTES - 16));
    if (threadIdx.x < 4) xb_st[threadIdx.x] = 0u;
    __syncthreads();
    if (threadIdx.x == 0) (void)xb_add((unsigned*)(a.ws + WS_BAR) + XB_XCNT(xb_xcc_id()), 1u);
#define SEAM() xcd_barrier((unsigned*)(a.ws + WS_BAR), xb_st, wsg)
#define PHASE_VARS int bid = blockIdx.x, G = gridDim.x; asm volatile("" : "+s"(bid), "+s"(G));
#define INF(i) ((const float*)a.in[i])
#define x_in (INF(0))
#define p_in (INF(1))
#define pos ((const int*)a.in[2])
#define ev_w_in INF(3)
#define ev_conv_w INF(4)
#define ev_sink INF(5)
#define ev_a_norm INF(6)
#define ev_b_norm INF(7)
#define ev_w_out INF(8)
#define od_w_in INF(9)
#define od_q_norm INF(10)
#define od_w_uq INF(11)
#define od_kv_norm INF(12)
#define od_w_ukv INF(13)
#define od_v_ln_g INF(14)
#define od_v_ln_b INF(15)
#define od_w_s INF(16)
#define od_b_s INF(17)
#define od_c_norm INF(18)
#define od_d_norm INF(19)
#define od_w_out INF(20)
#define post_ln_g INF(21)
#define post_ln_b INF(22)
#define ple_proj INF(23)
#define ple_gate INF(24)
#define WSP(T, off) ((T*)(a.ws + (off)))
#define WT_IN0 WSP(bf16_t, WS_WT_IN0)
#define WT_OUT0 WSP(bf16_t, WS_WT_OUT0)
#define WT_GATE0 WSP(bf16_t, WS_WT_GATE0)
#define WT_GATE1 WSP(bf16_t, WS_WT_GATE1)
#define WT_PROJ0 WSP(bf16_t, WS_WT_PROJ0)
#define WT_PROJ1 WSP(bf16_t, WS_WT_PROJ1)
#define WT_IN1 WSP(bf16_t, WS_WT_IN1)
#define WT_UQ WSP(bf16_t, WS_WT_UQ)
#define WT_UK WSP(bf16_t, WS_WT_UK)
#define WT_UV WSP(bf16_t, WS_WT_UV)
#define WT_OUT1 WSP(bf16_t, WS_WT_OUT1)
#define WSB WSP(bf16_t, WS_WSB)
#define GV WSP(float, WS_GV)
#define CS WSP(f32x2, WS_CS)
#define PART WSP(f32x2, WS_PART)
#define STATQ WSP(float, WS_STATQ)
#define STATKV WSP(float, WS_STATKV)
#define STATV WSP(f32x2, WS_STATV)
#define SSQC WSP(float, WS_SSQC)
#define MRBLK WSP(f32x2, WS_MRBLK)
#define XB WSP(bf16_t, WS_XB)
#define PB WSP(bf16_t, WS_PB)
#define PP WSP(bf16_t, WS_PP)
#define QB WSP(bf16_t, WS_PP)
#define H0 WSP(bf16_t, WS_HR)
#define H1 WSP(bf16_t, WS_HR)
#define UB WSP(bf16_t, WS_HR)
#define Y1B ((bf16_t*)a.out)
#define KB WSP(bf16_t, WS_KV)
#define VT WSP(bf16_t, WS_KV + 48 * MiB)

    PH(0) { PHASE_VARS const int tid = tid_from(wsg); const int gt = bid * 512 + tid, GT = G * 512;
        if (G >= 256 && bid < 256) {
            const int layer = bid >> 7, c = (bid & 127) * 8 + (tid & 7), ks = tid >> 3; const float* gate = ple_gate + (size_t)layer * DM * DM; const float* lg = post_ln_g + layer * DM; const float* lb = post_ln_b + layer * DM;
            float s1 = 0.f, s0 = 0.f;
#pragma unroll
            for (int k = ks * 16; k < ks * 16 + 16; ++k) { const float w = gate[(size_t)k * DM + c]; s1 += bf2f(f2bf(w * lg[k])); s0 += w * lb[k]; }
            float* red = (float*)lds; red[tid * 2] = s1; red[tid * 2 + 1] = s0;
            __syncthreads();
            if (tid < 8) { float t1 = 0.f, t0 = 0.f;
                for (int i = 0; i < 64; ++i) { t1 += red[(i * 8 + tid) * 2]; t0 += red[(i * 8 + tid) * 2 + 1]; }
                GV[layer * 2048 + c] = t1; GV[layer * 2048 + 1024 + c] = t0; }
            __syncthreads();
        } else if (G < 256 && bid < 32) {
            const int layer = bid >> 4, c = (bid & 15) * 64 + (tid & 63), kq = tid >> 6; const float* gate = ple_gate + (size_t)layer * DM * DM; const float* lg = post_ln_g + layer * DM; const float* lb = post_ln_b + layer * DM;
            float s1 = 0.f, s0 = 0.f;
            for (int k = kq * 128; k < kq * 128 + 128; ++k) { const float w = gate[(size_t)k * DM + c]; s1 += bf2f(f2bf(w * lg[k])); s0 += w * lb[k]; }
            float* red = (float*)lds; red[(kq * 64 + (tid & 63)) * 2] = s1; red[(kq * 64 + (tid & 63)) * 2 + 1] = s0;
            __syncthreads();
            if (tid < 64) { float t1 = 0.f, t0 = 0.f;
                for (int i = 0; i < 8; ++i) { t1 += red[(i * 64 + tid) * 2]; t0 += red[(i * 64 + tid) * 2 + 1]; }
                GV[layer * 2048 + c] = t1; GV[layer * 2048 + 1024 + c] = t0; }
            __syncthreads();
        }
        conv_w(ev_w_in, WT_IN0, 1024, EV_IN, EV_IN, 0, nullptr, nullptr, 0.125f * LOG2E, 512, gt, GT);
        conv_w(ev_w_out, WT_OUT0, 1024, 1024, 1024, 0, ev_a_norm, ev_b_norm, 1.f, 0, gt, GT);
        conv_w(ple_gate, WT_GATE0, 1024, 1024, 1024, 0, post_ln_g, nullptr, 1.f, 0, gt, GT);
        conv_w(ple_gate + (size_t)DM * DM, WT_GATE1, 1024, 1024, 1024, 0, post_ln_g + DM, nullptr, 1.f, 0, gt, GT);
        conv_w(ple_proj, WT_PROJ0, 256, 1024, 1024, 0, nullptr, nullptr, 1.f, 0, gt, GT);
        conv_w(ple_proj + 256 * DM, WT_PROJ1, 256, 1024, 1024, 0, nullptr, nullptr, 1.f, 0, gt, GT);
        conv_w(od_w_in, WT_IN1, 1024, OD_IN_SRC, OD_IN, 1, nullptr, nullptr, 1.f, 0, gt, GT);
        conv_w(od_w_uq, WT_UQ, 256, 768, 768, 2, od_q_norm, nullptr, 0.10206207261596577f * LOG2E, 768, gt, GT);
        conv_w(od_w_ukv, WT_UK, 128, 1024, 512, 3, od_kv_norm, nullptr, 1.f, 0, gt, GT);
        conv_w(od_w_ukv, WT_UV, 128, 1024, 512, 4, od_kv_norm, nullptr, 1.f, 0, gt, GT);
        conv_w(od_w_out, WT_OUT1, 1024, 1024, 1024, 0, od_c_norm, od_d_norm, 1.f, 0, gt, GT);
        conv_flat(od_w_s, WSB, (size_t)4 * 128 * 128 / 8, gt, GT);
        conv_flat(x_in, XB, (size_t)M * DM / 8, gt, GT);
        conv_flat(p_in, PB, (size_t)2 * M * 256 / 8, gt, GT);
        for (int i = gt; i < M * 16; i += GT) { const int row = i >> 4, j = i & 15; const float inv = exp2f(-(float)j * (13.287712379549449f / 16.f));
            double rev = (double)pos[row] * (double)inv * 0.15915494309189535; rev -= rint(rev); const float rf = (float)rev;
            CS[i] = (f32x2){__builtin_amdgcn_cosf(rf), __builtin_amdgcn_sinf(rf)}; }
    }
    if (a.ws == nullptr) grid.sync();
    SEAM();
    PH(1) { PHASE_VARS
        pg8::StaticOrder S; S.init(M, EV_IN, G, bid); pg8::Gemm g{XB, WT_IN0, M, EV_IN, 1024, 1024, 1024}; EpiStore E{H0, EV_IN, 1000};
        pg8::gemm_phase(wsg, lds3, g, S, E);
        pg8::StaticOrder S2; if (G == 256) S2.init(M, 1024, 128, bid - 128); else S2.init(M, 1024, G, bid);
        pg8::Gemm g2{PB, WT_PROJ0, M, 1024, 256, 256, 256}; EpiStore E2{PP, 1024, 1000};
        if (G != 256 || bid >= 128) pg8::gemm_phase(wsg, lds3, g2, S2, E2);
    }
    SEAM();
    PH(2) { PHASE_VARS for (int it = bid; it < 512; it += G) even_item(wsg, lds, H0, pos, ev_sink, ev_conv_w, XB, it >> 6, (it & 63) * 64); }
    SEAM();
    PH(3) { PHASE_VARS
        pg8::StaticOrder S; S.init(M, 1024, G, bid); pg8::Gemm g{XB, WT_OUT0, M, 1024, 1024, 1024, 1024}; EpiOut<false, false> E{x_in, UB, PART, nullptr};
        pg8::gemm_phase(wsg, lds3, g, S, E);
    }
    SEAM();
#define GATE_PHASE(WTG, LAYER, OUTF, XBOUT) do { \
        pg8::StaticOrder S; S.init(M, 1024, G, bid); \
        { int tq_ = tid_from(wsg); asm volatile("" : "+v"(tq_)); pg8::Unit u_; for (int i_ = tq_ >> 8; i_ < MR_UMAX && S.next(i_, u_); i_ += 2) { const int row_ = u_.pm * 256 + (tq_ & 255); const f32x4* pp_ = (const f32x4*)(PART + (size_t)row_ * 16); float s_ = 0.f, q_ = 0.f; \
              _Pragma("unroll") for (int j_ = 0; j_ < 8; ++j_) { const f32x4 v_ = pp_[j_]; s_ += v_[0] + v_[2]; q_ += v_[1] + v_[3]; } \
              const float mean_ = s_ * (1.f / 1024.f), var_ = q_ * (1.f / 1024.f) - mean_ * mean_; MRBLK[((size_t)bid * MR_UMAX + i_) * 256 + (tq_ & 255)] = (f32x2){mean_, rsqrtf(fmaxf(var_, 0.f) + EPS)}; } } \
        __threadfence_block(); __syncthreads(); \
        pg8::Gemm g{UB, WTG, M, 1024, 1024, 1024, 1024}; \
        EpiGate E{UB, MRBLK + (size_t)bid * MR_UMAX * 256, post_ln_g + (LAYER) * DM, post_ln_b + (LAYER) * DM, GV + (LAYER) * 2048, GV + (LAYER) * 2048 + 1024, PP, OUTF, XBOUT}; \
        pg8::gemm_phase(wsg, lds3, g, S, E); } while (0)
    PH(4) { PHASE_VARS GATE_PHASE(WT_GATE0, 0, (float*)nullptr, XB); }
    SEAM();
    PH(5) { PHASE_VARS
        pg8::StaticOrder S; S.init(M, OD_IN, G, bid); pg8::Gemm g{XB, WT_IN1, M, OD_IN, 1024, 1024, 1024}; EpiH1 E{H1, STATQ, STATKV, STATV, CS, KB};
        pg8::gemm_phase(wsg, lds3, g, S, E);
    }
    SEAM();
    PH(6) { PHASE_VARS
#ifndef P6MASK
#define P6MASK 15
#endif
        if constexpr (P6MASK & 1) { pg8::StaticOrder S; S.init(M, 768, G, bid); pg8::Gemm g{H1, WT_UQ, M, 768, 256, OD_IN, 256}; EpiQ E{STATQ, CS, QB}; pg8::gemm_phase(wsg, lds3, g, S, E); }
        if constexpr (P6MASK & 2) { pg8::StaticOrder S; S.init(M, 512, G, bid); pg8::Gemm g{H1 + 256, WT_UK, M, 512, 128, OD_IN, 128}; EpiK E{STATKV, KB}; pg8::gemm_phase(wsg, lds3, g, S, E); }
        if constexpr (P6MASK & 4) { pg8::StaticOrder S; S.init(512, M, G, bid); pg8::Gemm g{WT_UV, H1 + 256, 512, M, 128, 128, OD_IN}; EpiVT E{STATKV, VT}; pg8::gemm_phase(wsg, lds3, g, S, E); }
        if constexpr (P6MASK & 8) for (int it = bid; it < 256; it += G) gmlp_item(wsg, lds, H1, STATV, od_v_ln_g, od_v_ln_b, WSB, od_b_s, Y1B, it);
    }
    SEAM();
    PH(7) { PHASE_VARS for (int it = bid; it < 512; it += G) { const int xcd = it & 7, idx = it >> 3; mla_unit(wsg, lds, QB, KB, VT, H1, Y1B, SSQC, xcd * 8 + (idx >> 3), idx & 7); } }
    SEAM();
    PH(8) { PHASE_VARS
        pg8::StaticOrder S; S.init(M, 1024, G, bid); pg8::Gemm g{Y1B, WT_OUT1, M, 1024, 1024, 1024, 1024}; EpiOut<true, true> E{XB, UB, PART, SSQC};
        pg8::gemm_phase(wsg, lds3, g, S, E);
        pg8::StaticOrder S2; S2.init(M, 1024, G, bid); pg8::Gemm g2{PB + (size_t)M * 256, WT_PROJ1, M, 1024, 256, 256, 256}; EpiStore E2{PP, 1024, 1000};
        pg8::gemm_phase(wsg, lds3, g2, S2, E2);
    }
    SEAM();
    PH(9) { PHASE_VARS GATE_PHASE(WT_GATE1, 1, a.out, (bf16_t*)nullptr); }
}

extern "C" void kernel_launch(void* const* d_in, const int* in_sizes, int n_in, void* d_out, int out_size, void* d_ws, size_t ws_size, hipStream_t stream) {
    static int grid = 0;
    if (grid == 0) {
        if (n_in != 25 || out_size != M * DM || ws_size < WS_END) { fprintf(stderr, "kernel_launch: unexpected problem (n_in %d out %d ws %zu)\n", n_in, out_size, ws_size); grid = -1; return; }
        int dev = 0, cus = 0, per_cu = 0;
        (void)hipGetDevice(&dev);
        (void)hipDeviceGetAttribute(&cus, hipDeviceAttributeMultiprocessorCount, dev);
        (void)hipFuncSetAttribute((const void*)mega, hipFuncAttributeMaxDynamicSharedMemorySize, LDS_BYTES);
        (void)hipOccupancyMaxActiveBlocksPerMultiprocessor(&per_cu, (const void*)mega, 512, LDS_BYTES);
        if (per_cu < 1) { fprintf(stderr, "kernel_launch: occupancy query reports %d blocks per CU\n", per_cu); }
        grid = cus;
    }
    if (grid < 0) return;
    Args a{};
    for (int i = 0; i < 25; ++i) a.in[i] = d_in[i];
    a.out = (float*)d_out; a.ws = (unsigned char*)d_ws;
    (void)hipMemsetAsync((unsigned char*)d_ws + WS_BAR, 0, XCD_BAR_WORDS * 4, stream);
    void* args[] = {&a};
    hipError_t e = hipLaunchCooperativeKernel((const void*)mega, dim3(grid), dim3(512), args, LDS_BYTES, stream);
    if (e != hipSuccess) fprintf(stderr, "cooperative launch failed: %s (grid %d)\n", hipGetErrorString(e), grid);
}
```

```cpp
#include <hip/hip_runtime.h>
#include <hip/hip_cooperative_groups.h>
#include <cstdio>
#include <cstdint>
namespace cg = cooperative_groups;

#define LAS __attribute__((address_space(3)))
typedef unsigned short bf16_t;
typedef short bf16x8 __attribute__((ext_vector_type(8)));
typedef float f32x4 __attribute__((ext_vector_type(4)));
typedef float f32x2 __attribute__((ext_vector_type(2)));
typedef float f32x16 __attribute__((ext_vector_type(16)));
typedef unsigned u32x4 __attribute__((ext_vector_type(4)));
typedef unsigned u32x2 __attribute__((ext_vector_type(2)));

constexpr int BATCH = 8, SEQ = 4096, DM = 1024, M = BATCH * SEQ;
constexpr int EV_IN = 3328, OD_IN_SRC = 2464, OD_IN = 2560;
constexpr float EPS = 1e-6f, LOG2E = 1.4426950408889634f;
constexpr float DN_ALPHA = 1.4142135623730951f;
constexpr size_t MiB = 1u << 20;
constexpr size_t WS_WT_IN0 = 0, WS_WT_OUT0 = 7 * MiB, WS_WT_GATE0 = 9 * MiB, WS_WT_GATE1 = 11 * MiB, WS_WT_PROJ0 = 13 * MiB, WS_WT_PROJ1 = 13 * MiB + 512 * 1024,
                 WS_WT_IN1 = 14 * MiB, WS_WT_UQ = 19 * MiB, WS_WT_UK = 19 * MiB + 512 * 1024, WS_WT_UV = 19 * MiB + 768 * 1024, WS_WT_OUT1 = 20 * MiB,
                 WS_WSB = 22 * MiB, WS_GV = 22 * MiB + 512 * 1024, WS_CS = 23 * MiB, WS_PART = 27 * MiB, WS_STATQ = 31 * MiB, WS_STATKV = 31 * MiB + 512 * 1024,
                 WS_STATV = 32 * MiB, WS_SSQC = 34 * MiB, WS_MRBLK = 35 * MiB, WS_BAR = 39 * MiB,
                 WS_XB = 40 * MiB, WS_PB = 104 * MiB, WS_PP = 136 * MiB, WS_HR = 200 * MiB, WS_KV = 408 * MiB, WS_END = 488 * MiB;
constexpr int MR_UMAX = 8;

__device__ __forceinline__ unsigned cvt_pk_bf16(float lo, float hi) { unsigned r; asm volatile("v_cvt_pk_bf16_f32 %0, %1, %2" : "=v"(r) : "v"(lo), "v"(hi)); return r; }
__device__ __forceinline__ float bflo(unsigned w) { return __uint_as_float(w << 16); }
__device__ __forceinline__ float bfhi(unsigned w) { return __uint_as_float(w & 0xffff0000u); }
__device__ __forceinline__ float bf2f(bf16_t v) { return __uint_as_float((unsigned)v << 16); }
__device__ __forceinline__ bf16_t f2bf(float f) { return (bf16_t)(cvt_pk_bf16(f, 0.f) & 0xffffu); }
__device__ __forceinline__ float sigm(float x) { return __builtin_amdgcn_rcpf(1.f + __expf(-x)); }
__device__ __forceinline__ float siluf(float x) { return x * sigm(x); }
__device__ __forceinline__ float geluf(float x) { return x * sigm(1.5957691216057308f * (x + 0.044715f * x * x * x)); }
__device__ __forceinline__ u32x4 pack8(const f32x4 a, const f32x4 b) { u32x4 w; w.x = cvt_pk_bf16(a[0], a[1]); w.y = cvt_pk_bf16(a[2], a[3]); w.z = cvt_pk_bf16(b[0], b[1]); w.w = cvt_pk_bf16(b[2], b[3]); return w; }

template <int X> __device__ __forceinline__ float swz_xor(float v) { return __int_as_float(__builtin_amdgcn_ds_swizzle(__float_as_int(v), (X << 10) | 0x1f)); }
__device__ __forceinline__ float xor32_add(float v) { auto rr = __builtin_amdgcn_permlane32_swap(__float_as_uint(v), __float_as_uint(v), false, false); return __uint_as_float(rr[0]) + __uint_as_float(rr[1]); }
__device__ __forceinline__ float xor32_max(float v) { auto rr = __builtin_amdgcn_permlane32_swap(__float_as_uint(v), __float_as_uint(v), false, false); return fmaxf(__uint_as_float(rr[0]), __uint_as_float(rr[1])); }
__device__ __forceinline__ int lane_id_v() { int l; asm volatile("v_mbcnt_lo_u32_b32 %0, -1, 0\n\tv_mbcnt_hi_u32_b32 %0, -1, %0" : "=v"(l)); return l; }
__device__ __forceinline__ int tid_from(int wsg) { int l; asm volatile("v_mbcnt_lo_u32_b32 %0, -1, 0\n\tv_mbcnt_hi_u32_b32 %0, -1, %0" : "=v"(l)); return (wsg << 6) | l; }
__device__ __forceinline__ void swap32(unsigned& a, unsigned& b) { auto r = __builtin_amdgcn_permlane32_swap(a, b, false, false); a = r[0]; b = r[1]; }
namespace pg8 {
constexpr int BM = 256, BK = 64, HALF = 128, HTB = HALF * BK * 2, STAGE_BYTES = 8 * HTB, NXCD = 8, WGM = 8;
__host__ __device__ __forceinline__ int lds_byte(int r, int c) { const int st = (r >> 4) * 2 + (c >> 5), rr = r & 15, cc = c & 31, ob = rr * 64 + cc * 2; return st * 1024 + (ob ^ (((ob >> 9) & 1) << 5)); }
__host__ __device__ __forceinline__ void stage_rc(int b, int& R, int& C) { const int st = b / 1024, sb = b % 1024, swz = sb ^ (((sb >> 9) & 1) << 5); R = (st >> 1) * 16 + swz / 64; C = (st & 1) * 32 + (swz % 64) / 2; }
__host__ __device__ __forceinline__ int perm32(int rho) { const int n = rho >> 4, i = rho & 15; return 8 * (i >> 2) + 4 * n + (i & 3); }
struct Unit { int pm, pn, idx; };
struct Gemm { const bf16_t* A; const bf16_t* Bt; int M, N, K, lda, ldb; };
struct StaticOrder {
    int nM, nN, nwg, G, c;
    __device__ __forceinline__ void init(int M_, int N_, int G_, int c_) { nM = M_ / BM; nN = N_ / BM; nwg = nM * nN; G = G_; c = c_; }
    __device__ __forceinline__ bool next(int i, Unit& u) const {
        const long L = (long)i * G + c; if (L >= nwg) return false;
        int wgid = (int)L; { const int q = nwg / NXCD, r = nwg % NXCD, xcd = wgid % NXCD, off = wgid / NXCD; wgid = (xcd < r ? xcd * (q + 1) : r * (q + 1) + (xcd - r) * q) + off; }
        const int nig = WGM * nN, gid = wgid / nig, fm = gid * WGM, gsz = (nM - fm) < WGM ? (nM - fm) : WGM;
        u.pm = fm + ((wgid % nig) % gsz); u.pn = (wgid % nig) / gsz; u.idx = i; return true;
    }
};
template <class Epi, class Sched>
__device__ __forceinline__ void gemm_phase(int wsg, LAS unsigned char* lds, const Gemm g, const Sched& S, const Epi& E) {
    int tid_ = tid_from(wsg); asm volatile("" : "+v"(tid_));
    const int tid = tid_, wid = __builtin_amdgcn_readfirstlane(tid >> 6), lane = tid & 63, wr = wid >> 2, wc = wid & 3, fr = lane & 15, fq = lane >> 4;
    const int K = g.K, nt = K / BK;
    unsigned voffA[2], voffB[2];
#pragma unroll
    for (int i = 0; i < 2; ++i) { int R, C; stage_rc(tid * 16 + i * 8192, R, C); const int Rb = (R & ~31) + perm32(R & 31);
        voffA[i] = (unsigned)(R * g.lda + C) * 2u; voffB[i] = (unsigned)(Rb * g.ldb + C) * 2u; }
    const size_t kstep = (size_t)(BK * 2);
    const size_t hstepA = (size_t)HALF * g.lda * 2, hstepB = (size_t)HALF * g.ldb * 2;
    const size_t tstepA = 2 * hstepA, tstepB = 2 * hstepB;
    const unsigned ldsw = (unsigned)wid * 1024u;
    const int aoff = lds_byte(wr * 64 + fr, fq * 8), boff = lds_byte(wc * 32 + fr, fq * 8);
#define PG8_SA(b, h) (((b) * 2 + (h)) * HTB)
#define PG8_SB(b, h) ((4 + (b) * 2 + (h)) * HTB)
#define PG8_STAGE(bufoff, gbase, voff) do { _Pragma("unroll") for (int _i = 0; _i < 2; ++_i) \
        __builtin_amdgcn_global_load_lds((const unsigned*)((const char*)(gbase) + (voff)[_i]), (LAS unsigned*)(lds + (bufoff) + ldsw + _i * 8192), 16, 0, 0); } while (0)
#define PG8_LDA(dst, b, h) do { _Pragma("unroll") for (int m = 0; m < 4; ++m) _Pragma("unroll") for (int k = 0; k < 2; ++k) dst[m][k] = *(const LAS bf16x8*)(lds + PG8_SA(b, h) + aoff + m * 2048 + k * 1024); } while (0)
#define PG8_LDB(dst, b, h) do { _Pragma("unroll") for (int n = 0; n < 2; ++n) _Pragma("unroll") for (int k = 0; k < 2; ++k) dst[n][k] = *(const LAS bf16x8*)(lds + PG8_SB(b, h) + boff + n * 2048 + k * 1024); } while (0)
#define PG8_MMA(ai, bj, At, Bt) do { __builtin_amdgcn_s_setprio(1); _Pragma("unroll") for (int m = 0; m < 4; ++m) _Pragma("unroll") for (int n = 0; n < 2; ++n) _Pragma("unroll") for (int k = 0; k < 2; ++k) \
        acc[ai][bj][m][n] = __builtin_amdgcn_mfma_f32_16x16x32_bf16(Bt[n][k], At[m][k], acc[ai][bj][m][n], 0, 0, 0); __builtin_amdgcn_s_setprio(0); } while (0)
#define PG8_WAIT_V(n) asm volatile("s_waitcnt vmcnt(" #n ")" ::: "memory")
#define PG8_WAIT_L(n) asm volatile("s_waitcnt lgkmcnt(" #n ")" ::: "memory")
#define PG8_BAR __builtin_amdgcn_s_barrier()
#define PG8_SCHED __builtin_amdgcn_sched_barrier(0)
    Unit cur, nxt; int ui = 0;
    if (!S.next(0, cur)) return;
    f32x4 acc[2][2][4][2];
#pragma unroll
    for (int a = 0; a < 2; ++a)
#pragma unroll
        for (int b = 0; b < 2; ++b)
#pragma unroll
            for (int m = 0; m < 4; ++m)
#pragma unroll
                for (int n = 0; n < 2; ++n) acc[a][b][m][n] = (f32x4){0.f, 0.f, 0.f, 0.f};
    bf16x8 At[4][2], B0[2][2], B1[2][2];
    const char* cA = (const char*)g.A + (size_t)cur.pm * tstepA; const char* cB = (const char*)g.Bt + (size_t)cur.pn * tstepB;
    PG8_STAGE(PG8_SB(0, 0), cB, voffB); PG8_STAGE(PG8_SB(0, 1), cB + hstepB, voffB); PG8_STAGE(PG8_SA(0, 0), cA, voffA); PG8_STAGE(PG8_SA(0, 1), cA + hstepA, voffA);
    if (wr == 1) PG8_BAR;
    PG8_WAIT_V(2); PG8_BAR;
    PG8_STAGE(PG8_SB(1, 0), cB + kstep, voffB); PG8_STAGE(PG8_SA(1, 0), cA + kstep, voffA); PG8_STAGE(PG8_SB(1, 1), cB + hstepB + kstep, voffB);
    PG8_WAIT_V(6); PG8_BAR;
    for (;;) {
        const bool has_next = S.next(ui + 1, nxt);
        const char* nA = has_next ? (const char*)g.A + (size_t)nxt.pm * tstepA : cA; const char* nB = has_next ? (const char*)g.Bt + (size_t)nxt.pn * tstepB : cB;
        for (int t = 0; t < nt; t += 2) {
            const bool last = (t == nt - 2);
            const char* a1 = cA + (size_t)(t + 1) * kstep;
            const char* a2 = last ? nA : cA + (size_t)(t + 2) * kstep; const char* b2 = last ? nB : cB + (size_t)(t + 2) * kstep;
            const char* a3 = a2 + kstep; const char* b3 = b2 + kstep;
            if constexpr (Epi::MID) { if (t == (nt >> 1)) E.mid(acc, cur, wr, lane_id_v() & 15); }
            PG8_LDB(B0, 0, 0); PG8_LDB(B1, 0, 1); PG8_SCHED; PG8_LDA(At, 0, 0); PG8_STAGE(PG8_SA(1, 1), a1 + hstepA, voffA);
            PG8_WAIT_V(8); PG8_WAIT_L(0); PG8_BAR; PG8_MMA(0, 0, At, B0); PG8_MMA(0, 1, At, B1); PG8_BAR; PG8_SCHED;
            PG8_LDA(At, 0, 1); PG8_STAGE(PG8_SB(0, 0), b2, voffB); PG8_STAGE(PG8_SB(0, 1), b2 + hstepB, voffB); PG8_STAGE(PG8_SA(0, 0), a2, voffA);
            PG8_WAIT_V(8); PG8_WAIT_L(0); PG8_BAR; PG8_MMA(1, 0, At, B0); PG8_MMA(1, 1, At, B1); PG8_BAR; PG8_SCHED;
            PG8_LDB(B0, 1, 0); PG8_LDB(B1, 1, 1); PG8_SCHED; PG8_LDA(At, 1, 0); PG8_STAGE(PG8_SA(0, 1), a2 + hstepA, voffA);
            PG8_WAIT_V(8); PG8_WAIT_L(0); PG8_BAR; PG8_MMA(0, 0, At, B0); PG8_MMA(0, 1, At, B1); PG8_BAR; PG8_SCHED;
            PG8_LDA(At, 1, 1); PG8_STAGE(PG8_SB(1, 0), b3, voffB); PG8_STAGE(PG8_SB(1, 1), b3 + hstepB, voffB); PG8_STAGE(PG8_SA(1, 0), a3, voffA);
            PG8_WAIT_V(8); PG8_WAIT_L(0); PG8_BAR; PG8_MMA(1, 0, At, B0); PG8_MMA(1, 1, At, B1); PG8_BAR; PG8_SCHED;
        }
        if (wr == 0) PG8_BAR;
        { const int l_e = lane_id_v(); E(acc, cur, wr, wc, l_e & 15, l_e >> 4); }
        if (!has_next) break;
#pragma unroll
        for (int a = 0; a < 2; ++a)
#pragma unroll
            for (int b = 0; b < 2; ++b)
#pragma unroll
                for (int m = 0; m < 4; ++m)
#pragma unroll
                    for (int n = 0; n < 2; ++n) acc[a][b][m][n] = (f32x4){0.f, 0.f, 0.f, 0.f};
        cur = nxt; cA = nA; cB = nB; ++ui;
        if (wr == 1) PG8_BAR;
    }
    PG8_WAIT_V(0);
    PG8_BAR;
#undef PG8_SA
#undef PG8_SB
#undef PG8_STAGE
#undef PG8_LDA
#undef PG8_LDB
#undef PG8_MMA
#undef PG8_WAIT_V
#undef PG8_WAIT_L
#undef PG8_BAR
#undef PG8_SCHED
}
}
using pg8::Unit;
typedef f32x4 AccT[2][2][4][2];
#define EPI_ROW(u, ai, m) ((u).pm * 256 + (ai) * 128 + wr * 64 + (m) * 16 + fr)
#define EPI_LCOL(bj) ((bj) * 128 + wc * 32 + 8 * fq)

struct EpiStore {
    static constexpr bool MID = false;
    bf16_t* O; int ldc; int silu_pn;
    __device__ __forceinline__ void operator()(const AccT& acc, const Unit& u, int wr, int wc, int fr, int fq) const {
        const bool act = u.pn >= silu_pn;
#pragma unroll
        for (int ai = 0; ai < 2; ++ai)
#pragma unroll
            for (int m = 0; m < 4; ++m) { bf16_t* rowp = O + (size_t)EPI_ROW(u, ai, m) * ldc + u.pn * 256;
#pragma unroll
                for (int bj = 0; bj < 2; ++bj) { f32x4 v0 = acc[ai][bj][m][0], v1 = acc[ai][bj][m][1];
                    if (act) {
#pragma unroll
                        for (int e = 0; e < 4; ++e) { v0[e] = siluf(v0[e]); v1[e] = siluf(v1[e]); } }
                    *(u32x4*)(rowp + EPI_LCOL(bj)) = pack8(v0, v1); }
                asm volatile("" ::: "memory"); }
    }
};
template <bool MIDSCALE, bool RESBF> struct EpiOut {
    static constexpr bool MID = MIDSCALE;
    const void* res; bf16_t* Ub; f32x2* part; const float* ssqC;
    __device__ __forceinline__ void mid(AccT& acc, const Unit& u, int wr, int fr) const {
#pragma unroll
        for (int ai = 0; ai < 2; ++ai)
#pragma unroll
            for (int m = 0; m < 4; ++m) { const int row = EPI_ROW(u, ai, m); const f32x4 a = *(const f32x4*)(ssqC + (size_t)row * 8), b = *(const f32x4*)(ssqC + (size_t)row * 8 + 4);
                const float s = ((a[0] + a[1]) + (a[2] + a[3])) + ((b[0] + b[1]) + (b[2] + b[3])); const float rc = rsqrtf(s * (1.f / 512.f) + EPS);
#pragma unroll
                for (int bj = 0; bj < 2; ++bj)
#pragma unroll
                    for (int n = 0; n < 2; ++n) acc[ai][bj][m][n] *= rc; }
    }
    __device__ __forceinline__ void operator()(const AccT& acc, const Unit& u, int wr, int wc, int fr, int fq) const {
#pragma unroll
        for (int ai = 0; ai < 2; ++ai)
#pragma unroll
            for (int m = 0; m < 4; ++m) { const int row = EPI_ROW(u, ai, m); const size_t off = (size_t)row * DM + u.pn * 256; float s = 0.f, q = 0.f;
#pragma unroll
                for (int bj = 0; bj < 2; ++bj) { const size_t o = off + EPI_LCOL(bj); f32x4 r0, r1;
                    if constexpr (RESBF) { const u32x4 rw = *(const u32x4*)((const bf16_t*)res + o); r0 = (f32x4){bflo(rw.x), bfhi(rw.x), bflo(rw.y), bfhi(rw.y)}; r1 = (f32x4){bflo(rw.z), bfhi(rw.z), bflo(rw.w), bfhi(rw.w)}; }
                    else { r0 = *(const f32x4*)((const float*)res + o); r1 = *(const f32x4*)((const float*)res + o + 4); }
                    const f32x4 u0 = r0 * DN_ALPHA + acc[ai][bj][m][0], u1 = r1 * DN_ALPHA + acc[ai][bj][m][1];
                    *(u32x4*)(Ub + o) = pack8(u0, u1);
                    s += ((u0[0] + u0[1]) + (u0[2] + u0[3])) + ((u1[0] + u1[1]) + (u1[2] + u1[3]));
                    q += ((u0[0] * u0[0] + u0[1] * u0[1]) + (u0[2] * u0[2] + u0[3] * u0[3])) + ((u1[0] * u1[0] + u1[1] * u1[1]) + (u1[2] * u1[2] + u1[3] * u1[3])); }
                s += swz_xor<16>(s); s = xor32_add(s); q += swz_xor<16>(q); q = xor32_add(q);
                if (fq == 0) part[(size_t)row * 16 + u.pn * 4 + wc] = (f32x2){s, q};
                asm volatile("" ::: "memory"); }
    }
};
struct EpiGate {
    static constexpr bool MID = false;
    const bf16_t* Ub; const f32x2* mr; const float* lng; const float* lnb; const float* G1; const float* G0; const bf16_t* pp; float* out; bf16_t* xb;
    __device__ __forceinline__ void operator()(const AccT& acc, const Unit& u, int wr, int wc, int fr, int fq) const {
#pragma unroll
        for (int bj = 0; bj < 2; ++bj) { const int col = u.pn * 256 + EPI_LCOL(bj);
            f32x4 g[2], b[2], g1[2], g0[2];
#pragma unroll
            for (int n = 0; n < 2; ++n) { g[n] = *(const f32x4*)(lng + col + 4 * n); b[n] = *(const f32x4*)(lnb + col + 4 * n); g1[n] = *(const f32x4*)(G1 + col + 4 * n); g0[n] = *(const f32x4*)(G0 + col + 4 * n); }
#pragma unroll
            for (int ai = 0; ai < 2; ++ai)
#pragma unroll
                for (int m = 0; m < 4; ++m) { const int rl = ai * 128 + wr * 64 + m * 16 + fr; const f32x2 st = mr[u.idx * 256 + rl]; const size_t o = (size_t)(u.pm * 256 + rl) * DM + col;
                    const u32x4 pw = *(const u32x4*)(pp + o), uw = *(const u32x4*)(Ub + o); f32x4 ov[2];
                    const float ppv[8] = {bflo(pw.x), bfhi(pw.x), bflo(pw.y), bfhi(pw.y), bflo(pw.z), bfhi(pw.z), bflo(pw.w), bfhi(pw.w)};
                    const float uv[8] = {bflo(uw.x), bfhi(uw.x), bflo(uw.y), bfhi(uw.y), bflo(uw.z), bfhi(uw.z), bflo(uw.w), bfhi(uw.w)};
#pragma unroll
                    for (int n = 0; n < 2; ++n) {
#pragma unroll
                        for (int e = 0; e < 4; ++e) { const float h = (uv[4 * n + e] - st.x) * st.y * g[n][e] + b[n][e]; const float t = st.y * (acc[ai][bj][m][n][e] - st.x * g1[n][e]) + g0[n][e];
                            ov[n][e] = h + sigm(t) * ppv[4 * n + e]; } }
                    if (out) { __builtin_nontemporal_store(ov[0], (f32x4*)(out + o)); __builtin_nontemporal_store(ov[1], (f32x4*)(out + o + 4)); }
                    if (xb) *(u32x4*)(xb + o) = pack8(ov[0], ov[1]);
                    asm volatile("" ::: "memory"); } }
    }
};
struct EpiH1 {
    static constexpr bool MID = false;
    bf16_t* H1; float* statQ; float* statKV; f32x2* statV; const f32x2* cs; bf16_t* Kb;
    __device__ __forceinline__ void operator()(const AccT& acc, const Unit& u, int wr, int wc, int fr, int fq) const {
        const int pn = u.pn;
#pragma unroll
        for (int ai = 0; ai < 2; ++ai)
#pragma unroll
            for (int m = 0; m < 4; ++m) { const int row = EPI_ROW(u, ai, m); bf16_t* rowp = H1 + (size_t)row * OD_IN + pn * 256;
                if (pn == 0) { float q = 0.f;
#pragma unroll
                    for (int bj = 0; bj < 2; ++bj) { const f32x4 v0 = acc[ai][bj][m][0], v1 = acc[ai][bj][m][1]; *(u32x4*)(rowp + EPI_LCOL(bj)) = pack8(v0, v1);
                        q += ((v0[0] * v0[0] + v0[1] * v0[1]) + (v0[2] * v0[2] + v0[3] * v0[3])) + ((v1[0] * v1[0] + v1[1] * v1[1]) + (v1[2] * v1[2] + v1[3] * v1[3])); }
                    q += swz_xor<16>(q); q = xor32_add(q); if (fq == 0) statQ[(size_t)row * 4 + wc] = q;
                } else if (pn == 1) {
                    { const f32x4 v0 = acc[ai][0][m][0], v1 = acc[ai][0][m][1]; *(u32x4*)(rowp + EPI_LCOL(0)) = pack8(v0, v1);
                      float q = ((v0[0] * v0[0] + v0[1] * v0[1]) + (v0[2] * v0[2] + v0[3] * v0[3])) + ((v1[0] * v1[0] + v1[1] * v1[1]) + (v1[2] * v1[2] + v1[3] * v1[3]));
                      q += swz_xor<16>(q); q = xor32_add(q); if (fq == 0) statKV[(size_t)row * 4 + wc] = q; }
                    if (wc == 0) { const f32x4 v0 = acc[ai][1][m][0], v1 = acc[ai][1][m][1]; const float x[8] = {v0[0], v0[1], v0[2], v0[3], v1[0], v1[1], v1[2], v1[3]};
                        const f32x4 c01 = *(const f32x4*)(cs + (size_t)row * 16 + 4 * fq), c23 = *(const f32x4*)(cs + (size_t)row * 16 + 4 * fq + 2);
                        const float cc[4] = {c01[0], c01[2], c23[0], c23[2]}, ss[4] = {c01[1], c01[3], c23[1], c23[3]}; float o[8];
#pragma unroll
                        for (int e = 0; e < 4; ++e) { o[2 * e] = x[2 * e] * cc[e] - x[2 * e + 1] * ss[e]; o[2 * e + 1] = x[2 * e] * ss[e] + x[2 * e + 1] * cc[e]; }
                        u32x4 w; w.x = cvt_pk_bf16(o[0], o[1]); w.y = cvt_pk_bf16(o[2], o[3]); w.z = cvt_pk_bf16(o[4], o[5]); w.w = cvt_pk_bf16(o[6], o[7]);
                        const int b = row >> 12, s = row & 4095;
#pragma unroll
                        for (int h = 0; h < 8; ++h) *(u32x4*)(Kb + ((size_t)(b * 8 + h) * SEQ + s) * 96 + 64 + 8 * fq) = w; }
                } else if (pn < 6) { float s = 0.f, q = 0.f;
#pragma unroll
                    for (int bj = 0; bj < 2; ++bj) { f32x4 v0 = acc[ai][bj][m][0], v1 = acc[ai][bj][m][1];
#pragma unroll
                        for (int e = 0; e < 4; ++e) { v0[e] = geluf(v0[e]); v1[e] = geluf(v1[e]); }
                        *(u32x4*)(rowp + EPI_LCOL(bj)) = pack8(v0, v1);
                        s += ((v0[0] + v0[1]) + (v0[2] + v0[3])) + ((v1[0] + v1[1]) + (v1[2] + v1[3]));
                        q += ((v0[0] * v0[0] + v0[1] * v0[1]) + (v0[2] * v0[2] + v0[3] * v0[3])) + ((v1[0] * v1[0] + v1[1] * v1[1]) + (v1[2] * v1[2] + v1[3] * v1[3])); }
                    if (pn >= 4) { s += swz_xor<16>(s); s = xor32_add(s); q += swz_xor<16>(q); q = xor32_add(q);
                        if (fq == 0) statV[(size_t)row * 8 + (pn - 4) * 4 + wc] = (f32x2){s, q}; }
                } else {
#pragma unroll
                    for (int bj = 0; bj < 2; ++bj) *(u32x4*)(rowp + EPI_LCOL(bj)) = pack8(acc[ai][bj][m][0], acc[ai][bj][m][1]); }
                asm volatile("" ::: "memory"); }
    }
};
struct EpiQ {
    static constexpr bool MID = false;
    const float* statQ; const f32x2* cs; bf16_t* Qb;
    __device__ __forceinline__ void operator()(const AccT& acc, const Unit& u, int wr, int wc, int fr, int fq) const {
#pragma unroll
        for (int ai = 0; ai < 2; ++ai)
#pragma unroll
            for (int m = 0; m < 4; ++m) { const int row = EPI_ROW(u, ai, m); const f32x4 sq = *(const f32x4*)(statQ + (size_t)row * 4);
                const float rq = rsqrtf(((sq[0] + sq[1]) + (sq[2] + sq[3])) * (1.f / 256.f) + EPS); const int b = row >> 12, s = row & 4095;
#pragma unroll
                for (int bj = 0; bj < 2; ++bj) { const int col = u.pn * 256 + EPI_LCOL(bj), h = col / 96, j = col - h * 96;
                    const f32x4 v0 = acc[ai][bj][m][0] * rq, v1 = acc[ai][bj][m][1] * rq; u32x4 w;
                    if (j >= 64) { const int i0 = (j - 64) >> 1; const float x[8] = {v0[0], v0[1], v0[2], v0[3], v1[0], v1[1], v1[2], v1[3]};
                        const f32x4 c01 = *(const f32x4*)(cs + (size_t)row * 16 + i0), c23 = *(const f32x4*)(cs + (size_t)row * 16 + i0 + 2);
                        const float cc[4] = {c01[0], c01[2], c23[0], c23[2]}, ss[4] = {c01[1], c01[3], c23[1], c23[3]}; float o[8];
#pragma unroll
                        for (int e = 0; e < 4; ++e) { o[2 * e] = x[2 * e] * cc[e] - x[2 * e + 1] * ss[e]; o[2 * e + 1] = x[2 * e] * ss[e] + x[2 * e + 1] * cc[e]; }
                        w.x = cvt_pk_bf16(o[0], o[1]); w.y = cvt_pk_bf16(o[2], o[3]); w.z = cvt_pk_bf16(o[4], o[5]); w.w = cvt_pk_bf16(o[6], o[7]);
                    } else w = pack8(v0, v1);
                    *(u32x4*)(Qb + ((size_t)(b * 8 + h) * SEQ + s) * 96 + j) = w; }
                asm volatile("" ::: "memory"); }
    }
};
struct EpiK {
    static constexpr bool MID = false;
    const float* statKV; bf16_t* Kb;
    __device__ __forceinline__ void operator()(const AccT& acc, const Unit& u, int wr, int wc, int fr, int fq) const {
#pragma unroll
        for (int ai = 0; ai < 2; ++ai)
#pragma unroll
            for (int m = 0; m < 4; ++m) { const int row = EPI_ROW(u, ai, m); const f32x4 sq = *(const f32x4*)(statKV + (size_t)row * 4);
                const float rk = rsqrtf(((sq[0] + sq[1]) + (sq[2] + sq[3])) * (1.f / 128.f) + EPS); const int b = row >> 12, s = row & 4095;
#pragma unroll
                for (int bj = 0; bj < 2; ++bj) { const int col = u.pn * 256 + EPI_LCOL(bj), h = col >> 6, j = col & 63;
                    *(u32x4*)(Kb + ((size_t)(b * 8 + h) * SEQ + s) * 96 + j) = pack8(acc[ai][bj][m][0] * rk, acc[ai][bj][m][1] * rk); }
                asm volatile("" ::: "memory"); }
    }
};
struct EpiVT {
    static constexpr bool MID = false;
    const float* statKV; bf16_t* Vt;
    __device__ __forceinline__ void operator()(const AccT& acc, const Unit& u, int wr, int wc, int fr, int fq) const {
#pragma unroll
        for (int bj = 0; bj < 2; ++bj) { const int tok = u.pn * 256 + EPI_LCOL(bj), b = tok >> 12, s = tok & 4095; float rk[8];
#pragma unroll
            for (int e = 0; e < 8; ++e) { const f32x4 sq = *(const f32x4*)(statKV + (size_t)(tok + e) * 4); rk[e] = rsqrtf(((sq[0] + sq[1]) + (sq[2] + sq[3])) * (1.f / 128.f) + EPS); }
#pragma unroll
            for (int ai = 0; ai < 2; ++ai)
#pragma unroll
                for (int m = 0; m < 4; ++m) { const int hd = EPI_ROW(u, ai, m); f32x4 v0 = acc[ai][bj][m][0], v1 = acc[ai][bj][m][1];
#pragma unroll
                    for (int e = 0; e < 4; ++e) { v0[e] *= rk[e]; v1[e] *= rk[4 + e]; }
                    *(u32x4*)(Vt + ((size_t)b * 512 + hd) * SEQ + s) = pack8(v0, v1);
                    asm volatile("" ::: "memory"); } }
    }
};

__device__ __forceinline__ int colmap(int map, int n) {
    switch (map) {
    case 1: { if (n < 384) return n; if (n < 416) { const int j = n - 384, i = j >> 1; return 384 + ((j & 1) ? i + 16 : i); } if (n < 512) return -1; if (n < 1024) return 416 + (n - 512); if (n < 1536) return 928 + (n - 1024); return 1440 + (n - 1536); }
    case 2: { const int h = n / 96, j = n - h * 96; if (j < 64) return n; const int jj = j - 64, i = jj >> 1; return h * 96 + 64 + ((jj & 1) ? i + 16 : i); }
    case 3: return (n >> 6) * 128 + (n & 63);
    case 4: return (n >> 6) * 128 + 64 + (n & 63);
    default: return n;
    }
}
__device__ __forceinline__ void conv_w(const float* W, bf16_t* WT, int K, int Nsrc, int Ndst, int map, const float* rs, const float* rs2, float cscale, int cs_upto, int gt, int GT) {
    const int nitem = Ndst * (K >> 3);
    const int nb8 = Ndst >> 3;
    for (int it = gt; it < nitem; it += GT) { const int rest = it >> 6, n = (rest % nb8) * 8 + ((it >> 3) & 7), k0 = ((rest / nb8) * 8 + (it & 7)) * 8; const int src = colmap(map, n); const float cs = (n < cs_upto) ? cscale : 1.f; const int srcc = src < 0 ? 0 : src; const float csz = src < 0 ? 0.f : cs; float v[8];
#pragma unroll
        for (int e = 0; e < 8; ++e) { const int k = k0 + e; const float w = W[(size_t)k * Nsrc + srcc]; v[e] = w * csz; }
        if (rs) { const float* rp = (rs2 && k0 >= 512) ? (rs2 + (k0 - 512)) : (rs + k0); const f32x4 ra = *(const f32x4*)rp, rb4 = *(const f32x4*)(rp + 4);
#pragma unroll
            for (int e = 0; e < 4; ++e) { v[e] *= ra[e]; v[4 + e] *= rb4[e]; } }
        u32x4 o; o.x = cvt_pk_bf16(v[0], v[1]); o.y = cvt_pk_bf16(v[2], v[3]); o.z = cvt_pk_bf16(v[4], v[5]); o.w = cvt_pk_bf16(v[6], v[7]);
        *(u32x4*)(WT + (size_t)n * K + k0) = o; }
}
__device__ __forceinline__ void conv_flat(const float* src, bf16_t* dst, size_t n8, int gt, int GT) {
    size_t i = gt;
    for (; i + 3 * (size_t)GT < n8; i += 4 * (size_t)GT) { f32x4 a[4], b[4];
#pragma unroll
        for (int j = 0; j < 4; ++j) { a[j] = __builtin_nontemporal_load((const f32x4*)(src + (i + j * (size_t)GT) * 8)); b[j] = __builtin_nontemporal_load((const f32x4*)(src + (i + j * (size_t)GT) * 8 + 4)); }
#pragma unroll
        for (int j = 0; j < 4; ++j) *(u32x4*)(dst + (i + j * (size_t)GT) * 8) = pack8(a[j], b[j]); }
    for (; i < n8; i += GT) { const f32x4 a = *(const f32x4*)(src + i * 8), b = *(const f32x4*)(src + i * 8 + 4); *(u32x4*)(dst + i * 8) = pack8(a, b); }
}

struct Args { const void* in[25]; float* out; unsigned char* ws; };

__device__ __forceinline__ int kappa(int r) { return (r & ~12) | ((r & 4) << 1) | ((r & 8) >> 1); }
constexpr int EK_ROW = 72, EK_BUF = 64 * EK_ROW * 2, EV_STAGE = 4 * EK_BUF + 256;
__device__ __forceinline__ void even_item(int wsg, unsigned char* lds, const bf16_t* H0, const int* pos, const float* sink, const float* convw, bf16_t* Y0, int b, int q0) {
    int tid_ = tid_from(wsg); asm volatile("" : "+v"(tid_));
    const int tid = tid_, lane = tid & 63, wid = tid >> 6, r32 = lane & 31, hi = lane >> 5;
    const int h = wid, kvh = h >> 2;
    const size_t tb = (size_t)b * SEQ;
    bf16x8 qf[2][4]; float posq[2];
#pragma unroll
    for (int qb = 0; qb < 2; ++qb) { const size_t t = tb + q0 + 32 * qb + r32; posq[qb] = (float)pos[t];
#pragma unroll
        for (int ks = 0; ks < 4; ++ks) qf[qb][ks] = *(const bf16x8*)(H0 + t * EV_IN + h * 64 + 16 * ks + 8 * hi); }
    const float slope2 = exp2f(-(float)(h + 1)) * LOG2E, sink2 = sink[h] * LOG2E;
    f32x16 O[2][2]; float mrun[2], lrun[2];
#pragma unroll
    for (int qb = 0; qb < 2; ++qb) { mrun[qb] = sink2; lrun[qb] = (hi == 0) ? 1.f : 0.f; O[qb][0] = (f32x16){}; O[qb][1] = (f32x16){}; }
    u32x4 gk[2], gv[2]; float gp = 0.f;
#define EV_ISSUE(j_) do { const int kbase_ = q0 - 128 + 64 * (j_); \
        _Pragma("unroll") for (int i = 0; i < 2; ++i) { const int c = tid + i * 512; \
            { const int key = (c >> 3) & 63, ch = c & 7, kg = min(max(kbase_ + key, 0), SEQ - 1); gk[i] = *(const u32x4*)(H0 + (tb + kg) * EV_IN + 512 + i * 64 + ch * 8); } \
            { const int key = c & 63, ch = (c >> 6) & 7, kg = min(max(kbase_ + key, 0), SEQ - 1); gv[i] = *(const u32x4*)(H0 + (tb + kg) * EV_IN + 640 + i * 64 + ch * 8); } } \
        { const int kg = min(max(kbase_ + (tid & 63), 0), SEQ - 1); gp = (float)pos[tb + kg]; } } while (0)
#define EV_COMMIT(p_) do { unsigned char* base_ = lds + (p_) * EV_STAGE; \
        _Pragma("unroll") for (int i = 0; i < 2; ++i) { const int c = tid + i * 512; \
            { const int key = (c >> 3) & 63, ch = c & 7; *(u32x4*)(base_ + i * EK_BUF + (key * EK_ROW + ch * 8) * 2) = gk[i]; } \
            { const int key = c & 63, ch = (c >> 6) & 7; const u32x4 v = gv[i]; bf16_t* vt = (bf16_t*)(base_ + 2 * EK_BUF + i * EK_BUF) + (ch * 8) * EK_ROW + key; \
              vt[0 * EK_ROW] = (bf16_t)(v.x & 0xffffu); vt[1 * EK_ROW] = (bf16_t)(v.x >> 16); vt[2 * EK_ROW] = (bf16_t)(v.y & 0xffffu); vt[3 * EK_ROW] = (bf16_t)(v.y >> 16); \
              vt[4 * EK_ROW] = (bf16_t)(v.z & 0xffffu); vt[5 * EK_ROW] = (bf16_t)(v.z >> 16); vt[6 * EK_ROW] = (bf16_t)(v.w & 0xffffu); vt[7 * EK_ROW] = (bf16_t)(v.w >> 16); } } \
        ((float*)(base_ + 4 * EK_BUF))[tid & 63] = gp; } while (0)
    __syncthreads();
    EV_ISSUE(0); EV_COMMIT(0);
    __syncthreads();
#pragma unroll 1
    for (int j = 0; j < 5; ++j) {
        const int kbase = q0 - 128 + 64 * j; const int pbuf = j & 1;
        if (j + 1 < 5) EV_ISSUE(j + 1);
        const unsigned char* KLp = lds + pbuf * EV_STAGE; const unsigned char* VTp = KLp + 2 * EK_BUF; const float* posK = (const float*)(KLp + 4 * EK_BUF);
        const unsigned char* kb = KLp + kvh * EK_BUF; const unsigned char* vb = VTp + kvh * EK_BUF;
        f32x16 S[2][2];
#pragma unroll
        for (int rb = 0; rb < 2; ++rb) { bf16x8 kf[4];
#pragma unroll
            for (int ks = 0; ks < 4; ++ks) kf[ks] = *(const bf16x8*)(kb + ((kappa(r32) + 32 * rb) * EK_ROW + 16 * ks + 8 * hi) * 2);
#pragma unroll
            for (int qb = 0; qb < 2; ++qb) { f32x16 a = (f32x16){};
#pragma unroll
                for (int ks = 0; ks < 4; ++ks) a = __builtin_amdgcn_mfma_f32_32x32x16_bf16(kf[ks], qf[qb][ks], a, 0, 0, 0);
                S[qb][rb] = a; } }
#pragma unroll
        for (int qb = 0; qb < 2; ++qb) { const int qg = q0 + 32 * qb + r32; float mx = -1e30f;
            const int lo = max(-kbase, qg - 128 - kbase) - 8 * hi; const unsigned span = (unsigned)(min(SEQ - 1 - kbase, qg + 128 - kbase) - 8 * hi - lo);
            const float* pk_ = posK + 8 * hi;
#pragma unroll
            for (int rb = 0; rb < 2; ++rb)
#pragma unroll
                for (int hf = 0; hf < 2; ++hf) {
                    const f32x4 pa = *(const f32x4*)(pk_ + 32 * rb + 16 * hf), pb = *(const f32x4*)(pk_ + 32 * rb + 16 * hf + 4);
                    const float pkv[8] = {pa[0], pa[1], pa[2], pa[3], pb[0], pb[1], pb[2], pb[3]};
#pragma unroll
                    for (int i = 0; i < 8; ++i) { const int r = 8 * hf + i, c = 32 * rb + i + 16 * hf;
                        const float bias = slope2 * fabsf(posq[qb] - pkv[i]); const float sv0 = S[qb][rb][r] - bias;
                        const bool valid = (unsigned)(c - lo) <= span;
                        const float sv = valid ? sv0 : -1e30f; S[qb][rb][r] = sv; mx = fmaxf(mx, sv); }
                    __builtin_amdgcn_sched_barrier(0); }
            if (__builtin_expect(__builtin_amdgcn_ballot_w64(mx - mrun[qb] > 8.0f) != 0ull, 0)) { mx = xor32_max(mx); const float mnew_ = fmaxf(mrun[qb], mx), alpha = __builtin_amdgcn_exp2f(mrun[qb] - mnew_); mrun[qb] = mnew_; lrun[qb] *= alpha;
#pragma unroll
                for (int db = 0; db < 2; ++db) O[qb][db] *= alpha; }
            const float mnew = mrun[qb]; float ps = 0.f;
#pragma unroll
            for (int rb = 0; rb < 2; ++rb)
#pragma unroll
                for (int r = 0; r < 16; ++r) { const float p = __builtin_amdgcn_exp2f(S[qb][rb][r] - mnew); S[qb][rb][r] = p; ps += p; }
            lrun[qb] += ps; }
#pragma unroll
        for (int mm = 0; mm < 4; ++mm) { bf16x8 pf[2];
#pragma unroll
            for (int qb = 0; qb < 2; ++qb) { const f32x16& s = S[qb][mm >> 1]; const int o = 8 * (mm & 1); u32x4 w;
                w.x = cvt_pk_bf16(s[o + 0], s[o + 1]); w.y = cvt_pk_bf16(s[o + 2], s[o + 3]); w.z = cvt_pk_bf16(s[o + 4], s[o + 5]); w.w = cvt_pk_bf16(s[o + 6], s[o + 7]); pf[qb] = __builtin_bit_cast(bf16x8, w); }
#pragma unroll
            for (int db = 0; db < 2; ++db) { const bf16x8 vf = *(const bf16x8*)(vb + ((32 * db + r32) * EK_ROW + 16 * mm + 8 * hi) * 2);
#pragma unroll
                for (int qb = 0; qb < 2; ++qb) O[qb][db] = __builtin_amdgcn_mfma_f32_32x32x16_bf16(vf, pf[qb], O[qb][db], 0, 0, 0); } }
        if (j + 1 < 5) EV_COMMIT(pbuf ^ 1);
        __syncthreads();
    }
#undef EV_ISSUE
#undef EV_COMMIT
    float* ssq = (float*)lds;
#pragma unroll
    for (int qb = 0; qb < 2; ++qb) { float l = lrun[qb]; l = xor32_add(l); const float il = 1.f / l; float q = 0.f;
#pragma unroll
        for (int db = 0; db < 2; ++db) { O[qb][db] *= il;
#pragma unroll
            for (int r = 0; r < 16; ++r) q += O[qb][db][r] * O[qb][db][r]; }
        q = xor32_add(q); if (hi == 0) ssq[h * 64 + 32 * qb + r32] = q; }
    __syncthreads();
#pragma unroll
    for (int qb = 0; qb < 2; ++qb) { float s = 0.f;
#pragma unroll
        for (int hh = 0; hh < 8; ++hh) s += ssq[hh * 64 + 32 * qb + r32];
        const float ra = rsqrtf(s * (1.f / 512.f) + EPS); const size_t t = tb + q0 + 32 * qb + r32;
#pragma unroll
        for (int kp = 0; kp < 4; ++kp) {
            const int db = kp >> 1, ga = (2 * kp) & 3, gb = ga + 1, c16 = 16 * kp + 8 * hi;
            u32x4 zq = *(const u32x4*)(H0 + t * EV_IN + 2304 + h * 64 + c16);
            unsigned z0 = zq.x, z1 = zq.y, z2 = zq.z, z3 = zq.w; swap32(z0, z2); swap32(z1, z3); zq = (u32x4){z0, z1, z2, z3};
            unsigned a0 = cvt_pk_bf16(O[qb][db][4 * ga + 0] * ra * siluf(bflo(zq.x)), O[qb][db][4 * ga + 1] * ra * siluf(bfhi(zq.x))), a1 = cvt_pk_bf16(O[qb][db][4 * ga + 2] * ra * siluf(bflo(zq.y)), O[qb][db][4 * ga + 3] * ra * siluf(bfhi(zq.y)));
            unsigned b0 = cvt_pk_bf16(O[qb][db][4 * gb + 0] * ra * siluf(bflo(zq.z)), O[qb][db][4 * gb + 1] * ra * siluf(bfhi(zq.z))), b1 = cvt_pk_bf16(O[qb][db][4 * gb + 2] * ra * siluf(bflo(zq.w)), O[qb][db][4 * gb + 3] * ra * siluf(bfhi(zq.w)));
            swap32(a0, b0); swap32(a1, b1);
            *(u32x4*)(Y0 + t * DM + h * 64 + c16) = (u32x4){a0, a1, b0, b1}; } }
    { const int c0 = lane * 8; float cw[3][8];
#pragma unroll
        for (int jj = 0; jj < 3; ++jj) { const f32x4 a = *(const f32x4*)(convw + jj * 512 + c0), bq = *(const f32x4*)(convw + jj * 512 + c0 + 4);
#pragma unroll
            for (int e = 0; e < 4; ++e) { cw[jj][e] = a[e]; cw[jj][4 + e] = bq[e]; } }
        const int t0 = q0 + wid * 8;
#define EV_Z(dst, j_) do { const float vm_ = ((tg - 1 + (j_)) >= 0 && (tg - 1 + (j_)) < SEQ) ? 1.f : 0.f; const u32x4 cg_ = CG[j_], xi_ = XI[j_]; \
            dst[0] = bflo(cg_.x) * bflo(xi_.x) * vm_; dst[1] = bfhi(cg_.x) * bfhi(xi_.x) * vm_; dst[2] = bflo(cg_.y) * bflo(xi_.y) * vm_; dst[3] = bfhi(cg_.y) * bfhi(xi_.y) * vm_; \
            dst[4] = bflo(cg_.z) * bflo(xi_.z) * vm_; dst[5] = bfhi(cg_.z) * bfhi(xi_.z) * vm_; dst[6] = bflo(cg_.w) * bflo(xi_.w) * vm_; dst[7] = bfhi(cg_.w) * bfhi(xi_.w) * vm_; } while (0)
#pragma unroll 1
        for (int hg = 0; hg < 2; ++hg) { const int tg = t0 + 4 * hg; u32x4 CG[6], XI[6], BG[4], ZW[4];
#pragma unroll
            for (int j = 0; j < 6; ++j) { const int tc = min(max(tg - 1 + j, 0), SEQ - 1); CG[j] = *(const u32x4*)(H0 + (tb + tc) * EV_IN + 1280 + c0); XI[j] = *(const u32x4*)(H0 + (tb + tc) * EV_IN + 1792 + c0); }
#pragma unroll
            for (int i = 0; i < 4; ++i) { BG[i] = *(const u32x4*)(H0 + (tb + tg + i) * EV_IN + 768 + c0); ZW[i] = *(const u32x4*)(H0 + (tb + tg + i) * EV_IN + 2304 + 512 + c0); }
            float zp[8], zc[8], zn[8];
            EV_Z(zp, 0); EV_Z(zc, 1);
#pragma unroll
            for (int i = 0; i < 4; ++i) { const int t = tg + i; EV_Z(zn, i + 2);
                const u32x4 bgw = BG[i], zw = ZW[i];
                const float bg[8] = {bflo(bgw.x), bfhi(bgw.x), bflo(bgw.y), bfhi(bgw.y), bflo(bgw.z), bfhi(bgw.z), bflo(bgw.w), bfhi(bgw.w)};
                const float zz[8] = {siluf(bflo(zw.x)), siluf(bfhi(zw.x)), siluf(bflo(zw.y)), siluf(bfhi(zw.y)), siluf(bflo(zw.z)), siluf(bfhi(zw.z)), siluf(bflo(zw.w)), siluf(bfhi(zw.w))};
                float y[8], q = 0.f;
#pragma unroll
                for (int e = 0; e < 8; ++e) { y[e] = bg[e] * (cw[0][e] * zp[e] + cw[1][e] * zc[e] + cw[2][e] * zn[e]); q += y[e] * y[e]; }
                q += swz_xor<1>(q); q += swz_xor<2>(q); q += swz_xor<4>(q); q += swz_xor<8>(q); q += swz_xor<16>(q); q = xor32_add(q);
                const float rb = rsqrtf(q * (1.f / 512.f) + EPS); u32x4 w;
                w.x = cvt_pk_bf16(y[0] * rb * zz[0], y[1] * rb * zz[1]); w.y = cvt_pk_bf16(y[2] * rb * zz[2], y[3] * rb * zz[3]);
                w.z = cvt_pk_bf16(y[4] * rb * zz[4], y[5] * rb * zz[5]); w.w = cvt_pk_bf16(y[6] * rb * zz[6], y[7] * rb * zz[7]);
                *(u32x4*)(Y0 + (tb + t) * DM + 512 + c0) = w;
#pragma unroll
                for (int e = 0; e < 8; ++e) { zp[e] = zc[e]; zc[e] = zn[e]; }
                __builtin_amdgcn_sched_barrier(0); } }
#undef EV_Z
    }
}

constexpr int GV_ROW = 136, GV_BUF = 128 * GV_ROW * 2;
__device__ __forceinline__ void gmlp_item(int wsg, unsigned char* lds, const bf16_t* H1, const f32x2* statV, const float* lng, const float* lnb, const bf16_t* WSb, const float* bs, bf16_t* Y1, int chunk) {
    int tid_ = tid_from(wsg); asm volatile("" : "+v"(tid_));
    const int tid = tid_, lane = tid & 63, wid = tid >> 6, fr = lane & 15, fq = lane >> 4;
    f32x2* mr = (f32x2*)(lds + 2 * GV_BUF);
    const size_t row0 = (size_t)chunk * 128;
    __syncthreads();
    if (tid < 128) { const f32x2* p = statV + (row0 + tid) * 8; float s = 0.f, q = 0.f;
#pragma unroll
        for (int i = 0; i < 8; ++i) { const f32x2 v = p[i]; s += v.x; q += v.y; }
        const float mean = s * (1.f / 512.f), var = q * (1.f / 512.f) - mean * mean; mr[tid] = (f32x2){mean, rsqrtf(fmaxf(var, 0.f) + EPS)}; }
    const int st_s = (tid >> 2) & 127, st_cl = tid & 3;
    u32x4 gst[4];
#define GM_ISSUE(g_) do { _Pragma("unroll") for (int i = 0; i < 4; ++i) gst[i] = *(const u32x4*)(H1 + (row0 + st_s) * OD_IN + 1024 + (g_) * 128 + (st_cl + 4 * i) * 8); } while (0)
#define GM_COMMIT(g_, buf_) do { bf16_t* VnT_ = (bf16_t*)(lds + (buf_) * GV_BUF); const f32x2 st = mr[st_s]; \
        _Pragma("unroll") for (int i = 0; i < 4; ++i) { const int ch = st_cl + 4 * i, cb = (g_) * 128 + ch * 8; const u32x4 v = gst[i]; \
            const f32x4 ga = *(const f32x4*)(lng + cb), gb = *(const f32x4*)(lng + cb + 4), ba = *(const f32x4*)(lnb + cb), bb = *(const f32x4*)(lnb + cb + 4); \
            const float x[8] = {bflo(v.x), bfhi(v.x), bflo(v.y), bfhi(v.y), bflo(v.z), bfhi(v.z), bflo(v.w), bfhi(v.w)}; \
            const float gg[8] = {ga[0], ga[1], ga[2], ga[3], gb[0], gb[1], gb[2], gb[3]}, bbv[8] = {ba[0], ba[1], ba[2], ba[3], bb[0], bb[1], bb[2], bb[3]}; \
            _Pragma("unroll") for (int e = 0; e < 8; ++e) VnT_[(ch * 8 + e) * GV_ROW + st_s] = f2bf((x[e] - st.x) * st.y * gg[e] + bbv[e]); } } while (0)
    unsigned ydp[4][8][2]; float q = 0.f;
    const size_t trow = row0 + 16 * wid + fr;
    GM_ISSUE(0);
    __syncthreads();
    GM_COMMIT(0, 0);
    __syncthreads();
#pragma unroll
    for (int g = 0; g < 4; ++g) {
        if (g < 3) GM_ISSUE(g + 1);
        const bf16_t* VnT = (const bf16_t*)(lds + (g & 1) * GV_BUF);
        bf16x8 wf[4];
#pragma unroll
        for (int ks = 0; ks < 4; ++ks) wf[ks] = *(const bf16x8*)(WSb + ((size_t)g * 128 + 16 * wid + fr) * 128 + 32 * ks + 8 * fq);
        const float bsv = bs[g * 128 + 16 * wid + fr];
#pragma unroll
        for (int nb = 0; nb < 8; ++nb) { f32x4 a = (f32x4){0.f, 0.f, 0.f, 0.f};
#pragma unroll
            for (int ks = 0; ks < 4; ++ks) { const bf16x8 vf = *(const bf16x8*)(VnT + (16 * nb + fr) * GV_ROW + 32 * ks + 8 * fq); a = __builtin_amdgcn_mfma_f32_16x16x32_bf16(vf, wf[ks], a, 0, 0, 0); }
            const int d = g * 128 + 16 * nb + 4 * fq; const u32x2 uw = *(const u32x2*)(H1 + trow * OD_IN + 512 + d);
            const float y0 = bflo(uw.x) * (a[0] + bsv), y1 = bfhi(uw.x) * (a[1] + bsv), y2 = bflo(uw.y) * (a[2] + bsv), y3 = bfhi(uw.y) * (a[3] + bsv);
            q += (y0 * y0 + y1 * y1) + (y2 * y2 + y3 * y3); ydp[g][nb][0] = cvt_pk_bf16(y0, y1); ydp[g][nb][1] = cvt_pk_bf16(y2, y3); }
        if (g < 3) GM_COMMIT(g + 1, (g + 1) & 1);
        __syncthreads();
        __builtin_amdgcn_sched_barrier(0);
    }
#undef GM_ISSUE
#undef GM_COMMIT
    q += swz_xor<16>(q); q = xor32_add(q);
    const float rd = rsqrtf(q * (1.f / 512.f) + EPS);
#pragma unroll
    for (int g = 0; g < 4; ++g)
#pragma unroll
        for (int nb = 0; nb < 8; ++nb) { const int d = g * 128 + 16 * nb + 4 * fq; const u32x2 zw = *(const u32x2*)(H1 + trow * OD_IN + 1536 + 512 + d); u32x2 w;
            w.x = cvt_pk_bf16(bflo(ydp[g][nb][0]) * rd * siluf(bflo(zw.x)), bfhi(ydp[g][nb][0]) * rd * siluf(bfhi(zw.x))); w.y = cvt_pk_bf16(bflo(ydp[g][nb][1]) * rd * siluf(bflo(zw.y)), bfhi(ydp[g][nb][1]) * rd * siluf(bfhi(zw.y)));
            *(u32x2*)(Y1 + trow * DM + 512 + d) = w; }
}

constexpr int MK_ROW = 104, MK_BUF = 64 * MK_ROW * 2, MV_ROW = 72, MV_BUF = 64 * MV_ROW * 2;
__device__ __forceinline__ void mla_unit(int wsg, unsigned char* lds, const bf16_t* Qb, const bf16_t* Kb, const bf16_t* Vt, const bf16_t* H1, bf16_t* Y1, float* ssqC, int bh, int qblk) {
    int tid_ = tid_from(wsg); asm volatile("" : "+v"(tid_));
    const int tid = tid_, lane = tid & 63, wid = tid >> 6, r32 = lane & 31, hi = lane >> 5;
    const int b = bh >> 3, h = bh & 7;
    const bf16_t* Kg = Kb + (size_t)bh * SEQ * 96; const bf16_t* Vg = Vt + (size_t)bh * 64 * SEQ;
    const int qrow0 = qblk * 512 + wid * 64;
    bf16x8 qf[2][6];
#pragma unroll
    for (int qb = 0; qb < 2; ++qb)
#pragma unroll
        for (int ks = 0; ks < 6; ++ks) qf[qb][ks] = *(const bf16x8*)(Qb + ((size_t)bh * SEQ + qrow0 + 32 * qb + r32) * 96 + 16 * ks + 8 * hi);
    f32x16 O[2][2]; float mrun[2], lrun[2];
#pragma unroll
    for (int qb = 0; qb < 2; ++qb) { mrun[qb] = -1e30f; lrun[qb] = 0.f; O[qb][0] = (f32x16){}; O[qb][1] = (f32x16){}; }
    const int kc0 = tid, kc1 = tid + 512; const int vc = (tid >= 256) ? tid - 256 : tid + 256;
    const int k0_key = kc0 / 12, k0_ch = kc0 - k0_key * 12, k1_key = kc1 / 12, k1_ch = kc1 - k1_key * 12;
    const unsigned k0_l = (k0_key * MK_ROW + k0_ch * 8) * 2, k1_l = (k1_key * MK_ROW + k1_ch * 8) * 2, v_l = ((vc >> 3) * MV_ROW + (vc & 7) * 8) * 2;
    const bf16_t* vsrc = Vg + (size_t)(vc >> 3) * SEQ + (vc & 7) * 8;
    u32x4 g0, g1, g2 = (u32x4){0u, 0u, 0u, 0u};
#define MLA_ISSUE(t) do { g0 = *(const u32x4*)(Kg + (size_t)(t) * 64 * 96 + kc0 * 8); if (tid < 256) { g1 = *(const u32x4*)(Kg + (size_t)(t) * 64 * 96 + kc1 * 8); g2 = *(const u32x4*)(vsrc + (t) * 64); } else { g1 = *(const u32x4*)(vsrc + (t) * 64); } } while (0)
#define MLA_COMMIT(p) do { unsigned char* kb_ = lds + (p) * MK_BUF; unsigned char* vb_ = lds + 2 * MK_BUF + (p) * MV_BUF; *(u32x4*)(kb_ + k0_l) = g0; \
        if (tid < 256) { *(u32x4*)(kb_ + k1_l) = g1; *(u32x4*)(vb_ + v_l) = g2; } else { *(u32x4*)(vb_ + v_l) = g1; } } while (0)
    __syncthreads();
    MLA_ISSUE(0); MLA_COMMIT(0);
    __syncthreads();
    const int krow = kappa(r32);
    for (int t = 0; t < 64; ++t) {
        const int p = t & 1;
        if (t + 1 < 64) MLA_ISSUE(t + 1);
        const unsigned char* kb = lds + p * MK_BUF; const unsigned char* vb = lds + 2 * MK_BUF + p * MV_BUF;
        f32x16 S[2][2];
#pragma unroll
        for (int rb = 0; rb < 2; ++rb) { bf16x8 kf[6];
#pragma unroll
            for (int ks = 0; ks < 6; ++ks) kf[ks] = *(const bf16x8*)(kb + ((krow + 32 * rb) * MK_ROW + 16 * ks + 8 * hi) * 2);
#pragma unroll
            for (int qb = 0; qb < 2; ++qb) { f32x16 a = (f32x16){};
#pragma unroll
                for (int ks = 0; ks < 6; ++ks) a = __builtin_amdgcn_mfma_f32_32x32x16_bf16(kf[ks], qf[qb][ks], a, 0, 0, 0);
                S[qb][rb] = a; } }
#pragma unroll
        for (int qb = 0; qb < 2; ++qb) { float mx = -1e30f;
#pragma unroll
            for (int rb = 0; rb < 2; ++rb)
#pragma unroll
                for (int r = 0; r < 16; ++r) mx = fmaxf(mx, S[qb][rb][r]);
            if (__builtin_expect(__builtin_amdgcn_ballot_w64(mx - mrun[qb] > 8.0f) != 0ull, 0)) { mx = xor32_max(mx);
                const float mnew_ = fmaxf(mrun[qb], mx), alpha = __builtin_amdgcn_exp2f(mrun[qb] - mnew_); mrun[qb] = mnew_; lrun[qb] *= alpha;
#pragma unroll
                for (int db = 0; db < 2; ++db) O[qb][db] *= alpha; }
            const float mnew = mrun[qb]; float ps = 0.f;
#pragma unroll
            for (int rb = 0; rb < 2; ++rb)
#pragma unroll
                for (int r = 0; r < 16; ++r) { const float pe = __builtin_amdgcn_exp2f(S[qb][rb][r] - mnew); S[qb][rb][r] = pe; ps += pe; }
            lrun[qb] += ps; }
#pragma unroll
        for (int mm = 0; mm < 4; ++mm) { bf16x8 pf[2];
#pragma unroll
            for (int qb = 0; qb < 2; ++qb) { const f32x16& s = S[qb][mm >> 1]; const int o = 8 * (mm & 1); u32x4 w;
                w.x = cvt_pk_bf16(s[o + 0], s[o + 1]); w.y = cvt_pk_bf16(s[o + 2], s[o + 3]); w.z = cvt_pk_bf16(s[o + 4], s[o + 5]); w.w = cvt_pk_bf16(s[o + 6], s[o + 7]); pf[qb] = __builtin_bit_cast(bf16x8, w); }
#pragma unroll
            for (int db = 0; db < 2; ++db) { const bf16x8 vf = *(const bf16x8*)(vb + ((32 * db + r32) * MV_ROW + 16 * mm + 8 * hi) * 2);
#pragma unroll
                for (int qb = 0; qb < 2; ++qb) O[qb][db] = __builtin_amdgcn_mfma_f32_32x32x16_bf16(vf, pf[qb], O[qb][db], 0, 0, 0); } }
        if (t + 1 < 64) MLA_COMMIT(p ^ 1);
        __syncthreads();
    }
#undef MLA_ISSUE
#undef MLA_COMMIT
#pragma unroll
    for (int qb = 0; qb < 2; ++qb) { float l = lrun[qb]; l = xor32_add(l); const float il = 1.f / l; float q = 0.f;
        const size_t t = (size_t)b * SEQ + qrow0 + 32 * qb + r32;
#pragma unroll
        for (int db = 0; db < 2; ++db) { O[qb][db] *= il;
#pragma unroll
            for (int r = 0; r < 16; ++r) q += O[qb][db][r] * O[qb][db][r]; }
        q = xor32_add(q); if (hi == 0) ssqC[t * 8 + h] = q;
#pragma unroll
        for (int kp = 0; kp < 4; ++kp) {
            const int db = kp >> 1, ga = (2 * kp) & 3, gb = ga + 1, c16 = 16 * kp + 8 * hi;
            u32x4 zq = *(const u32x4*)(H1 + t * OD_IN + 1536 + h * 64 + c16);
            unsigned z0 = zq.x, z1 = zq.y, z2 = zq.z, z3 = zq.w; swap32(z0, z2); swap32(z1, z3); zq = (u32x4){z0, z1, z2, z3};
            unsigned a0 = cvt_pk_bf16(O[qb][db][4 * ga + 0] * siluf(bflo(zq.x)), O[qb][db][4 * ga + 1] * siluf(bfhi(zq.x))), a1 = cvt_pk_bf16(O[qb][db][4 * ga + 2] * siluf(bflo(zq.y)), O[qb][db][4 * ga + 3] * siluf(bfhi(zq.y)));
            unsigned b0 = cvt_pk_bf16(O[qb][db][4 * gb + 0] * siluf(bflo(zq.z)), O[qb][db][4 * gb + 1] * siluf(bfhi(zq.z))), b1 = cvt_pk_bf16(O[qb][db][4 * gb + 2] * siluf(bflo(zq.w)), O[qb][db][4 * gb + 3] * siluf(bfhi(zq.w)));
            swap32(a0, b0); swap32(a1, b1);
            *(u32x4*)(Y1 + t * DM + h * 64 + c16) = (u32x4){a0, a1, b0, b1}; } }
}

#define XB_TMO      128
#define XB_XCNT(j)  (256  + 64 * (j))
#define XB_XSUB(j)  (1280 + 64 * (j))
#define XB_XGEN(j)  (2304 + 64 * (j))
#define XB_TOP      3328
#define XB_TOPGEN   3392
#define XCD_BAR_WORDS 3456
#define XB_SPIN_CAP (1u << 18)
__device__ __forceinline__ unsigned xb_ld(unsigned* p)              { return __hip_atomic_load(p, __ATOMIC_RELAXED, __HIP_MEMORY_SCOPE_AGENT); }
__device__ __forceinline__ unsigned xb_add(unsigned* p, unsigned v) { return __hip_atomic_fetch_add(p, v, __ATOMIC_RELAXED, __HIP_MEMORY_SCOPE_AGENT); }
__device__ __forceinline__ unsigned xb_xcc_id() { return (unsigned)__builtin_amdgcn_s_getreg((3 << 11) | 20) & 0xFu; }
#define XB_SPIN(cond, bar) do { unsigned _sp = 0; while (cond) { __builtin_amdgcn_s_sleep(1); \
    if ((++_sp & 255u) == 0u) { if (xb_ld(&(bar)[XB_TMO])) break; if (_sp > XB_SPIN_CAP) { atomicAdd(&(bar)[XB_TMO], 1u); break; } } } } while (0)
__device__ __forceinline__ void xcd_barrier_complete(unsigned* bar, unsigned x, unsigned& nloc, unsigned& nx) {
    const unsigned G = gridDim.x * gridDim.y * gridDim.z;
    unsigned sum, cnt, mine, sp = 0u;
    for (;;) {
        sum = 0u; cnt = 0u; mine = 0u;
#pragma unroll
        for (unsigned j = 0; j < 16; ++j) { const unsigned c = xb_ld(&bar[XB_XCNT(j)]); sum += c; cnt += (c > 0u) ? 1u : 0u; mine = (j == x) ? c : mine; }
        if (sum == G) break;
        __builtin_amdgcn_s_sleep(1);
        if ((++sp & 255u) == 0u) { if (xb_ld(&bar[XB_TMO])) break; if (sp > XB_SPIN_CAP) { atomicAdd(&bar[XB_TMO], 1u); break; } }
    }
    nloc = mine > 0u ? mine : 1u; nx = cnt > 0u ? cnt : 1u;
}
__device__ __forceinline__ void xcd_barrier(unsigned* bar, volatile LAS unsigned* st, int wsg) {
    asm volatile("s_waitcnt vmcnt(0)" ::: "memory");
    __syncthreads();
    if (tid_from(wsg) == 0) {
        __builtin_amdgcn_s_waitcnt(0);
        const unsigned x = xb_xcc_id();
        unsigned nloc = st[0], nx = st[1];
        if (nloc == 0u) { xcd_barrier_complete(bar, x, nloc, nx); st[0] = nloc; st[1] = nx; }
        const unsigned old = xb_add(&bar[XB_XSUB(x)], 1u);
        const unsigned gen = old / nloc;
        if (old + 1u == (gen + 1u) * nloc) {
            __builtin_amdgcn_fence(__ATOMIC_RELEASE, "agent");
            asm volatile("s_waitcnt vmcnt(0)" ::: "memory");
            const unsigned og = xb_add(&bar[XB_TOP], 1u);
            const unsigned tg = og / nx;
            if (og + 1u == (tg + 1u) * nx) xb_add(&bar[XB_TOPGEN], 1u);
            else XB_SPIN(xb_ld(&bar[XB_TOPGEN]) == tg, bar);
            __builtin_amdgcn_fence(__ATOMIC_ACQUIRE, "agent");
            xb_add(&bar[XB_XGEN(x)], 1u);
            asm volatile("s_waitcnt vmcnt(0)" ::: "memory");
        } else {
            XB_SPIN(xb_ld(&bar[XB_XGEN(x)]) == gen, bar);
            __builtin_amdgcn_fence(__ATOMIC_ACQUIRE, "agent");
            asm volatile("s_waitcnt vmcnt(0)" ::: "memory");
        }
    }
    __syncthreads();
}

constexpr int LDS_BYTES = 147456;
#ifndef PHMASK
#define PHMASK 0x3ff
#endif
#ifndef DUPMASK
#define DUPMASK 0x000
#endif
#define PH(k) for (int rep_ = 0; rep_ < (((DUPMASK >> (k)) & 1) ? 2 : 1); ++rep_) if constexpr ((PHMASK >> (k)) & 1)
__global__ void __launch_bounds__(512, 2) mega(Args a) {
    extern __shared__ __attribute__((aligned(16))) unsigned char lds_raw[];
    cg::grid_group grid = cg::this_grid();
    LAS unsigned char* lds3 = (LAS unsigned char*)lds_raw;
    unsigned char* lds = lds_raw;
    const int wsg = __builtin_amdgcn_readfirstlane(threadIdx.x >> 6);
    volatile LAS unsigned* xb_st = (volatile LAS unsigned*)(lds3 + (LDS_BYTES - 16));
    if (threadIdx.x < 4) xb_st[threadIdx.x] = 0u;
    __syncthreads();
    if (threadIdx.x == 0) (void)xb_add((unsigned*)(a.ws + WS_BAR) + XB_XCNT(xb_xcc_id()), 1u);
#define SEAM() xcd_barrier((unsigned*)(a.ws + WS_BAR), xb_st, wsg)
#define PHASE_VARS int bid = blockIdx.x, G = gridDim.x; asm volatile("" : "+s"(bid), "+s"(G));
#define INF(i) ((const float*)a.in[i])
#define x_in (INF(0))
#define p_in (INF(1))
#define pos ((const int*)a.in[2])
#define ev_w_in INF(3)
#define ev_conv_w INF(4)
#define ev_sink INF(5)
#define ev_a_norm INF(6)
#define ev_b_norm INF(7)
#define ev_w_out INF(8)
#define od_w_in INF(9)
#define od_q_norm INF(10)
#define od_w_uq INF(11)
#define od_kv_norm INF(12)
#define od_w_ukv INF(13)
#define od_v_ln_g INF(14)
#define od_v_ln_b INF(15)
#define od_w_s INF(16)
#define od_b_s INF(17)
#define od_c_norm INF(18)
#define od_d_norm INF(19)
#define od_w_out INF(20)
#define post_ln_g INF(21)
#define post_ln_b INF(22)
#define ple_proj INF(23)
#define ple_gate INF(24)
#define WSP(T, off) ((T*)(a.ws + (off)))
#define WT_IN0 WSP(bf16_t, WS_WT_IN0)
#define WT_OUT0 WSP(bf16_t, WS_WT_OUT0)
#define WT_GATE0 WSP(bf16_t, WS_WT_GATE0)
#define WT_GATE1 WSP(bf16_t, WS_WT_GATE1)
#define WT_PROJ0 WSP(bf16_t, WS_WT_PROJ0)
#define WT_PROJ1 WSP(bf16_t, WS_WT_PROJ1)
#define WT_IN1 WSP(bf16_t, WS_WT_IN1)
#define WT_UQ WSP(bf16_t, WS_WT_UQ)
#define WT_UK WSP(bf16_t, WS_WT_UK)
#define WT_UV WSP(bf16_t, WS_WT_UV)
#define WT_OUT1 WSP(bf16_t, WS_WT_OUT1)
#define WSB WSP(bf16_t, WS_WSB)
#define GV WSP(float, WS_GV)
#define CS WSP(f32x2, WS_CS)
#define PART WSP(f32x2, WS_PART)
#define STATQ WSP(float, WS_STATQ)
#define STATKV WSP(float, WS_STATKV)
#define STATV WSP(f32x2, WS_STATV)
#define SSQC WSP(float, WS_SSQC)
#define MRBLK WSP(f32x2, WS_MRBLK)
#define XB WSP(bf16_t, WS_XB)
#define PB WSP(bf16_t, WS_PB)
#define PP WSP(bf16_t, WS_PP)
#define QB WSP(bf16_t, WS_PP)
#define H0 WSP(bf16_t, WS_HR)
#define H1 WSP(bf16_t, WS_HR)
#define UB WSP(bf16_t, WS_HR)
#define Y1B ((bf16_t*)a.out)
#define KB WSP(bf16_t, WS_KV)
#define VT WSP(bf16_t, WS_KV + 48 * MiB)

    PH(0) { PHASE_VARS const int tid = tid_from(wsg); const int gt = bid * 512 + tid, GT = G * 512;
        if (G >= 256 && bid < 256) {
            const int layer = bid >> 7, c = (bid & 127) * 8 + (tid & 7), ks = tid >> 3; const float* gate = ple_gate + (size_t)layer * DM * DM; const float* lg = post_ln_g + layer * DM; const float* lb = post_ln_b + layer * DM;
            float s1 = 0.f, s0 = 0.f;
#pragma unroll
            for (int k = ks * 16; k < ks * 16 + 16; ++k) { const float w = gate[(size_t)k * DM + c]; s1 += bf2f(f2bf(w * lg[k])); s0 += w * lb[k]; }
            float* red = (float*)lds; red[tid * 2] = s1; red[tid * 2 + 1] = s0;
            __syncthreads();
            if (tid < 8) { float t1 = 0.f, t0 = 0.f;
                for (int i = 0; i < 64; ++i) { t1 += red[(i * 8 + tid) * 2]; t0 += red[(i * 8 + tid) * 2 + 1]; }
                GV[layer * 2048 + c] = t1; GV[layer * 2048 + 1024 + c] = t0; }
            __syncthreads();
        } else if (G < 256 && bid < 32) {
            const int layer = bid >> 4, c = (bid & 15) * 64 + (tid & 63), kq = tid >> 6; const float* gate = ple_gate + (size_t)layer * DM * DM; const float* lg = post_ln_g + layer * DM; const float* lb = post_ln_b + layer * DM;
            float s1 = 0.f, s0 = 0.f;
            for (int k = kq * 128; k < kq * 128 + 128; ++k) { const float w = gate[(size_t)k * DM + c]; s1 += bf2f(f2bf(w * lg[k])); s0 += w * lb[k]; }
            float* red = (float*)lds; red[(kq * 64 + (tid & 63)) * 2] = s1; red[(kq * 64 + (tid & 63)) * 2 + 1] = s0;
            __syncthreads();
            if (tid < 64) { float t1 = 0.f, t0 = 0.f;
                for (int i = 0; i < 8; ++i) { t1 += red[(i * 64 + tid) * 2]; t0 += red[(i * 64 + tid) * 2 + 1]; }
                GV[layer * 2048 + c] = t1; GV[layer * 2048 + 1024 + c] = t0; }
            __syncthreads();
        }
        conv_w(ev_w_in, WT_IN0, 1024, EV_IN, EV_IN, 0, nullptr, nullptr, 0.125f * LOG2E, 512, gt, GT);
        conv_w(ev_w_out, WT_OUT0, 1024, 1024, 1024, 0, ev_a_norm, ev_b_norm, 1.f, 0, gt, GT);
        conv_w(ple_gate, WT_GATE0, 1024, 1024, 1024, 0, post_ln_g, nullptr, 1.f, 0, gt, GT);
        conv_w(ple_gate + (size_t)DM * DM, WT_GATE1, 1024, 1024, 1024, 0, post_ln_g + DM, nullptr, 1.f, 0, gt, GT);
        conv_w(ple_proj, WT_PROJ0, 256, 1024, 1024, 0, nullptr, nullptr, 1.f, 0, gt, GT);
        conv_w(ple_proj + 256 * DM, WT_PROJ1, 256, 1024, 1024, 0, nullptr, nullptr, 1.f, 0, gt, GT);
        conv_w(od_w_in, WT_IN1, 1024, OD_IN_SRC, OD_IN, 1, nullptr, nullptr, 1.f, 0, gt, GT);
        conv_w(od_w_uq, WT_UQ, 256, 768, 768, 2, od_q_norm, nullptr, 0.10206207261596577f * LOG2E, 768, gt, GT);
        conv_w(od_w_ukv, WT_UK, 128, 1024, 512, 3, od_kv_norm, nullptr, 1.f, 0, gt, GT);
        conv_w(od_w_ukv, WT_UV, 128, 1024, 512, 4, od_kv_norm, nullptr, 1.f, 0, gt, GT);
        conv_w(od_w_out, WT_OUT1, 1024, 1024, 1024, 0, od_c_norm, od_d_norm, 1.f, 0, gt, GT);
        conv_flat(od_w_s, WSB, (size_t)4 * 128 * 128 / 8, gt, GT);
        conv_flat(x_in, XB, (size_t)M * DM / 8, gt, GT);
        conv_flat(p_in, PB, (size_t)2 * M * 256 / 8, gt, GT);
        for (int i = gt; i < M * 16; i += GT) { const int row = i >> 4, j = i & 15; const float inv = exp2f(-(float)j * (13.287712379549449f / 16.f));
            double rev = (double)pos[row] * (double)inv * 0.15915494309189535; rev -= rint(rev); const float rf = (float)rev;
            CS[i] = (f32x2){__builtin_amdgcn_cosf(rf), __builtin_amdgcn_sinf(rf)}; }
    }
    if (a.ws == nullptr) grid.sync();
    SEAM();
    PH(1) { PHASE_VARS
        pg8::StaticOrder S; S.init(M, EV_IN, G, bid); pg8::Gemm g{XB, WT_IN0, M, EV_IN, 1024, 1024, 1024}; EpiStore E{H0, EV_IN, 1000};
        pg8::gemm_phase(wsg, lds3, g, S, E);
        pg8::StaticOrder S2; if (G == 256) S2.init(M, 1024, 128, bid - 128); else S2.init(M, 1024, G, bid);
        pg8::Gemm g2{PB, WT_PROJ0, M, 1024, 256, 256, 256}; EpiStore E2{PP, 1024, 1000};
        if (G != 256 || bid >= 128) pg8::gemm_phase(wsg, lds3, g2, S2, E2);
    }
    SEAM();
    PH(2) { PHASE_VARS for (int it = bid; it < 512; it += G) even_item(wsg, lds, H0, pos, ev_sink, ev_conv_w, XB, it >> 6, (it & 63) * 64); }
    SEAM();
    PH(3) { PHASE_VARS
        pg8::StaticOrder S; S.init(M, 1024, G, bid); pg8::Gemm g{XB, WT_OUT0, M, 1024, 1024, 1024, 1024}; EpiOut<false, false> E{x_in, UB, PART, nullptr};
        pg8::gemm_phase(wsg, lds3, g, S, E);
    }
    SEAM();
#define GATE_PHASE(WTG, LAYER, OUTF, XBOUT) do { \
        pg8::StaticOrder S; S.init(M, 1024, G, bid); \
        { int tq_ = tid_from(wsg); asm volatile("" : "+v"(tq_)); pg8::Unit u_; for (int i_ = tq_ >> 8; i_ < MR_UMAX && S.next(i_, u_); i_ += 2) { const int row_ = u_.pm * 256 + (tq_ & 255); const f32x4* pp_ = (const f32x4*)(PART + (size_t)row_ * 16); float s_ = 0.f, q_ = 0.f; \
              _Pragma("unroll") for (int j_ = 0; j_ < 8; ++j_) { const f32x4 v_ = pp_[j_]; s_ += v_[0] + v_[2]; q_ += v_[1] + v_[3]; } \
              const float mean_ = s_ * (1.f / 1024.f), var_ = q_ * (1.f / 1024.f) - mean_ * mean_; MRBLK[((size_t)bid * MR_UMAX + i_) * 256 + (tq_ & 255)] = (f32x2){mean_, rsqrtf(fmaxf(var_, 0.f) + EPS)}; } } \
        __threadfence_block(); __syncthreads(); \
        pg8::Gemm g{UB, WTG, M, 1024, 1024, 1024, 1024}; \
        EpiGate E{UB, MRBLK + (size_t)bid * MR_UMAX * 256, post_ln_g + (LAYER) * DM, post_ln_b + (LAYER) * DM, GV + (LAYER) * 2048, GV + (LAYER) * 2048 + 1024, PP, OUTF, XBOUT}; \
        pg8::gemm_phase(wsg, lds3, g, S, E); } while (0)
    PH(4) { PHASE_VARS GATE_PHASE(WT_GATE0, 0, (float*)nullptr, XB); }
    SEAM();
    PH(5) { PHASE_VARS
        pg8::StaticOrder S; S.init(M, OD_IN, G, bid); pg8::Gemm g{XB, WT_IN1, M, OD_IN, 1024, 1024, 1024}; EpiH1 E{H1, STATQ, STATKV, STATV, CS, KB};
        pg8::gemm_phase(wsg, lds3, g, S, E);
    }
    SEAM();
    PH(6) { PHASE_VARS
#ifndef P6MASK
#define P6MASK 15
#endif
        if constexpr (P6MASK & 1) { pg8::StaticOrder S; S.init(M, 768, G, bid); pg8::Gemm g{H1, WT_UQ, M, 768, 256, OD_IN, 256}; EpiQ E{STATQ, CS, QB}; pg8::gemm_phase(wsg, lds3, g, S, E); }
        if constexpr (P6MASK & 2) { pg8::StaticOrder S; S.init(M, 512, G, bid); pg8::Gemm g{H1 + 256, WT_UK, M, 512, 128, OD_IN, 128}; EpiK E{STATKV, KB}; pg8::gemm_phase(wsg, lds3, g, S, E); }
        if constexpr (P6MASK & 4) { pg8::StaticOrder S; S.init(512, M, G, bid); pg8::Gemm g{WT_UV, H1 + 256, 512, M, 128, 128, OD_IN}; EpiVT E{STATKV, VT}; pg8::gemm_phase(wsg, lds3, g, S, E); }
        if constexpr (P6MASK & 8) for (int it = bid; it < 256; it += G) gmlp_item(wsg, lds, H1, STATV, od_v_ln_g, od_v_ln_b, WSB, od_b_s, Y1B, it);
    }
    SEAM();
    PH(7) { PHASE_VARS for (int it = bid; it < 512; it += G) { const int xcd = it & 7, idx = it >> 3; mla_unit(wsg, lds, QB, KB, VT, H1, Y1B, SSQC, xcd * 8 + (idx >> 3), idx & 7); } }
    SEAM();
    PH(8) { PHASE_VARS
        pg8::StaticOrder S; S.init(M, 1024, G, bid); pg8::Gemm g{Y1B, WT_OUT1, M, 1024, 1024, 1024, 1024}; EpiOut<true, true> E{XB, UB, PART, SSQC};
        pg8::gemm_phase(wsg, lds3, g, S, E);
        pg8::StaticOrder S2; S2.init(M, 1024, G, bid); pg8::Gemm g2{PB + (size_t)M * 256, WT_PROJ1, M, 1024, 256, 256, 256}; EpiStore E2{PP, 1024, 1000};
        pg8::gemm_phase(wsg, lds3, g2, S2, E2);
    }
    SEAM();
    PH(9) { PHASE_VARS GATE_PHASE(WT_GATE1, 1, a.out, (bf16_t*)nullptr); }
}

extern "C" void kernel_launch(void* const* d_in, const int* in_sizes, int n_in, void* d_out, int out_size, void* d_ws, size_t ws_size, hipStream_t stream) {
    static int grid = 0;
    if (grid == 0) {
        if (n_in != 25 || out_size != M * DM || ws_size < WS_END) { fprintf(stderr, "kernel_launch: unexpected problem (n_in %d out %d ws %zu)\n", n_in, out_size, ws_size); grid = -1; return; }
        int dev = 0, cus = 0, per_cu = 0;
        (void)hipGetDevice(&dev);
        (void)hipDeviceGetAttribute(&cus, hipDeviceAttributeMultiprocessorCount, dev);
        (void)hipFuncSetAttribute((const void*)mega, hipFuncAttributeMaxDynamicSharedMemorySize, LDS_BYTES);
        (void)hipOccupancyMaxActiveBlocksPerMultiprocessor(&per_cu, (const void*)mega, 512, LDS_BYTES);
        if (per_cu < 1) { fprintf(stderr, "kernel_launch: occupancy query reports %d blocks per CU\n", per_cu); }
        grid = cus;
    }
    if (grid < 0) return;
    Args a{};
    for (int i = 0; i < 25; ++i) a.in[i] = d_in[i];
    a.out = (float*)d_out; a.ws = (unsigned char*)d_ws;
    (void)hipMemsetAsync((unsigned char*)d_ws + WS_BAR, 0, XCD_BAR_WORDS * 4, stream);
    void* args[] = {&a};
    hipError_t e = hipLaunchCooperativeKernel((const void*)mega, dim3(grid), dim3(512), args, LDS_BYTES, stream);
    if (e != hipSuccess) fprintf(stderr, "cooperative launch failed: %s (grid %d)\n", hipGetErrorString(e), grid);
}
```
